# Optimizing an MI355X kernel written in HIP

```python
import jax, jax.numpy as jnp
from jax import lax
import numpy as np

D_MODEL = 1024
BATCH = 16
SEQ = 2048
DEPTH = 4

GRID_W = 64
CTX_LEN = 256
EXPAND = 2
D_INNER = EXPAND * D_MODEL
M_HEADS = 4
M_HEAD_DIM = D_INNER // M_HEADS
CHUNK = 64
N_CONV_LAYERS = (DEPTH + 1) // 2
N_MLSTM_LAYERS = DEPTH // 2
EPS = 1e-6

kernel_name = "hybrid_shortconv_mlstm_dit"


def _rmsnorm(x, g):
    xf = x.astype(jnp.float32)
    y = xf * lax.rsqrt(jnp.mean(xf * xf, axis=-1, keepdims=True) + EPS)
    return (y * g.astype(jnp.float32)).astype(x.dtype)


def _modulate(x, g, shift, scale):
    return _rmsnorm(x, g) * (1 + scale) + shift


def _dwconv3(u, w):
    pad = [(0, 0)] * (u.ndim - 2) + [(1, 1), (0, 0)]
    p = jnp.pad(u, pad)
    return p[..., :-2, :] * w[0] + p[..., 1:-1, :] * w[1] + p[..., 2:, :] * w[2]


def _grid_conv3(u, w):
    b, s, ch = u.shape
    rows = s // GRID_W
    return _dwconv3(u.reshape(b, rows, GRID_W, ch), w).reshape(b, s, ch)


def _shortconv_mixer(h, w_in, w_conv, w_out, conv_fn):
    b_gate, c_gate, u, z = jnp.split(h @ w_in, 4, axis=-1)
    y = b_gate * conv_fn(c_gate * u, w_conv)
    return (y * jax.nn.silu(z)) @ w_out


def _zero_state(b):
    return (jnp.zeros((b, M_HEADS, M_HEAD_DIM, M_HEAD_DIM), jnp.float32),
            jnp.zeros((b, M_HEADS, M_HEAD_DIM), jnp.float32),
            jnp.zeros((b, M_HEADS), jnp.float32))


def _mlstm_scan(q, k, v, ig, lf, state):
    b, nh, t, dh = q.shape
    nc = t // CHUNK

    def to_chunks(a):
        return jnp.moveaxis(a.reshape(b, nh, nc, CHUNK, *a.shape[3:]), 2, 0)

    mask = jnp.tril(jnp.ones((CHUNK, CHUNK), bool))

    def step(carry, xs):
        c_prev, n_prev, m_prev = carry
        qc, kc, vc, ic, fc = xs
        bcum = jnp.cumsum(fc, axis=-1)
        dmat = bcum[..., :, None] - bcum[..., None, :] + ic[..., None, :]
        dmat = jnp.where(mask, dmat, -jnp.inf)
        m_inter = bcum + m_prev[..., None]
        m_j = jnp.maximum(m_inter, dmat.max(-1))
        s = jnp.einsum('bhjd,bhsd->bhjs', qc, kc) * jnp.exp(dmat - m_j[..., None])
        w_inter = jnp.exp(m_inter - m_j)
        num = w_inter[..., None] * jnp.einsum('bhjd,bhde->bhje', qc, c_prev) + jnp.einsum('bhjs,bhse->bhje', s, vc)
        den = w_inter * jnp.einsum('bhjd,bhd->bhj', qc, n_prev) + s.sum(-1)
        h = num / jnp.maximum(jnp.abs(den), jnp.exp(-m_j))[..., None]
        b_last = bcum[..., -1]
        g = b_last[..., None] - bcum + ic
        m_new = jnp.maximum(b_last + m_prev, g.max(-1))
        w_decay = jnp.exp(b_last + m_prev - m_new)
        w_s = jnp.exp(g - m_new[..., None])
        c_new = w_decay[..., None, None] * c_prev + jnp.einsum('bhs,bhsd,bhse->bhde', w_s, kc, vc)
        n_new = w_decay[..., None] * n_prev + jnp.einsum('bhs,bhsd->bhd', w_s, kc)
        return (c_new, n_new, m_new), h

    state, hs = lax.scan(step, state, (to_chunks(q), to_chunks(k), to_chunks(v), to_chunks(ig), to_chunks(lf)))
    h = jnp.moveaxis(hs, 0, 2).reshape(b, nh, t, dh)
    return h, state


def _mlstm_final_state(k, v, ig, lf):
    bcum = jnp.cumsum(lf, axis=-1)
    b_last = bcum[..., -1]
    g = b_last[..., None] - bcum + ig
    m = jnp.maximum(b_last, g.max(-1))
    w = jnp.exp(g - m[..., None])
    return (jnp.einsum('bht,bhtd,bhte->bhde', w, k, v), jnp.einsum('bht,bhtd->bhd', w, k), m)


def _flip_t(a):
    return jnp.flip(a, axis=2)


def _mlstm_inputs(u, w_conv, wq, wk, wv, w_gate, b_gate, conv_fn):
    b, t, _ = u.shape
    u_c = jax.nn.silu(conv_fn(u, w_conv))
    uc_h = u_c.reshape(b, t, M_HEADS, M_HEAD_DIM)
    u_h = u.reshape(b, t, M_HEADS, M_HEAD_DIM)
    q = jnp.einsum('bthd,hde->bthe', uc_h, wq)
    k = jnp.einsum('bthd,hde->bthe', uc_h, wk) * (M_HEAD_DIM ** -0.5)
    v = jnp.einsum('bthd,hde->bthe', u_h, wv)
    gin = jnp.concatenate([q.reshape(b, t, D_INNER), k.reshape(b, t, D_INNER), v.reshape(b, t, D_INNER)], axis=-1)
    gates = (gin @ w_gate + b_gate).astype(jnp.float32).reshape(b, t, 4, M_HEADS)
    gates = jnp.transpose(gates, (2, 0, 3, 1))
    to_bhtd = lambda a: jnp.transpose(a, (0, 2, 1, 3)).astype(jnp.float32)
    return to_bhtd(q), to_bhtd(k), to_bhtd(v), gates, u_c


def _mlstm_mixer(h, w_in, w_conv, wq, wk, wv, w_gate, b_gate, norm_g, skip, w_out, conv_fn, st_f, st_b):
    b, t, _ = h.shape
    u, z, o_pre = jnp.split(h @ w_in, 3, axis=-1)
    q, k, v, g, u_c = _mlstm_inputs(u, w_conv, wq, wk, wv, w_gate, b_gate, conv_fn)
    h_f, st_f = _mlstm_scan(q, k, v, g[0], jax.nn.log_sigmoid(g[1]), st_f)
    h_b, st_b = _mlstm_scan(_flip_t(q), _flip_t(k), _flip_t(v), _flip_t(g[2]),
                            jax.nn.log_sigmoid(_flip_t(g[3])), st_b)
    h_sum = h_f + _flip_t(h_b)
    mu = jnp.mean(h_sum, axis=-1, keepdims=True)
    var = jnp.mean(jnp.square(h_sum - mu), axis=-1, keepdims=True)
    hn = (h_sum - mu) * lax.rsqrt(var + EPS)
    hn = jnp.transpose(hn, (0, 2, 1, 3)).reshape(b, t, D_INNER).astype(h.dtype) * norm_g
    y = jax.nn.sigmoid(o_pre) * hn
    y = (y + skip * u_c) * jax.nn.silu(z)
    return y @ w_out, st_f, st_b


def _mlstm_context_states(h, w_in, w_conv, wq, wk, wv, w_gate, b_gate):
    u = h @ w_in[:, :D_INNER]
    q, k, v, g, _ = _mlstm_inputs(u, w_conv, wq, wk, wv, w_gate, b_gate, _dwconv3)
    st_f = _mlstm_final_state(k, v, g[0], jax.nn.log_sigmoid(g[1]))
    st_b = _mlstm_final_state(_flip_t(k), _flip_t(v), _flip_t(g[2]), jax.nn.log_sigmoid(_flip_t(g[3])))
    return st_f, st_b


def setup_inputs(seed: int = 0) -> dict:
    key = jax.random.key(seed)
    ks = jax.random.split(key, 32)
    f32 = jnp.float32
    nrm = lambda k, shape, scale: jax.random.normal(k, shape, f32) * scale
    nc, nm, h = N_CONV_LAYERS, N_MLSTM_LAYERS, M_HEADS
    f_bias = jnp.linspace(3.0, 6.0, h, dtype=f32)
    b_gate = jnp.concatenate([nrm(ks[20], (nm, h), 0.1), f_bias + nrm(ks[21], (nm, h), 0.1),
                              nrm(ks[22], (nm, h), 0.1), f_bias + nrm(ks[23], (nm, h), 0.1)], axis=-1)
    return {
        "x": nrm(ks[0], (BATCH, SEQ, D_MODEL), 1.0),
        "c": nrm(ks[1], (BATCH, D_MODEL), 1.0),
        "ctx": nrm(ks[2], (BATCH, CTX_LEN, D_MODEL), 1.0),
        "c_ctx": nrm(ks[3], (D_MODEL,), 1.0),
        "norm_g": 1.0 + nrm(ks[4], (DEPTH, D_MODEL), 0.05),
        "mod_w": nrm(ks[5], (DEPTH, D_MODEL, 3 * D_MODEL), 0.5 * D_MODEL ** -0.5),
        "mod_b": nrm(ks[6], (DEPTH, 3 * D_MODEL), 0.02),
        "conv_w_in": nrm(ks[7], (nc, D_MODEL, 4 * D_INNER), D_MODEL ** -0.5),
        "conv_w": nrm(ks[8], (nc, 3, D_INNER), 3 ** -0.5),
        "conv_w_out": nrm(ks[9], (nc, D_INNER, D_MODEL), D_INNER ** -0.5),
        "m_w_in": nrm(ks[10], (nm, D_MODEL, 3 * D_INNER), D_MODEL ** -0.5),
        "m_conv_w": nrm(ks[11], (nm, 3, D_INNER), 3 ** -0.5),
        "m_wq": nrm(ks[12], (nm, h, M_HEAD_DIM, M_HEAD_DIM), M_HEAD_DIM ** -0.5),
        "m_wk": nrm(ks[13], (nm, h, M_HEAD_DIM, M_HEAD_DIM), M_HEAD_DIM ** -0.5),
        "m_wv": nrm(ks[14], (nm, h, M_HEAD_DIM, M_HEAD_DIM), M_HEAD_DIM ** -0.5),
        "m_w_gate": nrm(ks[15], (nm, 3 * D_INNER, 4 * h), 0.3 * (3 * D_INNER) ** -0.5),
        "m_b_gate": b_gate,
        "m_norm_g": 1.0 + nrm(ks[16], (nm, D_INNER), 0.05),
        "m_skip": 1.0 + nrm(ks[17], (nm, D_INNER), 0.1),
        "m_w_out": nrm(ks[18], (nm, D_INNER, D_MODEL), D_INNER ** -0.5),
        "final_g": 1.0 + nrm(ks[19], (D_MODEL,), 0.05),
    }


def reference(x, c, ctx, c_ctx, norm_g, mod_w, mod_b, conv_w_in, conv_w, conv_w_out,
              m_w_in, m_conv_w, m_wq, m_wk, m_wv, m_w_gate, m_b_gate, m_norm_g, m_skip, m_w_out, final_g):
    b = x.shape[0]
    sc = jax.nn.silu(c)
    scc = jax.nn.silu(c_ctx)
    for i in range(DEPTH):
        last = i == DEPTH - 1
        j = i // 2
        shift, scale, gate = jnp.split(sc @ mod_w[i] + mod_b[i], 3, axis=-1)
        hx = _modulate(x, norm_g[i], shift[:, None], scale[:, None])
        if i % 2 == 0:
            x = x + gate[:, None] * _shortconv_mixer(hx, conv_w_in[j], conv_w[j], conv_w_out[j], _grid_conv3)
            if not last:
                shift_c, scale_c, gate_c = jnp.split(scc @ mod_w[i] + mod_b[i], 3, axis=-1)
                hc = _modulate(ctx, norm_g[i], shift_c, scale_c)
                ctx = ctx + gate_c * _shortconv_mixer(hc, conv_w_in[j], conv_w[j], conv_w_out[j], _dwconv3)
        else:
            shift_c, scale_c, gate_c = jnp.split(scc @ mod_w[i] + mod_b[i], 3, axis=-1)
            hc = _modulate(ctx, norm_g[i], shift_c, scale_c)
            if last:
                st_f, st_b = _mlstm_context_states(hc, m_w_in[j], m_conv_w[j], m_wq[j], m_wk[j], m_wv[j],
                                                   m_w_gate[j], m_b_gate[j])
            else:
                yc, st_f, st_b = _mlstm_mixer(hc, m_w_in[j], m_conv_w[j], m_wq[j], m_wk[j], m_wv[j],
                                              m_w_gate[j], m_b_gate[j], m_norm_g[j], m_skip[j], m_w_out[j],
                                              _dwconv3, _zero_state(b), _zero_state(b))
                ctx = ctx + gate_c * yc
            yx, _, _ = _mlstm_mixer(hx, m_w_in[j], m_conv_w[j], m_wq[j], m_wk[j], m_wv[j],
                                    m_w_gate[j], m_b_gate[j], m_norm_g[j], m_skip[j], m_w_out[j],
                                    _grid_conv3, st_f, st_b)
            x = x + gate[:, None] * yx
    return _rmsnorm(x, final_g)
```

```cpp
#include <hip/hip_runtime.h>
#include <hip/hip_cooperative_groups.h>
#include <cstdio>
namespace cg = cooperative_groups;

#define LAS __attribute__((address_space(3)))
typedef unsigned short bf16_t;
typedef short bf16x8 __attribute__((ext_vector_type(8)));
typedef float f32x4 __attribute__((ext_vector_type(4)));
typedef unsigned u32x4 __attribute__((ext_vector_type(4)));
typedef unsigned u32x2 __attribute__((ext_vector_type(2)));

constexpr int DM = 1024, DI = 2048, NB = 16, SEQ = 2048, CTXL = 256, TT = 2304  , NH = 4, DH = 512;
constexpr int GB = 4  , RG = GB * TT  , MT = RG / 256  ;
constexpr float EPSV = 1e-6f;
constexpr size_t MIB = 1ull << 20;
constexpr size_t WS_CWIN = 0, WS_CWOUT = 32 * MIB, WS_MWIN = 40 * MIB, WS_MWQKV = 64 * MIB, WS_MWOUT = 76 * MIB, WS_MWG = 84 * MIB,
                 WS_MODP = 90 * MIB, WS_MOD = 97 * MIB, WS_XC = 98 * MIB, WS_HX = 114 * MIB, WS_BIG = 132 * MIB, WS_UC = WS_BIG + 108 * MIB,
                 WS_QKV = 276 * MIB, WS_KT = 384 * MIB, WS_VT = 420 * MIB, WS_QKR = 456 * MIB, WS_GATES = 465 * MIB, WS_BAR = 466 * MIB, WS_GATESP = 468 * MIB  , WS_HX2 = 474 * MIB  , WS_END = 492 * MIB;
constexpr int LDS_BST = 139264;
constexpr int LDS_BYTES = LDS_BST + 16;

struct Params {
    const float *x, *c, *ctx, *c_ctx, *norm_g, *mod_w, *mod_b, *conv_w_in, *conv_w, *conv_w_out, *m_w_in, *m_conv_w, *m_wq, *m_wk, *m_wv,
        *m_w_gate, *m_b_gate, *m_norm_g, *m_skip, *m_w_out, *final_g;
    float* out; unsigned char* ws;
};

__device__ __forceinline__ unsigned cvt_pk_bf16(float lo, float hi) { unsigned r; asm volatile("v_cvt_pk_bf16_f32 %0, %1, %2" : "=v"(r) : "v"(lo), "v"(hi)); return r; }
__device__ __forceinline__ float bf_lo(unsigned w) { return __uint_as_float(w << 16); }
__device__ __forceinline__ float bf_hi(unsigned w) { return __uint_as_float(w & 0xffff0000u); }
__device__ __forceinline__ void unpack8(u32x4 v, float* f) { f[0] = bf_lo(v.x); f[1] = bf_hi(v.x); f[2] = bf_lo(v.y); f[3] = bf_hi(v.y); f[4] = bf_lo(v.z); f[5] = bf_hi(v.z); f[6] = bf_lo(v.w); f[7] = bf_hi(v.w); }
__device__ __forceinline__ u32x4 pack8(const float* f) { u32x4 o; o.x = cvt_pk_bf16(f[0], f[1]); o.y = cvt_pk_bf16(f[2], f[3]); o.z = cvt_pk_bf16(f[4], f[5]); o.w = cvt_pk_bf16(f[6], f[7]); return o; }
__device__ __forceinline__ float silu_f(float v) { return v * __builtin_amdgcn_rcpf(1.f + __expf(-v)); }
__device__ __forceinline__ float sigmoid_f(float v) { return __builtin_amdgcn_rcpf(1.f + __expf(-v)); }
__device__ __forceinline__ float lane_read(float v, int srclane) { return __int_as_float(__builtin_amdgcn_ds_bpermute(srclane << 2, __float_as_int(v))); }
__device__ __forceinline__ float wave_sum(float v, int lane) {
    (void)lane;
#define DPPS(x, ctrl, rmask) __int_as_float(__builtin_amdgcn_update_dpp(0, __float_as_int(x), ctrl, rmask, 0xf, false))
    v += DPPS(v, 0x111, 0xf); v += DPPS(v, 0x112, 0xf); v += DPPS(v, 0x114, 0xf); v += DPPS(v, 0x118, 0xf);
    v += DPPS(v, 0x142, 0xa); v += DPPS(v, 0x143, 0xc);
#undef DPPS
    return __int_as_float(__builtin_amdgcn_readlane(__float_as_int(v), 63));
}
#define LDS_WAIT() asm volatile("s_waitcnt lgkmcnt(0)" ::: "memory")
template <class T> __device__ __forceinline__ T* opq(T* p) { return p; }
#define CAS __attribute__((address_space(4)))
__device__ __forceinline__ Params load_params() {
    int z = 0; asm volatile("" : "+s"(z));
    const CAS unsigned long long* kp = (const CAS unsigned long long*)((const CAS char*)__builtin_amdgcn_kernarg_segment_ptr() + z);
    Params r; unsigned long long* d = (unsigned long long*)&r;
#pragma unroll
    for (int i = 0; i < (int)(sizeof(Params) / 8); ++i) d[i] = kp[i];
    return r;
}
__device__ __forceinline__ int opaque_tid(int wv) {
    int ln; asm volatile("v_mbcnt_lo_u32_b32 %0, -1, 0\n\tv_mbcnt_hi_u32_b32 %0, -1, %0" : "=&v"(ln)); return wv * 64 + ln; }

constexpr int BM = 256, BK = 64, HALF = 128, HTB = HALF * BK * 2, NXCD = 8, WGM = 8;
__device__ __forceinline__ int lds_byte(int r, int c) { const int st = (r >> 4) * 2 + (c >> 5), rr = r & 15, cc = c & 31, ob = rr * 64 + cc * 2; return st * 1024 + (ob ^ (((ob >> 9) & 1) << 5)); }
__device__ __forceinline__ void stage_rc(int b, int& R, int& C) { const int st = b / 1024, sb = b % 1024, swz = sb ^ (((sb >> 9) & 1) << 5); R = (st >> 1) * 16 + swz / 64; C = (st & 1) * 32 + (swz % 64) / 2; }
__device__ __forceinline__ int perm32(int rho) { const int n = rho >> 4, i = rho & 15; return 8 * (i >> 2) + 4 * n + (i & 3); }
struct Unit { int pm, pn; };
__device__ __forceinline__ bool tile_next(int i, int G, int c, int nM, int nN, Unit& u, int tailc = 0) {
    const int nwg = nM * nN; long L = (long)i * G + c;
    if (tailc > 0) { const int fr_ = nwg / G, full = fr_ * G, rem = nwg - full;
        if (i >= fr_) { const int k = i - fr_; if (k == 0) { if (c >= tailc) return false; L = full + c; } else if (k == 1) { if (c >= rem - tailc) return false; L = full + tailc + c; } else return false; } }
    if (L >= nwg) return false;
    int wgid = (int)L; { const int q = nwg / NXCD, r = nwg % NXCD, xcd = wgid % NXCD, off = wgid / NXCD; wgid = (xcd < r ? xcd * (q + 1) : r * (q + 1) + (xcd - r) * q) + off; }
    const int nig = WGM * nN, gid = wgid / nig, fm = gid * WGM, gsz = (nM - fm) < WGM ? (nM - fm) : WGM;
    u.pm = fm + ((wgid % nig) % gsz); u.pn = (wgid % nig) / gsz; return true;
}

__device__ __forceinline__ void store_bf16_tile(const f32x4 (&acc)[2][2][4][2], bf16_t* base, size_t ldc, float scale, int wr, int wc, int fr, int fq) {
    bf16_t* p0 = base + (size_t)(wr * 64 + fr) * ldc + wc * 32 + 8 * fq;
#pragma unroll
    for (int ai = 0; ai < 2; ++ai)
#pragma unroll
        for (int m = 0; m < 4; ++m) { bf16_t* rowp = p0 + (size_t)(ai * HALF + m * 16) * ldc;
#pragma unroll
            for (int bj = 0; bj < 2; ++bj) { const f32x4 v0 = acc[ai][bj][m][0] * scale, v1 = acc[ai][bj][m][1] * scale;
                u32x4 w; w.x = cvt_pk_bf16(v0[0], v0[1]); w.y = cvt_pk_bf16(v0[2], v0[3]); w.z = cvt_pk_bf16(v1[0], v1[1]); w.w = cvt_pk_bf16(v1[2], v1[3]);
                *(u32x4*)(rowp + bj * HALF) = w; } }
}

template <class PH>
__device__ __forceinline__ void gemm_phase(LAS unsigned char* lds, const PH& S, int wv) {
    const int tid = opaque_tid(wv);
    const int wid = __builtin_amdgcn_readfirstlane(tid >> 6), lane = tid & 63, wr = wid >> 2, wc = wid & 3, fr = lane & 15, fq = lane >> 4;
    const int K = S.K, nt = K / BK;
    const int G = gridDim.x, cblk = (int)((blockIdx.x + (unsigned)S.coff) % gridDim.x);
    unsigned voffA[2], voffB[2];
#pragma unroll
    for (int i = 0; i < 2; ++i) { int R, C; stage_rc(tid * 16 + i * 8192, R, C); const int Rb = PH::PERM ? ((R & ~31) + perm32(R & 31)) : R;
        voffA[i] = (unsigned)(R * S.lda + C) * 2u; voffB[i] = (unsigned)(Rb * S.ldb + C) * 2u; }
    const size_t kstep = (size_t)(BK * 2);
    const size_t hstepA = (size_t)HALF * S.lda * 2, hstepB = (size_t)HALF * S.ldb * 2;
    const unsigned ldsw = (unsigned)wid * 1024u;
    const int aoff = lds_byte(wr * 64 + fr, fq * 8), boff = lds_byte(wc * 32 + fr, fq * 8);
#define PG8_SA(b, h) (((b) * 2 + (h)) * HTB)
#define PG8_SB(b, h) ((4 + (b) * 2 + (h)) * HTB)
#define PG8_STAGE(bufoff, gbase, voff) do { _Pragma("unroll") for (int _i = 0; _i < 2; ++_i) \
        __builtin_amdgcn_global_load_lds((const unsigned*)((const char*)(gbase) + (voff)[_i]), (LAS unsigned*)(lds + (bufoff) + ldsw + _i * 8192), 16, 0, 0); } while (0)
#define PG8_LDA(dst, b, h) do { _Pragma("unroll") for (int m = 0; m < 4; ++m) _Pragma("unroll") for (int k = 0; k < 2; ++k) dst[m][k] = *(const LAS bf16x8*)(lds + PG8_SA(b, h) + aoff + m * 2048 + k * 1024); } while (0)
#define PG8_LDB(dst, b, h) do { _Pragma("unroll") for (int n = 0; n < 2; ++n) _Pragma("unroll") for (int k = 0; k < 2; ++k) dst[n][k] = *(const LAS bf16x8*)(lds + PG8_SB(b, h) + boff + n * 2048 + k * 1024); } while (0)
#define PG8_MMA(ai, bj, At, Bt) do { __builtin_amdgcn_s_setprio(1); _Pragma("unroll") for (int m = 0; m < 4; ++m) _Pragma("unroll") for (int n = 0; n < 2; ++n) _Pragma("unroll") for (int k = 0; k < 2; ++k) \
        acc[ai][bj][m][n] = __builtin_amdgcn_mfma_f32_16x16x32_bf16(Bt[n][k], At[m][k], acc[ai][bj][m][n], 0, 0, 0); __builtin_amdgcn_s_setprio(0); } while (0)
#define PG8_WAIT_V(n) asm volatile("s_waitcnt vmcnt(" #n ")" ::: "memory")
#define PG8_WAIT_L(n) asm volatile("s_waitcnt lgkmcnt(" #n ")" ::: "memory")
#define PG8_BAR __builtin_amdgcn_s_barrier()
#define PG8_SCHED __builtin_amdgcn_sched_barrier(0)
    Unit cur, nxt; int ui = 0;
    if (!tile_next(0, G, cblk, S.nM, S.nN, cur, S.coff != 0 ? PH::TAILC : 0)) return;
    f32x4 acc[2][2][4][2];
#pragma unroll
    for (int a = 0; a < 2; ++a)
#pragma unroll
        for (int b = 0; b < 2; ++b)
#pragma unroll
            for (int m = 0; m < 4; ++m)
#pragma unroll
                for (int n = 0; n < 2; ++n) acc[a][b][m][n] = (f32x4){0.f, 0.f, 0.f, 0.f};
    bf16x8 At[4][2], B0[2][2], B1[2][2];
    const char* cA = S.aptr(cur); const char* cB = S.bptr(cur);
    PG8_STAGE(PG8_SB(0, 0), cB, voffB); PG8_STAGE(PG8_SA(0, 0), cA, voffA); PG8_STAGE(PG8_SB(0, 1), cB + hstepB, voffB); PG8_STAGE(PG8_SA(0, 1), cA + hstepA, voffA);
    if (wr == 1) PG8_BAR;
    PG8_WAIT_V(4); PG8_BAR;
    PG8_STAGE(PG8_SB(1, 0), cB + kstep, voffB); PG8_STAGE(PG8_SA(1, 0), cA + kstep, voffA); PG8_STAGE(PG8_SB(1, 1), cB + hstepB + kstep, voffB);
    PG8_WAIT_V(6); PG8_BAR;
    for (;;) {
        const bool has_next = tile_next(ui + 1, G, cblk, S.nM, S.nN, nxt, S.coff != 0 ? PH::TAILC : 0);
        const char* nA = has_next ? S.aptr(nxt) : cA; const char* nB = has_next ? S.bptr(nxt) : cB;
        for (int t = 0; t < nt; t += 2) {
            const bool last = (t == nt - 2);
            const char* a1 = cA + (size_t)(t + 1) * kstep;
            const char* a2 = last ? nA : cA + (size_t)(t + 2) * kstep; const char* b2 = last ? nB : cB + (size_t)(t + 2) * kstep;
            const char* a3 = a2 + kstep; const char* b3 = b2 + kstep;
            PG8_LDB(B0, 0, 0); PG8_SCHED; PG8_LDA(At, 0, 0); PG8_STAGE(PG8_SA(1, 1), a1 + hstepA, voffA);
            PG8_WAIT_L(8); PG8_BAR; PG8_WAIT_L(0); PG8_MMA(0, 0, At, B0); PG8_BAR; PG8_SCHED;
            PG8_LDB(B1, 0, 1); PG8_STAGE(PG8_SB(0, 0), b2, voffB);
            PG8_BAR; PG8_WAIT_L(0); PG8_MMA(0, 1, At, B1); PG8_BAR;
            PG8_LDA(At, 0, 1); PG8_STAGE(PG8_SA(0, 0), a2, voffA);
            PG8_BAR; PG8_WAIT_L(0); PG8_MMA(1, 0, At, B0); PG8_BAR; PG8_SCHED;
            PG8_STAGE(PG8_SB(0, 1), b2 + hstepB, voffB);
            PG8_WAIT_V(6); PG8_BAR; PG8_MMA(1, 1, At, B1); PG8_BAR;
            PG8_LDB(B0, 1, 0); PG8_SCHED; PG8_LDA(At, 1, 0); PG8_STAGE(PG8_SA(0, 1), a2 + hstepA, voffA);
            PG8_WAIT_L(8); PG8_BAR; PG8_WAIT_L(0); PG8_MMA(0, 0, At, B0); PG8_BAR; PG8_SCHED;
            PG8_LDB(B1, 1, 1); PG8_STAGE(PG8_SB(1, 0), b3, voffB);
            PG8_BAR; PG8_WAIT_L(0); PG8_MMA(0, 1, At, B1); PG8_BAR;
            PG8_LDA(At, 1, 1); PG8_STAGE(PG8_SA(1, 0), a3, voffA);
            PG8_BAR; PG8_WAIT_L(0); PG8_MMA(1, 0, At, B0); PG8_BAR; PG8_SCHED;
            PG8_STAGE(PG8_SB(1, 1), b3 + hstepB, voffB);
            PG8_WAIT_V(6); PG8_BAR; PG8_MMA(1, 1, At, B1); PG8_BAR;
        }
        S.epi(acc, cur, wr, wc, fr, fq);
        if (!has_next) break;
#pragma unroll
        for (int a = 0; a < 2; ++a)
#pragma unroll
            for (int b = 0; b < 2; ++b)
#pragma unroll
                for (int m = 0; m < 4; ++m)
#pragma unroll
                    for (int n = 0; n < 2; ++n) acc[a][b][m][n] = (f32x4){0.f, 0.f, 0.f, 0.f};
        cur = nxt; cA = nA; cB = nB; ++ui;
    }
    PG8_WAIT_V(0);
    if (wr == 0) PG8_BAR;
    PG8_BAR;
#undef PG8_SA
#undef PG8_SB
#undef PG8_STAGE
#undef PG8_LDA
#undef PG8_LDB
#undef PG8_MMA
#undef PG8_WAIT_V
#undef PG8_WAIT_L
#undef PG8_BAR
#undef PG8_SCHED
}

struct PhPlain {
    static constexpr bool PERM = true; static constexpr int TAILC = 0;
    int K, lda, ldb, nM, nN, coff; const bf16_t *A, *B; bf16_t* O; int ldc;
    __device__ __forceinline__ const char* aptr(const Unit& u) const { return (const char*)(A + (size_t)u.pm * 256 * lda); }
    __device__ __forceinline__ const char* bptr(const Unit& u) const { return (const char*)(B + (size_t)u.pn * 256 * ldb); }
    __device__ __forceinline__ void epi(const f32x4 (&acc)[2][2][4][2], const Unit& u, int wr, int wc, int fr, int fq) const {
        store_bf16_tile(acc, O + (size_t)u.pm * 256 * ldc + (size_t)u.pn * 256, (size_t)ldc, 1.f, wr, wc, fr, fq);
    }
};
#define DPP4(dst, src, ctrl) { _Pragma("unroll") for (int i_ = 0; i_ < 4; ++i_) dst[i_] = __int_as_float(__builtin_amdgcn_update_dpp(0, __float_as_int(src[i_]), ctrl, 0xf, 0xf, false)); }
struct PhConvFused {
    static constexpr bool PERM = true; static constexpr int TAILC = 112;
    int K, lda, ldb, nM, nN, coff; const bf16_t *A, *B; bf16_t* BIG; bf16_t* Y; const float* cw;
    __device__ __forceinline__ const char* aptr(const Unit& u) const { return (const char*)(A + (size_t)u.pm * 256 * lda); }
    __device__ __forceinline__ const char* bptr(const Unit& u) const { return (const char*)(B + (size_t)u.pn * 256 * ldb); }
    __device__ __forceinline__ void epi(const f32x4 (&acc)[2][2][4][2], const Unit& u, int wr, int wc, int fr, int fq) const {
        const int jc = u.pn * 64 + 16 * wc + 4 * fq;
        if (u.pm % 9 == 0) {
#pragma unroll
            for (int ai = 0; ai < 2; ++ai)
#pragma unroll
                for (int m = 0; m < 4; ++m) { bf16_t* rowp = BIG + (size_t)(u.pm * 256 + ai * HALF + wr * 64 + m * 16 + fr) * 8192 + jc;
#pragma unroll
                    for (int bj = 0; bj < 2; ++bj)
#pragma unroll
                        for (int n = 0; n < 2; ++n) { const f32x4 v = acc[ai][bj][m][n]; u32x2 o; o.x = cvt_pk_bf16(v[0], v[1]); o.y = cvt_pk_bf16(v[2], v[3]);
                            *(u32x2*)(rowp + (2 * bj + n) * 2048) = o; } }
            return;
        }
        const f32x4 w0 = *(const f32x4*)(cw + jc), w1 = *(const f32x4*)(cw + DI + jc), w2 = *(const f32x4*)(cw + 2 * DI + jc);
#pragma unroll
        for (int ai = 0; ai < 2; ++ai) {
            f32x4 cu[4];
#pragma unroll
            for (int m = 0; m < 4; ++m) cu[m] = acc[ai][0][m][1] * acc[ai][1][m][0];
#pragma unroll
            for (int m = 0; m < 4; ++m) {
                f32x4 pv, nx, t;
                DPP4(pv, cu[m], 0x111)
                if (m > 0) { DPP4(t, cu[m - 1], 0x121) if (fr == 0) pv = t; }
                DPP4(nx, cu[m], 0x101)
                if (m < 3) { DPP4(t, cu[m + 1], 0x12F) if (fr == 15) nx = t; }
                const f32x4 bb = acc[ai][0][m][0], zz = acc[ai][1][m][1];
                f32x4 y;
#pragma unroll
                for (int i = 0; i < 4; ++i) y[i] = bb[i] * (w0[i] * pv[i] + w1[i] * cu[m][i] + w2[i] * nx[i]) * silu_f(zz[i]);
                u32x2 o; o.x = cvt_pk_bf16(y[0], y[1]); o.y = cvt_pk_bf16(y[2], y[3]);
                *(u32x2*)(Y + (size_t)(u.pm * 256 + ai * HALF + wr * 64 + m * 16 + fr) * DI + jc) = o;
            }
        }
    }
};
struct PhQKV {
    static constexpr bool PERM = true; static constexpr int TAILC = 0;
    int K, lda, ldb, nM, nN, coff; const bf16_t* A; const bf16_t* W  ; bf16_t* O; int which0;
    __device__ __forceinline__ const char* aptr(const Unit& u) const { const int h = (u.pn >> 1) & 3; return (const char*)(A + (size_t)u.pm * 256 * lda + h * 512); }
    __device__ __forceinline__ const char* bptr(const Unit& u) const { const int which = which0 + (u.pn >> 3), h = (u.pn >> 1) & 3, half = u.pn & 1;
        return (const char*)(W + ((size_t)(which * 4 + h) * 512 + half * 256) * 512); }
    __device__ __forceinline__ void epi(const f32x4 (&acc)[2][2][4][2], const Unit& u, int wr, int wc, int fr, int fq) const {
        const int which = which0 + (u.pn >> 3), h = (u.pn >> 1) & 3, half = u.pn & 1;
        store_bf16_tile(acc, O + (size_t)u.pm * 256 * 6144 + which * 2048 + h * 512 + half * 256, 6144, which == 1 ? 0.044194173824159216f : 1.f, wr, wc, fr, fq);
    }
};
struct PhTr {
    static constexpr bool PERM = true; static constexpr int TAILC = 0;
    int K, lda, ldb, nM, nN, coff; const bf16_t* W  ; const bf16_t* Act; bf16_t* OT; float scale;
    __device__ __forceinline__ const char* aptr(const Unit& u) const { const int h = u.pm >> 1, mh = u.pm & 1; return (const char*)(W + ((size_t)h * 512 + mh * 256) * 512); }
    __device__ __forceinline__ const char* bptr(const Unit& u) const { const int h = u.pm >> 1; return (const char*)(Act + (size_t)u.pn * 256 * ldb + h * 512); }
    __device__ __forceinline__ void epi(const f32x4 (&acc)[2][2][4][2], const Unit& u, int wr, int wc, int fr, int fq) const {
        const int h = u.pm >> 1, mh = u.pm & 1, bl = u.pn / 9, w = u.pn % 9;
        store_bf16_tile(acc, OT + ((size_t)(bl * 4 + h) * 512 + mh * 256) * TT + w * 256, (size_t)TT, scale, wr, wc, fr, fq);
    }
};
struct PhQK {
    static constexpr bool PERM = false; static constexpr int TAILC = 0;
    int K, lda, ldb, nM, nN, coff; const bf16_t* QKV; float* QKR;
    __device__ __forceinline__ const char* aptr(const Unit& u) const { const int bl = u.pm / 36, h = (u.pm / 9) & 3, w = u.pm % 9; return (const char*)(QKV + (size_t)(bl * TT + w * 256) * 6144 + h * 512); }
    __device__ __forceinline__ const char* bptr(const Unit& u) const { const int bl = u.pm / 36, h = (u.pm / 9) & 3, w = u.pm % 9; return (const char*)(QKV + (size_t)(bl * TT + w * 256) * 6144 + 2048 + h * 512); }
    __device__ __forceinline__ void epi(const f32x4 (&acc)[2][2][4][2], const Unit& u, int wr, int wc, int fr, int fq) const {
        if (wr != (wc >> 1)) return;
        const int bl = u.pm / 36, h = (u.pm / 9) & 3, w = u.pm % 9;
        float* base = QKR + ((size_t)(bl * 4 + h) * TT + w * 256 + wr * 64 + fr) * 64 + 32 * (wc & 1) + 4 * fq;
#pragma unroll
        for (int ai = 0; ai < 2; ++ai)
#pragma unroll
            for (int m = 0; m < 4; ++m)
#pragma unroll
                for (int n = 0; n < 2; ++n) *(f32x4*)(base + (size_t)(ai * 128 + m * 16) * 64 + n * 16) = acc[ai][ai][m][n];
    }
};
struct PhGates {
    static constexpr bool PERM = false; static constexpr int TAILC = 0;
    int K, lda, ldb, nM, nN, coff; const bf16_t* A; const bf16_t* WG; float* GATESP; int poff;
    __device__ __forceinline__ const char* aptr(const Unit& u) const { return (const char*)(A + (size_t)u.pm * 256 * lda + u.pn * 512); }
    __device__ __forceinline__ const char* bptr(const Unit& u) const { return (const char*)(WG + u.pn * 512); }
    __device__ __forceinline__ void epi(const f32x4 (&acc)[2][2][4][2], const Unit& u, int wr, int wc, int fr, int fq) const {
        if (wc != 0) return;
        float* base = GATESP + (size_t)(poff + u.pn) * RG * 16 + (size_t)(u.pm * 256 + wr * 64 + fr) * 16 + 4 * fq;
#pragma unroll
        for (int ai = 0; ai < 2; ++ai)
#pragma unroll
            for (int m = 0; m < 4; ++m) *(f32x4*)(base + (size_t)(ai * 128 + m * 16) * 16) = acc[ai][0][m][0];
    }
};
struct PhResid {
    static constexpr bool PERM = false; static constexpr int TAILC = 0;
    int K, lda, ldb, nM, nN, coff; const bf16_t *A, *B; const float *xin_x, *xin_c; float *xout_x, *xout_c; const float* mod  ; int g;
    __device__ __forceinline__ const char* aptr(const Unit& u) const { return (const char*)(A + (size_t)u.pm * 256 * lda); }
    __device__ __forceinline__ const char* bptr(const Unit& u) const { return (const char*)(B + (size_t)u.pn * 256 * ldb); }
    __device__ __forceinline__ void epi(const f32x4 (&acc)[2][2][4][2], const Unit& u, int wr, int wc, int fr, int fq) const {
        const int bl = u.pm / 9, w = u.pm % 9, b = g * GB + bl;
        const float* xin; float* xout; size_t rbase; int v;
        if (w == 0) { rbase = (size_t)b * CTXL; xin = xin_c; xout = xout_c; v = 16; } else { rbase = (size_t)b * SEQ + (w - 1) * 256; xin = xin_x; xout = xout_x; v = b; }
        const int col0 = u.pn * 256 + wc * 32 + 4 * fq;
        const float* gate = mod + (size_t)v * 3072 + 2048 + col0;
        f32x4 gv[2][2];
#pragma unroll
        for (int bj = 0; bj < 2; ++bj)
#pragma unroll
            for (int n = 0; n < 2; ++n) gv[bj][n] = *(const f32x4*)(gate + bj * HALF + n * 16);
#pragma unroll
        for (int ai = 0; ai < 2; ++ai)
#pragma unroll
            for (int m = 0; m < 4; ++m) { const size_t off = (rbase + wr * 64 + fr + ai * HALF + m * 16) * DM + col0;
#pragma unroll
                for (int bj = 0; bj < 2; ++bj)
#pragma unroll
                    for (int n = 0; n < 2; ++n) { const f32x4 xv = *(const f32x4*)(xin + off + bj * HALF + n * 16);
                        *(f32x4*)(xout + off + bj * HALF + n * 16) = xv + gv[bj][n] * acc[ai][bj][m][n]; } }
    }
};

__device__ __forceinline__ int convin_dst_row(int ns) { const int g = ns >> 11, rem = ns & 2047, pn = rem >> 6, jc = rem & 63;
    return 256 * pn + 128 * (g >> 1) + 32 * (jc >> 4) + 8 * ((jc >> 2) & 3) + 4 * (g & 1) + (jc & 3); }
__device__ __forceinline__ void transpose_item(const float* W, int K, int N, bf16_t* WT, LAS float* scr, int item, int lane, bool perm = false) {
    const int nblk = N / 32, kb = item / nblk, nb = item % nblk, k0 = 64 * kb, n0 = 32 * nb;
    float tv[32];
#pragma unroll
    for (int i = 0; i < 32; ++i) { const int kk = 2 * i + (lane >> 5); tv[i] = W[(size_t)(k0 + kk) * N + n0 + (lane & 31)]; }
#pragma unroll
    for (int i = 0; i < 32; ++i) { const int kk = 2 * i + (lane >> 5); scr[kk * 33 + (lane & 31)] = tv[i]; }
    LDS_WAIT();
    const int c = lane & 7;
#pragma unroll
    for (int j = 0; j < 4; ++j) { const int n = (lane >> 3) + 8 * j; const LAS float* s = scr + (8 * c) * 33 + n;
        u32x4 o; o.x = cvt_pk_bf16(s[0 * 33], s[1 * 33]); o.y = cvt_pk_bf16(s[2 * 33], s[3 * 33]); o.z = cvt_pk_bf16(s[4 * 33], s[5 * 33]); o.w = cvt_pk_bf16(s[6 * 33], s[7 * 33]);
        *(u32x4*)(WT + (size_t)(perm ? convin_dst_row(n0 + n) : (n0 + n)) * K + k0 + 8 * c) = o; }
    LDS_WAIT();
}
__device__ __forceinline__ void phase_prep(LAS unsigned char* lds, int wv) {
    const Params P = load_params();
    const int tid = opaque_tid(wv), lane = tid & 63, wave = tid >> 6;
    unsigned char* ws = opq(P.ws);
    float* MODP = (float*)(ws + WS_MODP);
    for (int item = blockIdx.x; item < 192; item += gridDim.x) {
        const int i = item / 48, rem = item % 48, ks = rem / 6, nb = rem % 6;
        LAS float* sc = (LAS float*)lds;
        for (int idx = tid; idx < 17 * 128; idx += 512) { const int v = idx >> 7, k = idx & 127; const float cv = (v < 16) ? P.c[v * DM + ks * 128 + k] : P.c_ctx[ks * 128 + k]; sc[idx] = silu_f(cv); }
        __syncthreads();
        const int n = nb * 512 + tid;
        float a[17];
#pragma unroll
        for (int v = 0; v < 17; ++v) a[v] = 0.f;
        const float* wp = P.mod_w + ((size_t)i * DM + ks * 128) * 3072 + n;
        for (int k0 = 0; k0 < 128; k0 += 16) {
            float wv[16];
#pragma unroll
            for (int u = 0; u < 16; ++u) wv[u] = wp[(size_t)(k0 + u) * 3072];
#pragma unroll
            for (int u = 0; u < 16; ++u)
#pragma unroll
                for (int v = 0; v < 17; ++v) a[v] += sc[v * 128 + k0 + u] * wv[u]; }
#pragma unroll
        for (int v = 0; v < 17; ++v) MODP[((size_t)(ks * 4 + i) * 17 + v) * 3072 + n] = a[v];
        __syncthreads();
    }
    LAS float* scr = (LAS float*)(lds + 16384 + wave * 8448);
    const int gw = blockIdx.x * 8 + wave, NGW = gridDim.x * 8;
    constexpr int PERJ = 4096 + 1024 + 3072 + 12 * 128 + 1024;
    for (int it = gw; it < 2 * PERJ; it += NGW) {
        const int j = it / PERJ; int r = it % PERJ;
        if (r < 4096) { transpose_item(P.conv_w_in + (size_t)j * DM * 8192, DM, 8192, (bf16_t*)(ws + WS_CWIN) + (size_t)j * 8192 * DM, scr, r, lane, true); continue; } r -= 4096;
        if (r < 1024) { transpose_item(P.conv_w_out + (size_t)j * DI * DM, DI, DM, (bf16_t*)(ws + WS_CWOUT) + (size_t)j * DM * DI, scr, r, lane); continue; } r -= 1024;
        if (r < 3072) { transpose_item(P.m_w_in + (size_t)j * DM * 6144, DM, 6144, (bf16_t*)(ws + WS_MWIN) + (size_t)j * 6144 * DM, scr, r, lane); continue; } r -= 3072;
        if (r < 1536) { const int wh = r / 128, which = wh >> 2, h = wh & 3; const float* src = (which == 0 ? P.m_wq : (which == 1 ? P.m_wk : P.m_wv)) + (size_t)(j * 4 + h) * DH * DH;
            transpose_item(src, DH, DH, (bf16_t*)(ws + WS_MWQKV) + ((size_t)(j * 3 + which) * 4 + h) * DH * DH, scr, r % 128, lane); continue; } r -= 1536;
        transpose_item(P.m_w_out + (size_t)j * DI * DM, DI, DM, (bf16_t*)(ws + WS_MWOUT) + (size_t)j * DM * DI, scr, r, lane);
    }
    bf16_t* MWG2 = (bf16_t*)(ws + WS_MWG);
    for (int item = gw; item < 2 * 2 * 2048; item += NGW) {
        const int j = item >> 12, part = (item >> 11) & 1, kg = item & 2047, h = kg >> 9, d = kg & 511;
        float acc[16];
#pragma unroll
        for (int n = 0; n < 16; ++n) acc[n] = 0.f;
        for (int pass = 0; pass < (part == 0 ? 2 : 1); ++pass) {
            const int which = part == 0 ? pass : 2; const float scl = which == 1 ? 0.044194173824159216f : 1.f;
            const float* wrow = (which == 0 ? P.m_wq : (which == 1 ? P.m_wk : P.m_wv)) + ((size_t)(j * 4 + h) * DH + d) * DH;
            const float* wgp = P.m_w_gate + ((size_t)j * 6144 + which * 2048 + h * 512) * 16;
#pragma unroll
            for (int q = 0; q < 8; ++q) { const int e = lane + 64 * q; const float wvv = wrow[e] * scl;
                const f32x4 g0 = *(const f32x4*)(wgp + (size_t)e * 16), g1 = *(const f32x4*)(wgp + (size_t)e * 16 + 4), g2 = *(const f32x4*)(wgp + (size_t)e * 16 + 8), g3 = *(const f32x4*)(wgp + (size_t)e * 16 + 12);
#pragma unroll
                for (int i = 0; i < 4; ++i) { acc[i] += wvv * g0[i]; acc[4 + i] += wvv * g1[i]; acc[8 + i] += wvv * g2[i]; acc[12 + i] += wvv * g3[i]; } }
        }
        float mine = 0.f;
#pragma unroll
        for (int n = 0; n < 16; ++n) { const float t = wave_sum(acc[n], lane); mine = (lane == n) ? t : mine; }
        if (lane < 16) MWG2[((size_t)(j * 2 + part) * 256 + lane) * 2048 + kg] = (bf16_t)(cvt_pk_bf16(mine, 0.f) & 0xffffu);
    }
    for (size_t idx = (size_t)blockIdx.x * 512 + tid; idx < (size_t)4 * 240 * 2048; idx += (size_t)gridDim.x * 512) {
        const int m4 = (int)(idx / (240 * 2048)); const int rem = (int)(idx % (240 * 2048));
        MWG2[((size_t)m4 * 256 + 16) * 2048 + rem] = (bf16_t)0;
    }
    __syncthreads();
}
__device__ __forceinline__ void phase_modreduce(int wv) {
    const Params P = load_params();
    unsigned char* ws = opq(P.ws);
    const float* MODP = (const float*)(ws + WS_MODP); float* MOD = (float*)(ws + WS_MOD);
    for (int idx = blockIdx.x * 512 + opaque_tid(wv); idx < 4 * 17 * 3072; idx += gridDim.x * 512) {
        const int i = idx / (17 * 3072), n = idx % 3072;
        float s = P.mod_b[i * 3072 + n];
#pragma unroll
        for (int ks = 0; ks < 8; ++ks) s += MODP[(size_t)ks * 4 * 17 * 3072 + idx];
        MOD[idx] = s;
    }
}

__device__ __forceinline__ void phase_modulate(int layer, int g, int buf, bool light, int wv) {
    if (light && blockIdx.x < 160) return;
    const Params P = load_params();
    const float* xin_x = (layer == 0) ? P.x : P.out; const float* xin_c = (layer == 0) ? P.ctx : (const float*)(P.ws + WS_XC);
    const int tid = opaque_tid(wv), lane = tid & 63, gw = (light ? (int)blockIdx.x - 160 : (int)blockIdx.x) * 8 + (tid >> 6), NGW = (light ? 96 : (int)gridDim.x) * 8;
    unsigned char* ws = opq(P.ws); xin_x = opq(xin_x); xin_c = opq(xin_c);
    bf16_t* HX = (bf16_t*)(ws + (buf ? WS_HX2 : WS_HX)); const float* MOD = (const float*)(ws + WS_MOD) + (size_t)layer * 17 * 3072;
    const float* ng = opq(P.norm_g) + layer * DM;
    for (int r = gw; r < RG; r += NGW) {
        const int bl = r / TT, tt = r % TT, b = g * GB + bl;
        const float* xr; int v;
        if (tt < CTXL) { xr = xin_c + ((size_t)b * CTXL + tt) * DM; v = 16; } else { xr = xin_x + ((size_t)b * SEQ + (tt - CTXL)) * DM; v = b; }
        const float* md = MOD + (size_t)v * 3072;
        f32x4 xv[4]; float ss = 0.f;
#pragma unroll
        for (int q = 0; q < 4; ++q) { xv[q] = *(const f32x4*)(xr + 4 * lane + 256 * q); ss += (xv[q][0] * xv[q][0] + xv[q][1] * xv[q][1]) + (xv[q][2] * xv[q][2] + xv[q][3] * xv[q][3]); }
        const float rstd = rsqrtf(wave_sum(ss, lane) * (1.f / DM) + EPSV);
#pragma unroll
        for (int q = 0; q < 4; ++q) { const int c0 = 4 * lane + 256 * q;
            const f32x4 gv = *(const f32x4*)(ng + c0), sh = *(const f32x4*)(md + c0), sc = *(const f32x4*)(md + 1024 + c0);
            const f32x4 y = xv[q] * rstd * gv * (sc + 1.f) + sh;
            u32x2 o; o.x = cvt_pk_bf16(y[0], y[1]); o.y = cvt_pk_bf16(y[2], y[3]);
            *(u32x2*)(HX + (size_t)r * DM + c0) = o; }
    }
}
__device__ __forceinline__ void conv_valid(int r, bool& pv, bool& nv) {
    const int tt = r % TT;
    if (tt < CTXL) { pv = tt != 0; nv = tt != CTXL - 1; } else { pv = (tt & 63) != 0; nv = (tt & 63) != 63; }
}
__device__ __forceinline__ void phase_convmix(int j, int g, int wv) {
    const Params P = load_params();
    unsigned char* ws = opq(P.ws);
    const bf16_t* BIG = (const bf16_t*)(ws + WS_BIG); bf16_t* Y = (bf16_t*)(ws + ((g & 1) ? WS_KT : WS_VT));
    const float* cw = opq(P.conv_w) + (size_t)j * 3 * DI;
    for (int it = blockIdx.x * 512 + opaque_tid(wv); it < GB * CTXL * 256; it += gridDim.x * 512) {
        const int rc = it >> 8, r = (rc >> 8) * TT + (rc & 255), c8 = (it & 255) * 8; bool pv, nv; conv_valid(r, pv, nv);
        const bf16_t* row = BIG + (size_t)r * 8192 + c8;
        float bb[8], cc[8], uu[8], zz[8], cp[8], up[8], cn[8], un[8];
        unpack8(*(const u32x4*)(row), bb); unpack8(*(const u32x4*)(row + 2048), cc); unpack8(*(const u32x4*)(row + 4096), uu); unpack8(*(const u32x4*)(row + 6144), zz);
        const u32x4 z4 = (u32x4){0u, 0u, 0u, 0u};
        unpack8(pv ? *(const u32x4*)(row - 8192 + 2048) : z4, cp); unpack8(pv ? *(const u32x4*)(row - 8192 + 4096) : z4, up);
        unpack8(nv ? *(const u32x4*)(row + 8192 + 2048) : z4, cn); unpack8(nv ? *(const u32x4*)(row + 8192 + 4096) : z4, un);
        float w0[8], w1[8], w2[8], y[8];
        *(f32x4*)(w0) = *(const f32x4*)(cw + c8); *(f32x4*)(w0 + 4) = *(const f32x4*)(cw + c8 + 4);
        *(f32x4*)(w1) = *(const f32x4*)(cw + DI + c8); *(f32x4*)(w1 + 4) = *(const f32x4*)(cw + DI + c8 + 4);
        *(f32x4*)(w2) = *(const f32x4*)(cw + 2 * DI + c8); *(f32x4*)(w2 + 4) = *(const f32x4*)(cw + 2 * DI + c8 + 4);
#pragma unroll
        for (int e = 0; e < 8; ++e) { const float s = w0[e] * (cp[e] * up[e]) + w1[e] * (cc[e] * uu[e]) + w2[e] * (cn[e] * un[e]); y[e] = bb[e] * s * silu_f(zz[e]); }
        *(u32x4*)(Y + (size_t)r * DI + c8) = pack8(y);
    }
}
__device__ __forceinline__ void phase_uc(int j, int wv) {
    const Params P = load_params();
    unsigned char* ws = opq(P.ws);
    const bf16_t* UZO = (const bf16_t*)(ws + WS_BIG); bf16_t* UC = (bf16_t*)(ws + WS_UC);
    const float* cw = opq(P.m_conv_w) + (size_t)j * 3 * DI;
    for (int it = blockIdx.x * 512 + opaque_tid(wv); it < RG * 256; it += gridDim.x * 512) {
        const int r = it >> 8, c8 = (it & 255) * 8; bool pv, nv; conv_valid(r, pv, nv);
        const bf16_t* row = UZO + (size_t)r * 6144 + c8;
        float uu[8], up[8], un[8], y[8];
        const u32x4 z4 = (u32x4){0u, 0u, 0u, 0u};
        unpack8(*(const u32x4*)(row), uu);
        unpack8(pv ? *(const u32x4*)(row - 6144) : z4, up);
        unpack8(nv ? *(const u32x4*)(row + 6144) : z4, un);
        float w0[8], w1[8], w2[8];
        *(f32x4*)(w0) = *(const f32x4*)(cw + c8); *(f32x4*)(w0 + 4) = *(const f32x4*)(cw + c8 + 4);
        *(f32x4*)(w1) = *(const f32x4*)(cw + DI + c8); *(f32x4*)(w1 + 4) = *(const f32x4*)(cw + DI + c8 + 4);
        *(f32x4*)(w2) = *(const f32x4*)(cw + 2 * DI + c8); *(f32x4*)(w2 + 4) = *(const f32x4*)(cw + 2 * DI + c8 + 4);
#pragma unroll
        for (int e = 0; e < 8; ++e) { const float s = w0[e] * up[e] + w1[e] * uu[e] + w2[e] * un[e]; y[e] = silu_f(s); }
        *(u32x4*)(UC + (size_t)r * DI + c8) = pack8(y);
    }
}
__device__ __forceinline__ void phase_gating(int j, int wv) {
    const Params P = load_params();
    const int tid = opaque_tid(wv), lane = tid & 63, gw = blockIdx.x * 8 + (tid >> 6), NGW = gridDim.x * 8;
    unsigned char* ws = opq(P.ws); const float* mng = opq(P.m_norm_g) + (size_t)j * DI; const float* msk = opq(P.m_skip) + (size_t)j * DI;
    const bf16_t* QKV = (const bf16_t*)(ws + WS_QKV); const bf16_t* UZO = (const bf16_t*)(ws + WS_BIG); const bf16_t* UC = (const bf16_t*)(ws + WS_UC);
    bf16_t* Y = (bf16_t*)(ws + WS_KT);
    u32x4 nhf, nhb, nzz, noo, nuc;
#define GATE_LOAD(IT) { const int r_ = (IT) >> 2, c_ = ((IT) & 3) * 512 + 8 * lane; \
        nhf = *(const u32x4*)(QKV + (size_t)r_ * 6144 + 2048 + c_); nhb = *(const u32x4*)(QKV + (size_t)r_ * 6144 + 4096 + c_); \
        nzz = *(const u32x4*)(UZO + (size_t)r_ * 6144 + 2048 + c_); noo = *(const u32x4*)(UZO + (size_t)r_ * 6144 + 4096 + c_); nuc = *(const u32x4*)(UC + (size_t)r_ * DI + c_); }
    if (gw < RG * 4) GATE_LOAD(gw)
    for (int it = gw; it < RG * 4; it += NGW) {
        const int r = it >> 2, h = it & 3, c0 = h * 512 + 8 * lane;
        float hf[8], hb[8], zz[8], oo[8], uc[8], y[8];
        unpack8(nhf, hf); unpack8(nhb, hb); unpack8(nzz, zz); unpack8(noo, oo); unpack8(nuc, uc);
        { const int itn = (it + NGW < RG * 4) ? it + NGW : it; GATE_LOAD(itn) }
        float s = 0.f;
#pragma unroll
        for (int e = 0; e < 8; ++e) { hf[e] += hb[e]; s += hf[e]; }
        const float mean = wave_sum(s, lane) * (1.f / DH); float s2 = 0.f;
#pragma unroll
        for (int e = 0; e < 8; ++e) { hf[e] -= mean; s2 += hf[e] * hf[e]; }
        const float rstd = rsqrtf(wave_sum(s2, lane) * (1.f / DH) + EPSV);
        float ng[8], sk[8];
        *(f32x4*)(ng) = *(const f32x4*)(mng + c0); *(f32x4*)(ng + 4) = *(const f32x4*)(mng + c0 + 4);
        *(f32x4*)(sk) = *(const f32x4*)(msk + c0); *(f32x4*)(sk + 4) = *(const f32x4*)(msk + c0 + 4);
#pragma unroll
        for (int e = 0; e < 8; ++e) y[e] = (sigmoid_f(oo[e]) * (hf[e] * rstd * ng[e]) + sk[e] * uc[e]) * silu_f(zz[e]);
        *(u32x4*)(Y + (size_t)r * DI + c0) = pack8(y);
    }
#undef GATE_LOAD
}
__device__ __forceinline__ void phase_final(int r0, int r1, bool light, int wv) {
    if (light && blockIdx.x < 144) return;
    const Params P = load_params();
    const int tid = opaque_tid(wv), lane = tid & 63, gw = (light ? (int)blockIdx.x - 144 : (int)blockIdx.x) * 8 + (tid >> 6), NGW = (light ? 112 : (int)gridDim.x) * 8;
    float* outp = opq(P.out); const float* fg = opq(P.final_g);
    for (int r = r0 + gw; r < r1; r += NGW) {
        float* xr = outp + (size_t)r * DM;
        f32x4 xv[4]; float ss = 0.f;
#pragma unroll
        for (int q = 0; q < 4; ++q) { xv[q] = *(const f32x4*)(xr + 4 * lane + 256 * q); ss += (xv[q][0] * xv[q][0] + xv[q][1] * xv[q][1]) + (xv[q][2] * xv[q][2] + xv[q][3] * xv[q][3]); }
        const float rstd = rsqrtf(wave_sum(ss, lane) * (1.f / DM) + EPSV);
#pragma unroll
        for (int q = 0; q < 4; ++q) { const f32x4 gv = *(const f32x4*)(fg + 4 * lane + 256 * q); *(f32x4*)(xr + 4 * lane + 256 * q) = xv[q] * rstd * gv; }
    }
}

constexpr int SC_R = 0, SC_V = 81920, SC_VW = 91136, SC_TAB = 100352;
__device__ __forceinline__ bf16x8 mk_frag(unsigned a, unsigned b, unsigned c, unsigned d) { u32x4 t; t.x = a; t.y = b; t.z = c; t.w = d; return __builtin_bit_cast(bf16x8, t); }
__device__ __forceinline__ void phase_scan(LAS unsigned char* lds, int j, int wv) {
    const Params P = load_params();
    const int tid = opaque_tid(wv);
    const int lane = tid & 63, w = __builtin_amdgcn_readfirstlane(tid >> 6), lr = lane & 15, lq = lane >> 4;
    const unsigned qoff = (unsigned)(lr * 6144 + 64 * w + 4 * lq) * 2u;
    const unsigned koff = (unsigned)((64 * w + lr) * TT + 8 * lq) * 2u;
    const unsigned hoff = (unsigned)((4 * lq) * 6144 + lr) * 2u;
    unsigned char* ws = opq(P.ws);
    bf16_t* QKV = (bf16_t*)(ws + WS_QKV); const bf16_t* KT = (const bf16_t*)(ws + WS_KT); const bf16_t* VT = (const bf16_t*)(ws + WS_VT);
    const float* QKR = (const float*)(ws + WS_QKR); const float* GATES = (const float*)(ws + WS_GATESP);
    LAS f32x4* R = (LAS f32x4*)(lds + SC_R);
    LAS bf16_t* sV = (LAS bf16_t*)(lds + SC_V); LAS bf16_t* sVW = (LAS bf16_t*)(lds + SC_VW);
    LAS u32x4* sS = (LAS u32x4*)(lds + 131072);
    LAS float* tA = (LAS float*)(lds + 102400); LAS float* tPM = tA + TT; LAS float* tBC = tA + 2 * TT;
    LAS float* cMP = (LAS float*)(lds + 102400 + 3 * TT * 4); LAS float* cM63 = cMP + 36; LAS float* cBL = cMP + 72; LAS float* cAM = cMP + 108;
    LAS float* tabA = (LAS float*)(lds + SC_TAB); LAS float* tabM = tabA + 64; LAS float* tabWI = tabA + 128; LAS float* tabFL = tabA + 192; LAS float* tabWS = tabA + 256; LAS float* scal = tabA + 320;
    for (int uid = blockIdx.x; uid < GB * NH * 2 * 8; uid += gridDim.x) {
        const int xcd_ = uid & 7, yy_ = uid >> 3, pair_ = xcd_ * 2 + (yy_ >> 4);
        const int es = yy_ & 7, dir = (yy_ >> 3) & 1, h = pair_ & 3, bl = pair_ >> 2;
        const bf16_t* qb = QKV + (size_t)(bl * TT) * 6144 + h * 512;
        const bf16_t* kTb = KT + (size_t)((bl * 4 + h) * 512) * TT;
        const bf16_t* vTb = VT + (size_t)((bl * 4 + h) * 512 + es * 64) * TT;
        const float* qkr = QKR + (size_t)((bl * 4 + h) * TT) * 64;
        const float* gt = GATES + (size_t)(bl * TT) * 16 + h + (dir ? 8 : 0);
        bf16_t* hout = QKV + (size_t)(bl * TT) * 6144 + (dir ? 4096 : 2048) + h * 512 + es * 64;
        f32x4 C[4][5];
#pragma unroll
        for (int a = 0; a < 4; ++a)
#pragma unroll
            for (int b = 0; b < 5; ++b) C[a][b] = (f32x4){0.f, 0.f, 0.f, 0.f};
        {
            const float bi_ = P.m_b_gate[j * 16 + (dir ? 8 : 0) + h], bf_ = P.m_b_gate[j * 16 + (dir ? 8 : 0) + 4 + h];
            for (int cc = w; cc < 36; cc += 8) { const int ac = dir ? (cc < 4 ? 3 - cc : 39 - cc) : cc, t = dir ? 63 - lane : lane, row = ac * 64 + t;
                const float* gp = gt + (size_t)row * 16; float si = bi_, sf = bf_;
#pragma unroll
                for (int ks_ = 0; ks_ < 8; ++ks_) { si += gp[(size_t)ks_ * RG * 16]; sf += gp[(size_t)ks_ * RG * 16 + 4]; }
                const float fp = sf; const float lf = fminf(fp, 0.f) - log1pf(__expf(-fabsf(fp)));
#define DPP_F(oldv, src, ctrl, rmask) __int_as_float(__builtin_amdgcn_update_dpp(__float_as_int(oldv), __float_as_int(src), ctrl, rmask, 0xf, false))
                float bc = lf;
                bc += DPP_F(0.f, bc, 0x111, 0xf); bc += DPP_F(0.f, bc, 0x112, 0xf); bc += DPP_F(0.f, bc, 0x114, 0xf); bc += DPP_F(0.f, bc, 0x118, 0xf);
                bc += DPP_F(0.f, bc, 0x142, 0xa); bc += DPP_F(0.f, bc, 0x143, 0xc);
                const float av = si - bc;
                const float ninf = -__builtin_inff();
                float pmx = av;
                pmx = fmaxf(pmx, DPP_F(ninf, pmx, 0x111, 0xf)); pmx = fmaxf(pmx, DPP_F(ninf, pmx, 0x112, 0xf)); pmx = fmaxf(pmx, DPP_F(ninf, pmx, 0x114, 0xf)); pmx = fmaxf(pmx, DPP_F(ninf, pmx, 0x118, 0xf));
                pmx = fmaxf(pmx, DPP_F(ninf, pmx, 0x142, 0xa)); pmx = fmaxf(pmx, DPP_F(ninf, pmx, 0x143, 0xc));
#undef DPP_F
                tA[row] = av; tPM[row] = pmx; tBC[row] = bc;
                if (lane == 63) { cBL[cc] = bc; cAM[cc] = pmx; } }
            __syncthreads();
            if (tid == 0) { float mp = 0.f; for (int cc = 0; cc < 36; ++cc) { cMP[cc] = mp; const float M63 = fmaxf(mp, cAM[cc]); cM63[cc] = M63; mp = cBL[cc] + M63; } }
            __syncthreads();
        }
        bf16x8 qa0[4], qa1[4];
#define SCAN_LOAD_Q0(T0) { _Pragma("unroll") for (int jt = 0; jt < 4; ++jt) { const char* p_ = (const char*)qb + (size_t)((T0) + 16 * jt) * 12288 + qoff; \
            const u32x2 lo_ = *(const u32x2*)p_, hi_ = *(const u32x2*)(p_ + 32); qa0[jt] = mk_frag(lo_.x, lo_.y, hi_.x, hi_.y); \
            const u32x2 lo2_ = *(const u32x2*)(p_ + 64), hi2_ = *(const u32x2*)(p_ + 96); qa1[jt] = mk_frag(lo2_.x, lo2_.y, hi2_.x, hi2_.y); } }
        SCAN_LOAD_Q0(dir ? 3 * 64 : 0)
        for (int cc = 0; cc < 36; ++cc) {
            const int ac = dir ? (cc < 4 ? 3 - cc : 39 - cc) : cc, t0 = ac * 64;
            const int ccn = cc < 35 ? cc + 1 : 35, acn = dir ? (ccn < 4 ? 3 - ccn : 39 - ccn) : ccn, t0n = acn * 64;
            if (w == 7) { const float mpc = cMP[cc], M63c = cM63[cc]; const float av_ = tA[t0 + lane], Mi_ = fmaxf(mpc, tPM[t0 + lane]);
                tabWS[lane] = __expf(av_ - M63c); tabWI[lane] = __expf(mpc - Mi_); tabFL[lane] = __expf(-(tBC[t0 + lane] + Mi_)); }
#define SCAN_PASS(E0, NE) { f32x4 Pt[4][NE]; \
                _Pragma("unroll") for (int ks = 0; ks < 2; ++ks) { \
                  _Pragma("unroll") for (int e = 0; e < NE; ++e) { const f32x4 c0 = C[2 * ks][E0 + e], c1 = C[2 * ks + 1][E0 + e]; \
                    const bf16x8 cb = mk_frag(cvt_pk_bf16(c0[0], c0[1]), cvt_pk_bf16(c0[2], c0[3]), cvt_pk_bf16(c1[0], c1[1]), cvt_pk_bf16(c1[2], c1[3])); \
                    _Pragma("unroll") for (int jt = 0; jt < 4; ++jt) Pt[jt][e] = __builtin_amdgcn_mfma_f32_16x16x32_bf16(ks == 0 ? qa0[jt] : qa1[jt], cb, ks == 0 ? (f32x4){0.f, 0.f, 0.f, 0.f} : Pt[jt][e], 0, 0, 0); } } \
                if (w >= 4) { _Pragma("unroll") for (int jt = 0; jt < 4; ++jt) _Pragma("unroll") for (int e = 0; e < NE; ++e) R[((w - 4) * 20 + jt * 5 + E0 + e) * 64 + lane] = Pt[jt][e]; } \
                __syncthreads(); \
                if (w < 4) { _Pragma("unroll") for (int jt = 0; jt < 4; ++jt) _Pragma("unroll") for (int e = 0; e < NE; ++e) { const int idx = (w * 20 + jt * 5 + E0 + e) * 64 + lane; const f32x4 sres = Pt[jt][e] + R[idx]; R[idx] = sres; } } }
            SCAN_PASS(0, 2)
            if (w >= 4) {
#pragma unroll
                for (int hlf = 0; hlf < 2; ++hlf) { const int it_ = (tid - 256) + 256 * hlf, ve = it_ >> 3, vs = (it_ & 7) * 8;
                    const u32x4 vraw = *(const u32x4*)(vTb + (size_t)ve * TT + t0 + vs);
                    float vf[8], wv[8]; unpack8(vraw, vf);
                    const f32x4 w0 = *(const LAS f32x4*)(tabWS + vs), w1 = *(const LAS f32x4*)(tabWS + vs + 4);
#pragma unroll
                    for (int e = 0; e < 4; ++e) { wv[e] = vf[e] * w0[e]; wv[4 + e] = vf[4 + e] * w1[e]; }
                    *(LAS u32x4*)(sV + ve * 72 + vs) = vraw;
                    *(LAS u32x4*)(sVW + ve * 72 + vs) = pack8(wv); }
            }
            SCAN_PASS(2, 3)
#undef SCAN_PASS
            if (w >= 4) {
                int jr = 16 * (w - 4) + lr; asm volatile("" : "+v"(jr));
                const float Mj = fmaxf(cMP[cc], tPM[t0 + jr]);
#pragma unroll
                for (int ks = 0; ks < 2; ++ks) { const int s0 = 32 * ks + 8 * lq; const float* qp = qkr + (size_t)(t0 + jr) * 64 + s0;
                    const f32x4 q0 = *(const f32x4*)qp, q1 = *(const f32x4*)(qp + 4);
                    const f32x4 a0 = *(const LAS f32x4*)(tA + t0 + s0), a1 = *(const LAS f32x4*)(tA + t0 + s0 + 4);
                    float sv[8];
#pragma unroll
                    for (int e = 0; e < 4; ++e) { const int sA = s0 + e, sB = s0 + 4 + e;
                        const bool vA = dir ? (sA >= jr) : (sA <= jr), vB = dir ? (sB >= jr) : (sB <= jr);
                        sv[e] = vA ? q0[e] * __expf(a0[e] - Mj) : 0.f; sv[4 + e] = vB ? q1[e] * __expf(a1[e] - Mj) : 0.f; }
                    sS[((w - 4) * 2 + ks) * 64 + lane] = pack8(sv); }
            }
            bf16x8 ka[4][2];
#pragma unroll
            for (int dt = 0; dt < 4; ++dt)
#pragma unroll
                for (int ks = 0; ks < 2; ++ks) ka[dt][ks] = *(const bf16x8*)((const char*)kTb + (size_t)(16 * dt * TT + t0 + 32 * ks) * 2 + koff);
            const int jt_f = w >> 1, eh = w & 1;
            __syncthreads();
            {
                const int jt = jt_f;
                bf16x8 sa[2];
#pragma unroll
                for (int ks = 0; ks < 2; ++ks) { const u32x4 pk = sS[(jt * 2 + ks) * 64 + lane]; sa[ks] = __builtin_bit_cast(bf16x8, pk); }
                const unsigned one2 = (lr == 0) ? 0x3F803F80u : 0u;
                const bf16x8 ones = mk_frag(one2, one2, one2, one2);
                const f32x4 wi = *(const LAS f32x4*)(tabWI + 16 * jt + 4 * lq), fl = *(const LAS f32x4*)(tabFL + 16 * jt + 4 * lq);
                f32x4 num[3];
#pragma unroll
                for (int x = 0; x < 3; ++x) { const int et = (x < 2) ? 2 * eh + x : 4, tile = jt * 5 + et;
                    const f32x4 inter = (R[(0 * 20 + tile) * 64 + lane] + R[(1 * 20 + tile) * 64 + lane]) + (R[(2 * 20 + tile) * 64 + lane] + R[(3 * 20 + tile) * 64 + lane]);
                    f32x4 it = (f32x4){0.f, 0.f, 0.f, 0.f};
#pragma unroll
                    for (int ks = 0; ks < 2; ++ks) { const bf16x8 vb = (x < 2) ? *(const LAS bf16x8*)(sV + (16 * et + lr) * 72 + 32 * ks + 8 * lq) : ones;
                        it = __builtin_amdgcn_mfma_f32_16x16x32_bf16(sa[ks], vb, it, 0, 0, 0); }
                    num[x] = wi * inter + it; }
                f32x4 den;
#pragma unroll
                for (int i = 0; i < 4; ++i) den[i] = fmaxf(fabsf(lane_read(num[2][i], lane & 48)), fl[i]);
#pragma unroll
                for (int x = 0; x < 2; ++x) { const int et = 2 * eh + x;
#pragma unroll
                    for (int i = 0; i < 4; ++i) { const float hv = num[x][i] * __builtin_amdgcn_rcpf(den[i]);
                        *(bf16_t*)((char*)hout + ((size_t)(t0 + 16 * jt + i) * 6144 + 16 * et) * 2 + hoff) = (bf16_t)(cvt_pk_bf16(hv, 0.f) & 0xffffu); } }
            }
            SCAN_LOAD_Q0(t0n)
            {
                const float wd = __expf(cMP[cc] - cM63[cc]);
#pragma unroll
                for (int dt = 0; dt < 4; ++dt)
#pragma unroll
                    for (int et = 0; et < 5; ++et) C[dt][et] = C[dt][et] * wd;
#pragma unroll
                for (int ks = 0; ks < 2; ++ks) {
#pragma unroll
                    for (int et = 0; et < 4; ++et) { const bf16x8 vwb = *(const LAS bf16x8*)(sVW + (16 * et + lr) * 72 + 32 * ks + 8 * lq);
#pragma unroll
                        for (int dt = 0; dt < 4; ++dt) C[dt][et] = __builtin_amdgcn_mfma_f32_16x16x32_bf16(ka[dt][ks], vwb, C[dt][et], 0, 0, 0); }
                    const f32x4 w0 = *(const LAS f32x4*)(tabWS + 32 * ks + 8 * lq), w1 = *(const LAS f32x4*)(tabWS + 32 * ks + 8 * lq + 4);
                    u32x4 wp; wp.x = cvt_pk_bf16(w0[0], w0[1]); wp.y = cvt_pk_bf16(w0[2], w0[3]); wp.z = cvt_pk_bf16(w1[0], w1[1]); wp.w = cvt_pk_bf16(w1[2], w1[3]);
                    if (lr != 0) { wp.x = 0u; wp.y = 0u; wp.z = 0u; wp.w = 0u; }
                    const bf16x8 wb = __builtin_bit_cast(bf16x8, wp);
#pragma unroll
                    for (int dt = 0; dt < 4; ++dt) C[dt][4] = __builtin_amdgcn_mfma_f32_16x16x32_bf16(ka[dt][ks], wb, C[dt][4], 0, 0, 0);
                }
            }
            __syncthreads();
        }
    }
}

__device__ __forceinline__ void run_in_gemm(LAS unsigned char* lds, int j, bool conv, int coff, int g, int buf, int wv) {
    const Params P = load_params(); unsigned char* ws = P.ws;
    if (conv) {
        PhConvFused ph; ph.K = DM; ph.lda = DM; ph.ldb = DM; ph.nM = MT; ph.nN = 32; ph.coff = coff; ph.A = (const bf16_t*)(ws + (buf ? WS_HX2 : WS_HX)); ph.B = (const bf16_t*)(ws + WS_CWIN) + (size_t)j * 8192 * DM;
        ph.BIG = (bf16_t*)(ws + WS_BIG); ph.Y = (bf16_t*)(ws + ((g & 1) ? WS_KT : WS_VT)); ph.cw = P.conv_w + (size_t)j * 3 * DI;
        gemm_phase(lds, ph, wv);
    } else {
        PhPlain ph; ph.K = DM; ph.lda = DM; ph.ldb = DM; ph.nM = MT; ph.coff = coff; ph.A = (const bf16_t*)(ws + (buf ? WS_HX2 : WS_HX)); ph.O = (bf16_t*)(ws + WS_BIG);
        ph.nN = 24; ph.B = (const bf16_t*)(ws + WS_MWIN) + (size_t)j * 6144 * DM; ph.ldc = 6144;
        gemm_phase(lds, ph, wv);
    }
}
__device__ __forceinline__ void run_out_gemm(LAS unsigned char* lds, int layer, int g, int wv) {
    const Params P = load_params(); unsigned char* ws = P.ws; const int j = layer >> 1;
    PhResid ph; ph.K = DI; ph.lda = DI; ph.ldb = DI; ph.nM = MT; ph.nN = 4; ph.coff = 0; ph.A = (const bf16_t*)(ws + (((layer & 1) || (g & 1)) ? WS_KT : WS_VT));
    ph.B = ((layer & 1) ? (const bf16_t*)(ws + WS_MWOUT) : (const bf16_t*)(ws + WS_CWOUT)) + (size_t)j * DM * DI;
    ph.xin_x = (layer == 0) ? P.x : P.out; ph.xin_c = (layer == 0) ? P.ctx : (const float*)(ws + WS_XC); ph.xout_x = P.out; ph.xout_c = (float*)(ws + WS_XC);
    ph.mod = (const float*)(ws + WS_MOD) + (size_t)layer * 17 * 3072; ph.g = g;
    gemm_phase(lds, ph, wv);
}
__device__ __forceinline__ void run_qkv_nat(LAS unsigned char* lds, int j, bool isv, int wv) {
    const Params P = load_params(); unsigned char* ws = P.ws;
    PhQKV ph; ph.K = DH; ph.ldb = DH; ph.nM = MT; ph.W = (const bf16_t*)(ws + WS_MWQKV) + (size_t)j * 3 * 4 * DH * DH; ph.O = (bf16_t*)(ws + WS_QKV);
    if (!isv) { ph.lda = DI; ph.nN = 16; ph.coff = 0; ph.A = (const bf16_t*)(ws + WS_UC); ph.which0 = 0; }
    else { ph.lda = 6144; ph.nN = 8; ph.coff = 256 - 64; ph.A = (const bf16_t*)(ws + WS_BIG); ph.which0 = 2; }
    gemm_phase(lds, ph, wv);
}
__device__ __forceinline__ void run_tr(LAS unsigned char* lds, int j, bool isv, int wv) {
    const Params P = load_params(); unsigned char* ws = P.ws;
    PhTr ph; ph.K = DH; ph.lda = DH; ph.nM = 8; ph.nN = MT;
    const bf16_t* WQKV = (const bf16_t*)(ws + WS_MWQKV) + (size_t)j * 3 * 4 * DH * DH;
    if (!isv) { ph.ldb = DI; ph.coff = 192; ph.W = WQKV + (size_t)1 * 4 * DH * DH; ph.Act = (const bf16_t*)(ws + WS_UC); ph.OT = (bf16_t*)(ws + WS_KT); ph.scale = 0.044194173824159216f; }
    else { ph.ldb = 6144; ph.coff = 160; ph.W = WQKV + (size_t)2 * 4 * DH * DH; ph.Act = (const bf16_t*)(ws + WS_BIG); ph.OT = (bf16_t*)(ws + WS_VT); ph.scale = 1.f; }
    gemm_phase(lds, ph, wv);
}
__device__ __forceinline__ void run_qk(LAS unsigned char* lds, int wv) {
    const Params P = load_params(); unsigned char* ws = P.ws;
    PhQK ph; ph.K = DH; ph.lda = 6144; ph.ldb = 6144; ph.nM = GB * NH * 9; ph.nN = 1; ph.coff = 0; ph.QKV = (const bf16_t*)(ws + WS_QKV); ph.QKR = (float*)(ws + WS_QKR);
    gemm_phase(lds, ph, wv);
}
__device__ __forceinline__ void run_gates(LAS unsigned char* lds, int j, int part, int wv) {
    const Params P = load_params(); unsigned char* ws = P.ws;
    PhGates ph; ph.K = 512; ph.ldb = 2048; ph.nM = MT; ph.nN = 4; ph.poff = 4 * part;
    if (part == 0) { ph.A = (const bf16_t*)(ws + WS_UC); ph.lda = DI; ph.coff = 128; } else { ph.A = (const bf16_t*)(ws + WS_BIG); ph.lda = 6144; ph.coff = 144; }
    ph.WG = (const bf16_t*)(ws + WS_MWG) + (size_t)(j * 2 + part) * 256 * 2048; ph.GATESP = (float*)(ws + WS_GATESP);
    gemm_phase(lds, ph, wv);
}

#define XB_TMO      128
#define XB_XCNT(j)  (256  + 64 * (j))
#define XB_XSUB(j)  (1280 + 64 * (j))
#define XB_XGEN(j)  (2304 + 64 * (j))
#define XB_TOP      3328
#define XB_TOPGEN   3392
#define XCD_BAR_WORDS 3456
#define XB_SPIN_CAP (1u << 22)
__device__ __forceinline__ unsigned xb_ld(unsigned* p)              { return __hip_atomic_load(p, __ATOMIC_RELAXED, __HIP_MEMORY_SCOPE_AGENT); }
__device__ __forceinline__ unsigned xb_add(unsigned* p, unsigned v) { return __hip_atomic_fetch_add(p, v, __ATOMIC_RELAXED, __HIP_MEMORY_SCOPE_AGENT); }
__device__ __forceinline__ unsigned xb_xcc_id() { return (unsigned)__builtin_amdgcn_s_getreg((3 << 11) | 20) & 0xFu; }
#define XB_SPIN(cond, bar) do { unsigned _sp = 0; while (cond) { __builtin_amdgcn_s_sleep(1); \
    if ((++_sp & 255u) == 0u) { if (xb_ld(&(bar)[XB_TMO])) break; if (_sp > XB_SPIN_CAP) { atomicAdd(&(bar)[XB_TMO], 1u); break; } } } } while (0)
struct XcdBarrier { unsigned* bar; unsigned x; volatile LAS unsigned* st; };
__device__ __forceinline__ XcdBarrier xcd_barrier_post(unsigned* bar, volatile LAS unsigned* st) {
    XcdBarrier b; b.bar = bar; b.x = xb_xcc_id(); b.st = st;
    if (threadIdx.x == 0) (void)xb_add(&bar[XB_XCNT(b.x)], 1u);
    return b;
}
__device__ __forceinline__ void xcd_barrier_complete(unsigned* bar, unsigned x, unsigned& nloc, unsigned& nx) {
    const unsigned G = gridDim.x * gridDim.y * gridDim.z;
    unsigned sum, cnt, mine, sp = 0u;
    for (;;) {
        sum = 0u; cnt = 0u; mine = 0u;
#pragma unroll
        for (unsigned j = 0; j < 16; ++j) { const unsigned c = xb_ld(&bar[XB_XCNT(j)]); sum += c; cnt += (c > 0u) ? 1u : 0u; mine = (j == x) ? c : mine; }
        if (sum == G) break;
        __builtin_amdgcn_s_sleep(1);
        if ((++sp & 255u) == 0u) { if (xb_ld(&bar[XB_TMO])) break; if (sp > XB_SPIN_CAP) { atomicAdd(&bar[XB_TMO], 1u); break; } }
    }
    nloc = mine > 0u ? mine : 1u; nx = cnt > 0u ? cnt : 1u;
}
__device__ __forceinline__ void xcd_barrier(const XcdBarrier& b, int wv) {
    asm volatile("s_waitcnt vmcnt(0)" ::: "memory");
    __syncthreads();
    if (opaque_tid(wv) == 0) {
        unsigned* bar = b.bar;
        __builtin_amdgcn_s_waitcnt(0);
        unsigned nloc = b.st[0], nx = b.st[1];
        if (nloc == 0u) { xcd_barrier_complete(bar, b.x, nloc, nx); b.st[0] = nloc; b.st[1] = nx; }
        const unsigned old = xb_add(&bar[XB_XSUB(b.x)], 1u);
        const unsigned gen = old / nloc;
        if (old + 1u == (gen + 1u) * nloc) {
            __builtin_amdgcn_fence(__ATOMIC_RELEASE, "agent");
            asm volatile("s_waitcnt vmcnt(0)" ::: "memory");
            const unsigned og = xb_add(&bar[XB_TOP], 1u);
            const unsigned tg = og / nx;
            if (og + 1u == (tg + 1u) * nx) xb_add(&bar[XB_TOPGEN], 1u);
            else XB_SPIN(xb_ld(&bar[XB_TOPGEN]) == tg, bar);
            __builtin_amdgcn_fence(__ATOMIC_ACQUIRE, "agent");
            xb_add(&bar[XB_XGEN(b.x)], 1u);
            asm volatile("s_waitcnt vmcnt(0)" ::: "memory");
        } else {
            XB_SPIN(xb_ld(&bar[XB_XGEN(b.x)]) == gen, bar);
            __builtin_amdgcn_fence(__ATOMIC_ACQUIRE, "agent");
            asm volatile("s_waitcnt vmcnt(0)" ::: "memory");
        }
    }
    __syncthreads();
}

__global__ void __launch_bounds__(512, 2) hybrid_fwd(Params Punused) {
    extern __shared__ __attribute__((aligned(16))) unsigned char lds_raw[];
    LAS unsigned char* lds = (LAS unsigned char*)lds_raw;
    cg::grid_group grid = cg::this_grid();
    const int wv = __builtin_amdgcn_readfirstlane((int)(threadIdx.x >> 6));
    volatile LAS unsigned* bst = (volatile LAS unsigned*)(lds + LDS_BST);
    if (threadIdx.x < 4) bst[threadIdx.x] = 0u;
    __syncthreads();
    { const Params P0 = load_params(); (void)xcd_barrier_post((unsigned*)(P0.ws + WS_BAR), bst); }
#define GSYNC() do { const Params Pb = load_params(); XcdBarrier xb_; xb_.bar = (unsigned*)(Pb.ws + WS_BAR); xb_.x = xb_xcc_id(); xb_.st = (volatile LAS unsigned*)(lds + LDS_BST); xcd_barrier(xb_, wv); } while (0)
    phase_prep(lds, wv);
    grid.sync();
    phase_modreduce(wv);
    GSYNC();
    phase_modulate(0, 0, 0, false, wv);
    GSYNC();
    run_in_gemm(lds, 0, true, 0, 0, 0, wv);
    phase_modulate(0, 1, 1, true, wv);
    GSYNC();
    for (int st = 0; st < 16; ++st) {
        const int layer = st >> 2, g = st & 3, j = st >> 3, nst = st + 1;
        if ((layer & 1) == 0) {
            phase_convmix(j, g, wv);
            GSYNC();
        } else {
            phase_uc(j, wv);
            GSYNC();
            run_qkv_nat(lds, j, false, wv); run_tr(lds, j, false, wv); run_tr(lds, j, true, wv); run_gates(lds, j, 0, wv); run_gates(lds, j, 1, wv);
            GSYNC();
            run_qk(lds, wv);
            GSYNC();
            phase_scan(lds, j, wv);
            GSYNC();
            phase_gating(j, wv);
            GSYNC();
        }
        run_out_gemm(lds, layer, g, wv);
        if (nst < 16) run_in_gemm(lds, nst >> 3, ((nst >> 2) & 1) == 0, 256 - 144, nst & 3, nst & 1, wv);
        if (st == 15) phase_final(0, 3 * GB * SEQ, true, wv);
        if (st + 2 < 16) phase_modulate((st + 2) >> 2, (st + 2) & 3, st & 1, true, wv);
        GSYNC();
    }
    phase_final(3 * GB * SEQ, NB * SEQ, false, wv);
}

extern "C" void kernel_launch(void* const* d_in, const int* in_sizes, int n_in, void* d_out, int out_size, void* d_ws, size_t ws_size, hipStream_t stream) {
    static int grid_blocks = 0;
    if (grid_blocks == 0) {
        if (n_in != 21 || out_size != NB * SEQ * DM || ws_size < WS_END) { fprintf(stderr, "kernel_launch: unexpected shapes (n_in %d out %d ws %zu)\n", n_in, out_size, ws_size); grid_blocks = -1; return; }
        int dev = 0, cus = 0, per_cu = 0;
        if (hipGetDevice(&dev) != hipSuccess || hipDeviceGetAttribute(&cus, hipDeviceAttributeMultiprocessorCount, dev) != hipSuccess) { grid_blocks = -1; return; }
        if (hipFuncSetAttribute((const void*)hybrid_fwd, hipFuncAttributeMaxDynamicSharedMemorySize, LDS_BYTES) != hipSuccess) { fprintf(stderr, "kernel_launch: hipFuncSetAttribute failed\n"); grid_blocks = -1; return; }
        if (hipOccupancyMaxActiveBlocksPerMultiprocessor(&per_cu, (const void*)hybrid_fwd, 512, LDS_BYTES) != hipSuccess || per_cu < 1) { fprintf(stderr, "kernel_launch: occupancy query says %d\n", per_cu); per_cu = 1; }
        (void)hipGetLastError();
        grid_blocks = cus;
    }
    if (grid_blocks < 0) return;
    if (hipMemsetAsync((char*)d_ws + WS_BAR, 0, XCD_BAR_WORDS * sizeof(unsigned), stream) != hipSuccess) { fprintf(stderr, "kernel_launch: memset of the barrier words failed\n"); return; }
    Params p{};
    const float** pp = (const float**)&p;
    for (int i = 0; i < 21; ++i) pp[i] = (const float*)d_in[i];
    p.out = (float*)d_out; p.ws = (unsigned char*)d_ws;
    void* args[] = {&p};
    hipError_t e = hipLaunchCooperativeKernel((const void*)hybrid_fwd, dim3(grid_blocks), dim3(512), args, LDS_BYTES, stream);
    if (e != hipSuccess) fprintf(stderr, "cooperative launch failed: %s (grid %d)\n", hipGetErrorString(e), grid_blocks);
}
```

```cpp
#include <hip/hip_runtime.h>
#include <hip/hip_cooperative_groups.h>
#include <cstdio>
namespace cg = cooperative_groups;

#define LAS __attribute__((address_space(3)))
typedef unsigned short bf16_t;
typedef short bf16x8 __attribute__((ext_vector_type(8)));
typedef float f32x4 __attribute__((ext_vector_type(4)));
typedef unsigned u32x4 __attribute__((ext_vector_type(4)));
typedef unsigned u32x2 __attribute__((ext_vector_type(2)));

constexpr int DM = 1024, DI = 2048, NB = 16, SEQ = 2048, CTXL = 256, TT = 2304  , NH = 4, DH = 512;
constexpr int GB = 4  , RG = GB * TT  , MT = RG / 256  ;
constexpr float EPSV = 1e-6f;
constexpr size_t MIB = 1ull << 20;
constexpr size_t WS_CWIN = 0, WS_CWOUT = 32 * MIB, WS_MWIN = 40 * MIB, WS_MWQKV = 64 * MIB, WS_MWOUT = 76 * MIB, WS_MWG = 84 * MIB,
                 WS_MODP = 90 * MIB, WS_MOD = 97 * MIB, WS_XC = 98 * MIB, WS_HX = 114 * MIB, WS_BIG = 132 * MIB, WS_UC = WS_BIG + 108 * MIB,
                 WS_QKV = 276 * MIB, WS_KT = 384 * MIB, WS_VT = 420 * MIB, WS_QKR = 456 * MIB, WS_GATES = 465 * MIB, WS_BAR = 466 * MIB, WS_GATESP = 468 * MIB  , WS_HX2 = 474 * MIB  , WS_GTAB = 492 * MIB  , WS_END = 493 * MIB;
constexpr int LDS_BST = 139264;
constexpr int LDS_BYTES = LDS_BST + 16;

struct Params {
    const float *x, *c, *ctx, *c_ctx, *norm_g, *mod_w, *mod_b, *conv_w_in, *conv_w, *conv_w_out, *m_w_in, *m_conv_w, *m_wq, *m_wk, *m_wv,
        *m_w_gate, *m_b_gate, *m_norm_g, *m_skip, *m_w_out, *final_g;
    float* out; unsigned char* ws;
};

__device__ __forceinline__ unsigned cvt_pk_bf16(float lo, float hi) { unsigned r; asm volatile("v_cvt_pk_bf16_f32 %0, %1, %2" : "=v"(r) : "v"(lo), "v"(hi)); return r; }
__device__ __forceinline__ float bf_lo(unsigned w) { return __uint_as_float(w << 16); }
__device__ __forceinline__ float bf_hi(unsigned w) { return __uint_as_float(w & 0xffff0000u); }
__device__ __forceinline__ void unpack8(u32x4 v, float* f) { f[0] = bf_lo(v.x); f[1] = bf_hi(v.x); f[2] = bf_lo(v.y); f[3] = bf_hi(v.y); f[4] = bf_lo(v.z); f[5] = bf_hi(v.z); f[6] = bf_lo(v.w); f[7] = bf_hi(v.w); }
__device__ __forceinline__ u32x4 pack8(const float* f) { u32x4 o; o.x = cvt_pk_bf16(f[0], f[1]); o.y = cvt_pk_bf16(f[2], f[3]); o.z = cvt_pk_bf16(f[4], f[5]); o.w = cvt_pk_bf16(f[6], f[7]); return o; }
__device__ __forceinline__ float silu_f(float v) { return v * __builtin_amdgcn_rcpf(1.f + __expf(-v)); }
__device__ __forceinline__ float sigmoid_f(float v) { return __builtin_amdgcn_rcpf(1.f + __expf(-v)); }
__device__ __forceinline__ float lane_read(float v, int srclane) { return __int_as_float(__builtin_amdgcn_ds_bpermute(srclane << 2, __float_as_int(v))); }
__device__ __forceinline__ float wave_sum(float v, int lane) {
    (void)lane;
#define DPPS(x, ctrl, rmask) __int_as_float(__builtin_amdgcn_update_dpp(0, __float_as_int(x), ctrl, rmask, 0xf, false))
    v += DPPS(v, 0x111, 0xf); v += DPPS(v, 0x112, 0xf); v += DPPS(v, 0x114, 0xf); v += DPPS(v, 0x118, 0xf);
    v += DPPS(v, 0x142, 0xa); v += DPPS(v, 0x143, 0xc);
#undef DPPS
    return __int_as_float(__builtin_amdgcn_readlane(__float_as_int(v), 63));
}
#define LDS_WAIT() asm volatile("s_waitcnt lgkmcnt(0)" ::: "memory")
template <class T> __device__ __forceinline__ T* opq(T* p) { return p; }
#define CAS __attribute__((address_space(4)))
__device__ __forceinline__ Params load_params() {
    int z = 0; asm volatile("" : "+s"(z));
    const CAS unsigned long long* kp = (const CAS unsigned long long*)((const CAS char*)__builtin_amdgcn_kernarg_segment_ptr() + z);
    Params r; unsigned long long* d = (unsigned long long*)&r;
#pragma unroll
    for (int i = 0; i < (int)(sizeof(Params) / 8); ++i) d[i] = kp[i];
    return r;
}
__device__ __forceinline__ int opaque_tid(int wv) {
    int ln; asm volatile("v_mbcnt_lo_u32_b32 %0, -1, 0\n\tv_mbcnt_hi_u32_b32 %0, -1, %0" : "=&v"(ln)); return wv * 64 + ln; }

constexpr int BM = 256, BK = 64, HALF = 128, HTB = HALF * BK * 2, NXCD = 8, WGM = 8;
__device__ __forceinline__ int lds_byte(int r, int c) { const int st = (r >> 4) * 2 + (c >> 5), rr = r & 15, cc = c & 31, ob = rr * 64 + cc * 2; return st * 1024 + (ob ^ (((ob >> 9) & 1) << 5)); }
__device__ __forceinline__ void stage_rc(int b, int& R, int& C) { const int st = b / 1024, sb = b % 1024, swz = sb ^ (((sb >> 9) & 1) << 5); R = (st >> 1) * 16 + swz / 64; C = (st & 1) * 32 + (swz % 64) / 2; }
__device__ __forceinline__ int perm32(int rho) { const int n = rho >> 4, i = rho & 15; return 8 * (i >> 2) + 4 * n + (i & 3); }
struct Unit { int pm, pn; };
__device__ __forceinline__ bool tile_next(int i, int G, int c, int nM, int nN, Unit& u, int tailc = 0) {
    const int nwg = nM * nN; long L = (long)i * G + c;
    if (tailc > 0) { const int fr_ = nwg / G, full = fr_ * G, rem = nwg - full;
        if (i >= fr_) { const int k = i - fr_; if (k == 0) { if (c >= tailc) return false; L = full + c; } else if (k == 1) { if (c >= rem - tailc) return false; L = full + tailc + c; } else return false; } }
    if (L >= nwg) return false;
    int wgid = (int)L; { const int q = nwg / NXCD, r = nwg % NXCD, xcd = wgid % NXCD, off = wgid / NXCD; wgid = (xcd < r ? xcd * (q + 1) : r * (q + 1) + (xcd - r) * q) + off; }
    const int nig = WGM * nN, gid = wgid / nig, fm = gid * WGM, gsz = (nM - fm) < WGM ? (nM - fm) : WGM;
    u.pm = fm + ((wgid % nig) % gsz); u.pn = (wgid % nig) / gsz; return true;
}

__device__ __forceinline__ void store_bf16_tile(const f32x4 (&acc)[2][2][4][2], bf16_t* base, size_t ldc, float scale, int wr, int wc, int fr, int fq) {
    bf16_t* p0 = base + (size_t)(wr * 64 + fr) * ldc + wc * 32 + 8 * fq;
#pragma unroll
    for (int ai = 0; ai < 2; ++ai)
#pragma unroll
        for (int m = 0; m < 4; ++m) { bf16_t* rowp = p0 + (size_t)(ai * HALF + m * 16) * ldc;
#pragma unroll
            for (int bj = 0; bj < 2; ++bj) { const f32x4 v0 = acc[ai][bj][m][0] * scale, v1 = acc[ai][bj][m][1] * scale;
                u32x4 w; w.x = cvt_pk_bf16(v0[0], v0[1]); w.y = cvt_pk_bf16(v0[2], v0[3]); w.z = cvt_pk_bf16(v1[0], v1[1]); w.w = cvt_pk_bf16(v1[2], v1[3]);
                *(u32x4*)(rowp + bj * HALF) = w; } }
}

template <class PH>
__device__ __forceinline__ void gemm_phase(LAS unsigned char* lds, const PH& S, int wv) {
    const int tid = opaque_tid(wv);
    const int wid = __builtin_amdgcn_readfirstlane(tid >> 6), lane = tid & 63, wr = wid >> 2, wc = wid & 3, fr = lane & 15, fq = lane >> 4;
    const int K = S.K, nt = K / BK;
    const int G = gridDim.x, cblk = (int)((blockIdx.x + (unsigned)S.coff) % gridDim.x);
    unsigned voffA[2], voffB[2];
#pragma unroll
    for (int i = 0; i < 2; ++i) { int R, C; stage_rc(tid * 16 + i * 8192, R, C); const int Rb = PH::PERM ? ((R & ~31) + perm32(R & 31)) : R;
        voffA[i] = (unsigned)(R * S.lda + C) * 2u; voffB[i] = (unsigned)(Rb * S.ldb + C) * 2u; }
    const size_t kstep = (size_t)(BK * 2);
    const size_t hstepA = (size_t)HALF * S.lda * 2, hstepB = (size_t)HALF * S.ldb * 2;
    const unsigned ldsw = (unsigned)wid * 1024u;
    const int aoff = lds_byte(wr * 64 + fr, fq * 8), boff = lds_byte(wc * 32 + fr, fq * 8);
#define PG8_SA(b, h) (((b) * 2 + (h)) * HTB)
#define PG8_SB(b, h) ((4 + (b) * 2 + (h)) * HTB)
#define PG8_STAGE(bufoff, gbase, voff) do { _Pragma("unroll") for (int _i = 0; _i < 2; ++_i) \
        __builtin_amdgcn_global_load_lds((const unsigned*)((const char*)(gbase) + (voff)[_i]), (LAS unsigned*)(lds + (bufoff) + ldsw + _i * 8192), 16, 0, 0); } while (0)
#define PG8_LDA(dst, b, h) do { _Pragma("unroll") for (int m = 0; m < 4; ++m) _Pragma("unroll") for (int k = 0; k < 2; ++k) dst[m][k] = *(const LAS bf16x8*)(lds + PG8_SA(b, h) + aoff + m * 2048 + k * 1024); } while (0)
#define PG8_LDB(dst, b, h) do { _Pragma("unroll") for (int n = 0; n < 2; ++n) _Pragma("unroll") for (int k = 0; k < 2; ++k) dst[n][k] = *(const LAS bf16x8*)(lds + PG8_SB(b, h) + boff + n * 2048 + k * 1024); } while (0)
#define PG8_MMA(ai, bj, At, Bt) do { __builtin_amdgcn_s_setprio(1); _Pragma("unroll") for (int m = 0; m < 4; ++m) _Pragma("unroll") for (int n = 0; n < 2; ++n) _Pragma("unroll") for (int k = 0; k < 2; ++k) \
        acc[ai][bj][m][n] = __builtin_amdgcn_mfma_f32_16x16x32_bf16(Bt[n][k], At[m][k], acc[ai][bj][m][n], 0, 0, 0); __builtin_amdgcn_s_setprio(0); } while (0)
#define PG8_WAIT_V(n) asm volatile("s_waitcnt vmcnt(" #n ")" ::: "memory")
#define PG8_WAIT_L(n) asm volatile("s_waitcnt lgkmcnt(" #n ")" ::: "memory")
#define PG8_BAR __builtin_amdgcn_s_barrier()
#define PG8_SCHED __builtin_amdgcn_sched_barrier(0)
    Unit cur, nxt; int ui = 0;
    if (!tile_next(0, G, cblk, S.nM, S.nN, cur, S.coff != 0 ? PH::TAILC : 0)) return;
    f32x4 acc[2][2][4][2];
#pragma unroll
    for (int a = 0; a < 2; ++a)
#pragma unroll
        for (int b = 0; b < 2; ++b)
#pragma unroll
            for (int m = 0; m < 4; ++m)
#pragma unroll
                for (int n = 0; n < 2; ++n) acc[a][b][m][n] = (f32x4){0.f, 0.f, 0.f, 0.f};
    bf16x8 At[4][2], B0[2][2], B1[2][2];
    const char* cA = S.aptr(cur); const char* cB = S.bptr(cur);
    PG8_STAGE(PG8_SB(0, 0), cB, voffB); PG8_STAGE(PG8_SA(0, 0), cA, voffA); PG8_STAGE(PG8_SB(0, 1), cB + hstepB, voffB); PG8_STAGE(PG8_SA(0, 1), cA + hstepA, voffA);
    if (wr == 1) PG8_BAR;
    PG8_WAIT_V(4); PG8_BAR;
    PG8_STAGE(PG8_SB(1, 0), cB + kstep, voffB); PG8_STAGE(PG8_SA(1, 0), cA + kstep, voffA); PG8_STAGE(PG8_SB(1, 1), cB + hstepB + kstep, voffB);
    PG8_WAIT_V(6); PG8_BAR;
    for (;;) {
        const bool has_next = tile_next(ui + 1, G, cblk, S.nM, S.nN, nxt, S.coff != 0 ? PH::TAILC : 0);
        const char* nA = has_next ? S.aptr(nxt) : cA; const char* nB = has_next ? S.bptr(nxt) : cB;
        for (int t = 0; t < nt; t += 2) {
            const bool last = (t == nt - 2);
            const char* a1 = cA + (size_t)(t + 1) * kstep;
            const char* a2 = last ? nA : cA + (size_t)(t + 2) * kstep; const char* b2 = last ? nB : cB + (size_t)(t + 2) * kstep;
            const char* a3 = a2 + kstep; const char* b3 = b2 + kstep;
            PG8_LDB(B0, 0, 0); PG8_SCHED; PG8_LDA(At, 0, 0); PG8_STAGE(PG8_SA(1, 1), a1 + hstepA, voffA);
            PG8_WAIT_L(8); PG8_BAR; PG8_WAIT_L(0); PG8_MMA(0, 0, At, B0); PG8_BAR; PG8_SCHED;
            PG8_LDB(B1, 0, 1); PG8_STAGE(PG8_SB(0, 0), b2, voffB);
            PG8_BAR; PG8_WAIT_L(0); PG8_MMA(0, 1, At, B1); PG8_BAR;
            PG8_LDA(At, 0, 1); PG8_STAGE(PG8_SA(0, 0), a2, voffA);
            PG8_BAR; PG8_WAIT_L(0); PG8_MMA(1, 0, At, B0); PG8_BAR; PG8_SCHED;
            PG8_STAGE(PG8_SB(0, 1), b2 + hstepB, voffB);
            PG8_WAIT_V(6); PG8_BAR; PG8_MMA(1, 1, At, B1); PG8_BAR;
            PG8_LDB(B0, 1, 0); PG8_SCHED; PG8_LDA(At, 1, 0); PG8_STAGE(PG8_SA(0, 1), a2 + hstepA, voffA);
            PG8_WAIT_L(8); PG8_BAR; PG8_WAIT_L(0); PG8_MMA(0, 0, At, B0); PG8_BAR; PG8_SCHED;
            PG8_LDB(B1, 1, 1); PG8_STAGE(PG8_SB(1, 0), b3, voffB);
            PG8_BAR; PG8_WAIT_L(0); PG8_MMA(0, 1, At, B1); PG8_BAR;
            PG8_LDA(At, 1, 1); PG8_STAGE(PG8_SA(1, 0), a3, voffA);
            PG8_BAR; PG8_WAIT_L(0); PG8_MMA(1, 0, At, B0); PG8_BAR; PG8_SCHED;
            PG8_STAGE(PG8_SB(1, 1), b3 + hstepB, voffB);
            PG8_WAIT_V(6); PG8_BAR; PG8_MMA(1, 1, At, B1); PG8_BAR;
        }
        S.epi(acc, cur, wr, wc, fr, fq);
        if (!has_next) break;
#pragma unroll
        for (int a = 0; a < 2; ++a)
#pragma unroll
            for (int b = 0; b < 2; ++b)
#pragma unroll
                for (int m = 0; m < 4; ++m)
#pragma unroll
                    for (int n = 0; n < 2; ++n) acc[a][b][m][n] = (f32x4){0.f, 0.f, 0.f, 0.f};
        cur = nxt; cA = nA; cB = nB; ++ui;
    }
    PG8_WAIT_V(0);
    if (wr == 0) PG8_BAR;
    PG8_BAR;
#undef PG8_SA
#undef PG8_SB
#undef PG8_STAGE
#undef PG8_LDA
#undef PG8_LDB
#undef PG8_MMA
#undef PG8_WAIT_V
#undef PG8_WAIT_L
#undef PG8_BAR
#undef PG8_SCHED
}

struct PhPlain {
    static constexpr bool PERM = true; static constexpr int TAILC = 0;
    int K, lda, ldb, nM, nN, coff; const bf16_t *A, *B; bf16_t* O; int ldc;
    __device__ __forceinline__ const char* aptr(const Unit& u) const { return (const char*)(A + (size_t)u.pm * 256 * lda); }
    __device__ __forceinline__ const char* bptr(const Unit& u) const { return (const char*)(B + (size_t)u.pn * 256 * ldb); }
    __device__ __forceinline__ void epi(const f32x4 (&acc)[2][2][4][2], const Unit& u, int wr, int wc, int fr, int fq) const {
        store_bf16_tile(acc, O + (size_t)u.pm * 256 * ldc + (size_t)u.pn * 256, (size_t)ldc, 1.f, wr, wc, fr, fq);
    }
};
#define DPP4(dst, src, ctrl) { _Pragma("unroll") for (int i_ = 0; i_ < 4; ++i_) dst[i_] = __int_as_float(__builtin_amdgcn_update_dpp(0, __float_as_int(src[i_]), ctrl, 0xf, 0xf, false)); }
struct PhConvFused {
    static constexpr bool PERM = true; static constexpr int TAILC = 112;
    int K, lda, ldb, nM, nN, coff; const bf16_t *A, *B; bf16_t* BIG; bf16_t* Y; const float* cw;
    __device__ __forceinline__ const char* aptr(const Unit& u) const { return (const char*)(A + (size_t)u.pm * 256 * lda); }
    __device__ __forceinline__ const char* bptr(const Unit& u) const { return (const char*)(B + (size_t)u.pn * 256 * ldb); }
    __device__ __forceinline__ void epi(const f32x4 (&acc)[2][2][4][2], const Unit& u, int wr, int wc, int fr, int fq) const {
        const int jc = u.pn * 64 + 16 * wc + 4 * fq;
        if (u.pm % 9 == 0) {
#pragma unroll
            for (int ai = 0; ai < 2; ++ai)
#pragma unroll
                for (int m = 0; m < 4; ++m) { bf16_t* rowp = BIG + (size_t)(u.pm * 256 + ai * HALF + wr * 64 + m * 16 + fr) * 8192 + jc;
#pragma unroll
                    for (int bj = 0; bj < 2; ++bj)
#pragma unroll
                        for (int n = 0; n < 2; ++n) { const f32x4 v = acc[ai][bj][m][n]; u32x2 o; o.x = cvt_pk_bf16(v[0], v[1]); o.y = cvt_pk_bf16(v[2], v[3]);
                            *(u32x2*)(rowp + (2 * bj + n) * 2048) = o; } }
            return;
        }
        const f32x4 w0 = *(const f32x4*)(cw + jc), w1 = *(const f32x4*)(cw + DI + jc), w2 = *(const f32x4*)(cw + 2 * DI + jc);
#pragma unroll
        for (int ai = 0; ai < 2; ++ai) {
            f32x4 cu[4];
#pragma unroll
            for (int m = 0; m < 4; ++m) cu[m] = acc[ai][0][m][1] * acc[ai][1][m][0];
#pragma unroll
            for (int m = 0; m < 4; ++m) {
                f32x4 pv, nx, t;
                DPP4(pv, cu[m], 0x111)
                if (m > 0) { DPP4(t, cu[m - 1], 0x121) if (fr == 0) pv = t; }
                DPP4(nx, cu[m], 0x101)
                if (m < 3) { DPP4(t, cu[m + 1], 0x12F) if (fr == 15) nx = t; }
                const f32x4 bb = acc[ai][0][m][0], zz = acc[ai][1][m][1];
                f32x4 y;
#pragma unroll
                for (int i = 0; i < 4; ++i) y[i] = bb[i] * (w0[i] * pv[i] + w1[i] * cu[m][i] + w2[i] * nx[i]) * silu_f(zz[i]);
                u32x2 o; o.x = cvt_pk_bf16(y[0], y[1]); o.y = cvt_pk_bf16(y[2], y[3]);
                *(u32x2*)(Y + (size_t)(u.pm * 256 + ai * HALF + wr * 64 + m * 16 + fr) * DI + jc) = o;
            }
        }
    }
};
struct PhQKV {
    static constexpr bool PERM = true; static constexpr int TAILC = 0;
    int K, lda, ldb, nM, nN, coff; const bf16_t* A; const bf16_t* W  ; bf16_t* O; int which0;
    __device__ __forceinline__ const char* aptr(const Unit& u) const { const int h = (u.pn >> 1) & 3; return (const char*)(A + (size_t)u.pm * 256 * lda + h * 512); }
    __device__ __forceinline__ const char* bptr(const Unit& u) const { const int which = which0 + (u.pn >> 3), h = (u.pn >> 1) & 3, half = u.pn & 1;
        return (const char*)(W + ((size_t)(which * 4 + h) * 512 + half * 256) * 512); }
    __device__ __forceinline__ void epi(const f32x4 (&acc)[2][2][4][2], const Unit& u, int wr, int wc, int fr, int fq) const {
        const int which = which0 + (u.pn >> 3), h = (u.pn >> 1) & 3, half = u.pn & 1;
        store_bf16_tile(acc, O + (size_t)u.pm * 256 * 6144 + which * 2048 + h * 512 + half * 256, 6144, which == 1 ? 0.044194173824159216f : 1.f, wr, wc, fr, fq);
    }
};
struct PhTr {
    static constexpr bool PERM = true; static constexpr int TAILC = 0;
    int K, lda, ldb, nM, nN, coff; const bf16_t* W  ; const bf16_t* Act; bf16_t* OT; float scale;
    __device__ __forceinline__ const char* aptr(const Unit& u) const { const int h = u.pm >> 1, mh = u.pm & 1; return (const char*)(W + ((size_t)h * 512 + mh * 256) * 512); }
    __device__ __forceinline__ const char* bptr(const Unit& u) const { const int h = u.pm >> 1; return (const char*)(Act + (size_t)u.pn * 256 * ldb + h * 512); }
    __device__ __forceinline__ void epi(const f32x4 (&acc)[2][2][4][2], const Unit& u, int wr, int wc, int fr, int fq) const {
        const int h = u.pm >> 1, mh = u.pm & 1, bl = u.pn / 9, w = u.pn % 9;
        store_bf16_tile(acc, OT + ((size_t)(bl * 4 + h) * 512 + mh * 256) * TT + w * 256, (size_t)TT, scale, wr, wc, fr, fq);
    }
};
struct PhQK {
    static constexpr bool PERM = false; static constexpr int TAILC = 0;
    int K, lda, ldb, nM, nN, coff; const bf16_t* QKV; float* QKR;
    __device__ __forceinline__ const char* aptr(const Unit& u) const { const int bl = u.pm / 36, h = (u.pm / 9) & 3, w = u.pm % 9; return (const char*)(QKV + (size_t)(bl * TT + w * 256) * 6144 + h * 512); }
    __device__ __forceinline__ const char* bptr(const Unit& u) const { const int bl = u.pm / 36, h = (u.pm / 9) & 3, w = u.pm % 9; return (const char*)(QKV + (size_t)(bl * TT + w * 256) * 6144 + 2048 + h * 512); }
    __device__ __forceinline__ void epi(const f32x4 (&acc)[2][2][4][2], const Unit& u, int wr, int wc, int fr, int fq) const {
        if (wr != (wc >> 1)) return;
        const int bl = u.pm / 36, h = (u.pm / 9) & 3, w = u.pm % 9;
        float* base = QKR + ((size_t)(bl * 4 + h) * TT + w * 256 + wr * 64 + fr) * 64 + 32 * (wc & 1) + 4 * fq;
#pragma unroll
        for (int ai = 0; ai < 2; ++ai)
#pragma unroll
            for (int m = 0; m < 4; ++m)
#pragma unroll
                for (int n = 0; n < 2; ++n) *(f32x4*)(base + (size_t)(ai * 128 + m * 16) * 64 + n * 16) = acc[ai][ai][m][n];
    }
};
struct PhGates {
    static constexpr bool PERM = false; static constexpr int TAILC = 0;
    int K, lda, ldb, nM, nN, coff; const bf16_t* A; const bf16_t* WG; float* GATESP; int poff;
    __device__ __forceinline__ const char* aptr(const Unit& u) const { return (const char*)(A + (size_t)u.pm * 256 * lda + u.pn * 512); }
    __device__ __forceinline__ const char* bptr(const Unit& u) const { return (const char*)(WG + u.pn * 512); }
    __device__ __forceinline__ void epi(const f32x4 (&acc)[2][2][4][2], const Unit& u, int wr, int wc, int fr, int fq) const {
        if (wc != 0) return;
        float* base = GATESP + (size_t)(poff + u.pn) * RG * 16 + (size_t)(u.pm * 256 + wr * 64 + fr) * 16 + 4 * fq;
#pragma unroll
        for (int ai = 0; ai < 2; ++ai)
#pragma unroll
            for (int m = 0; m < 4; ++m) *(f32x4*)(base + (size_t)(ai * 128 + m * 16) * 16) = acc[ai][0][m][0];
    }
};
struct PhResid {
    static constexpr bool PERM = false; static constexpr int TAILC = 0;
    int K, lda, ldb, nM, nN, coff; const bf16_t *A, *B; const float *xin_x, *xin_c; float *xout_x, *xout_c; const float* mod  ; int g;
    __device__ __forceinline__ const char* aptr(const Unit& u) const { return (const char*)(A + (size_t)u.pm * 256 * lda); }
    __device__ __forceinline__ const char* bptr(const Unit& u) const { return (const char*)(B + (size_t)u.pn * 256 * ldb); }
    __device__ __forceinline__ void epi(const f32x4 (&acc)[2][2][4][2], const Unit& u, int wr, int wc, int fr, int fq) const {
        const int bl = u.pm / 9, w = u.pm % 9, b = g * GB + bl;
        const float* xin; float* xout; size_t rbase; int v;
        if (w == 0) { rbase = (size_t)b * CTXL; xin = xin_c; xout = xout_c; v = 16; } else { rbase = (size_t)b * SEQ + (w - 1) * 256; xin = xin_x; xout = xout_x; v = b; }
        const int col0 = u.pn * 256 + wc * 32 + 4 * fq;
        const float* gate = mod + (size_t)v * 3072 + 2048 + col0;
        f32x4 gv[2][2];
#pragma unroll
        for (int bj = 0; bj < 2; ++bj)
#pragma unroll
            for (int n = 0; n < 2; ++n) gv[bj][n] = *(const f32x4*)(gate + bj * HALF + n * 16);
#pragma unroll
        for (int ai = 0; ai < 2; ++ai)
#pragma unroll
            for (int m = 0; m < 4; ++m) { const size_t off = (rbase + wr * 64 + fr + ai * HALF + m * 16) * DM + col0;
#pragma unroll
                for (int bj = 0; bj < 2; ++bj)
#pragma unroll
                    for (int n = 0; n < 2; ++n) { const f32x4 xv = *(const f32x4*)(xin + off + bj * HALF + n * 16);
                        *(f32x4*)(xout + off + bj * HALF + n * 16) = xv + gv[bj][n] * acc[ai][bj][m][n]; } }
    }
};

__device__ __forceinline__ int convin_dst_row(int ns) { const int g = ns >> 11, rem = ns & 2047, pn = rem >> 6, jc = rem & 63;
    return 256 * pn + 128 * (g >> 1) + 32 * (jc >> 4) + 8 * ((jc >> 2) & 3) + 4 * (g & 1) + (jc & 3); }
__device__ __forceinline__ void transpose_item(const float* W, int K, int N, bf16_t* WT, LAS float* scr, int item, int lane, bool perm = false) {
    const int nblk = N / 32, kb = item / nblk, nb = item % nblk, k0 = 64 * kb, n0 = 32 * nb;
    float tv[32];
#pragma unroll
    for (int i = 0; i < 32; ++i) { const int kk = 2 * i + (lane >> 5); tv[i] = W[(size_t)(k0 + kk) * N + n0 + (lane & 31)]; }
#pragma unroll
    for (int i = 0; i < 32; ++i) { const int kk = 2 * i + (lane >> 5); scr[kk * 33 + (lane & 31)] = tv[i]; }
    LDS_WAIT();
    const int c = lane & 7;
#pragma unroll
    for (int j = 0; j < 4; ++j) { const int n = (lane >> 3) + 8 * j; const LAS float* s = scr + (8 * c) * 33 + n;
        u32x4 o; o.x = cvt_pk_bf16(s[0 * 33], s[1 * 33]); o.y = cvt_pk_bf16(s[2 * 33], s[3 * 33]); o.z = cvt_pk_bf16(s[4 * 33], s[5 * 33]); o.w = cvt_pk_bf16(s[6 * 33], s[7 * 33]);
        *(u32x4*)(WT + (size_t)(perm ? convin_dst_row(n0 + n) : (n0 + n)) * K + k0 + 8 * c) = o; }
    LDS_WAIT();
}
__device__ __forceinline__ void phase_prep(LAS unsigned char* lds, int wv) {
    const Params P = load_params();
    const int tid = opaque_tid(wv), lane = tid & 63, wave = tid >> 6;
    unsigned char* ws = opq(P.ws);
    float* MODP = (float*)(ws + WS_MODP);
    for (int item = blockIdx.x; item < 192; item += gridDim.x) {
        const int i = item / 48, rem = item % 48, ks = rem / 6, nb = rem % 6;
        LAS float* sc = (LAS float*)lds;
        for (int idx = tid; idx < 17 * 128; idx += 512) { const int v = idx >> 7, k = idx & 127; const float cv = (v < 16) ? P.c[v * DM + ks * 128 + k] : P.c_ctx[ks * 128 + k]; sc[idx] = silu_f(cv); }
        __syncthreads();
        const int n = nb * 512 + tid;
        float a[17];
#pragma unroll
        for (int v = 0; v < 17; ++v) a[v] = 0.f;
        const float* wp = P.mod_w + ((size_t)i * DM + ks * 128) * 3072 + n;
        for (int k0 = 0; k0 < 128; k0 += 16) {
            float wv[16];
#pragma unroll
            for (int u = 0; u < 16; ++u) wv[u] = wp[(size_t)(k0 + u) * 3072];
#pragma unroll
            for (int u = 0; u < 16; ++u)
#pragma unroll
                for (int v = 0; v < 17; ++v) a[v] += sc[v * 128 + k0 + u] * wv[u]; }
#pragma unroll
        for (int v = 0; v < 17; ++v) MODP[((size_t)(ks * 4 + i) * 17 + v) * 3072 + n] = a[v];
        __syncthreads();
    }
    LAS float* scr = (LAS float*)(lds + 16384 + wave * 8448);
    const int gw = blockIdx.x * 8 + wave, NGW = gridDim.x * 8;
    constexpr int PERJ = 4096 + 1024 + 3072 + 12 * 128 + 1024;
    for (int it = gw; it < 2 * PERJ; it += NGW) {
        const int j = it / PERJ; int r = it % PERJ;
        if (r < 4096) { transpose_item(P.conv_w_in + (size_t)j * DM * 8192, DM, 8192, (bf16_t*)(ws + WS_CWIN) + (size_t)j * 8192 * DM, scr, r, lane, true); continue; } r -= 4096;
        if (r < 1024) { transpose_item(P.conv_w_out + (size_t)j * DI * DM, DI, DM, (bf16_t*)(ws + WS_CWOUT) + (size_t)j * DM * DI, scr, r, lane); continue; } r -= 1024;
        if (r < 3072) { transpose_item(P.m_w_in + (size_t)j * DM * 6144, DM, 6144, (bf16_t*)(ws + WS_MWIN) + (size_t)j * 6144 * DM, scr, r, lane); continue; } r -= 3072;
        if (r < 1536) { const int wh = r / 128, which = wh >> 2, h = wh & 3; const float* src = (which == 0 ? P.m_wq : (which == 1 ? P.m_wk : P.m_wv)) + (size_t)(j * 4 + h) * DH * DH;
            transpose_item(src, DH, DH, (bf16_t*)(ws + WS_MWQKV) + ((size_t)(j * 3 + which) * 4 + h) * DH * DH, scr, r % 128, lane); continue; } r -= 1536;
        transpose_item(P.m_w_out + (size_t)j * DI * DM, DI, DM, (bf16_t*)(ws + WS_MWOUT) + (size_t)j * DM * DI, scr, r, lane);
    }
    bf16_t* MWG2 = (bf16_t*)(ws + WS_MWG);
    for (int item = gw; item < 2 * 2 * 2048; item += NGW) {
        const int j = item >> 12, part = (item >> 11) & 1, kg = item & 2047, h = kg >> 9, d = kg & 511;
        float acc[16];
#pragma unroll
        for (int n = 0; n < 16; ++n) acc[n] = 0.f;
        for (int pass = 0; pass < (part == 0 ? 2 : 1); ++pass) {
            const int which = part == 0 ? pass : 2; const float scl = which == 1 ? 0.044194173824159216f : 1.f;
            const float* wrow = (which == 0 ? P.m_wq : (which == 1 ? P.m_wk : P.m_wv)) + ((size_t)(j * 4 + h) * DH + d) * DH;
            const float* wgp = P.m_w_gate + ((size_t)j * 6144 + which * 2048 + h * 512) * 16;
#pragma unroll
            for (int q = 0; q < 8; ++q) { const int e = lane + 64 * q; const float wvv = wrow[e] * scl;
                const f32x4 g0 = *(const f32x4*)(wgp + (size_t)e * 16), g1 = *(const f32x4*)(wgp + (size_t)e * 16 + 4), g2 = *(const f32x4*)(wgp + (size_t)e * 16 + 8), g3 = *(const f32x4*)(wgp + (size_t)e * 16 + 12);
#pragma unroll
                for (int i = 0; i < 4; ++i) { acc[i] += wvv * g0[i]; acc[4 + i] += wvv * g1[i]; acc[8 + i] += wvv * g2[i]; acc[12 + i] += wvv * g3[i]; } }
        }
        float mine = 0.f;
#pragma unroll
        for (int n = 0; n < 16; ++n) { const float t = wave_sum(acc[n], lane); mine = (lane == n) ? t : mine; }
        if (lane < 16) MWG2[((size_t)(j * 2 + part) * 256 + lane) * 2048 + kg] = (bf16_t)(cvt_pk_bf16(mine, 0.f) & 0xffffu);
    }
    for (size_t idx = (size_t)blockIdx.x * 512 + tid; idx < (size_t)4 * 240 * 2048; idx += (size_t)gridDim.x * 512) {
        const int m4 = (int)(idx / (240 * 2048)); const int rem = (int)(idx % (240 * 2048));
        MWG2[((size_t)m4 * 256 + 16) * 2048 + rem] = (bf16_t)0;
    }
    __syncthreads();
}
__device__ __forceinline__ void phase_modreduce(int wv) {
    const Params P = load_params();
    unsigned char* ws = opq(P.ws);
    const float* MODP = (const float*)(ws + WS_MODP); float* MOD = (float*)(ws + WS_MOD);
    for (int idx = blockIdx.x * 512 + opaque_tid(wv); idx < 4 * 17 * 3072; idx += gridDim.x * 512) {
        const int i = idx / (17 * 3072), n = idx % 3072;
        float s = P.mod_b[i * 3072 + n];
#pragma unroll
        for (int ks = 0; ks < 8; ++ks) s += MODP[(size_t)ks * 4 * 17 * 3072 + idx];
        MOD[idx] = s;
    }
}

__device__ __forceinline__ void phase_modulate(int layer, int g, int buf, bool light, int wv) {
    if (light && blockIdx.x < 160) return;
    const Params P = load_params();
    const float* xin_x = (layer == 0) ? P.x : P.out; const float* xin_c = (layer == 0) ? P.ctx : (const float*)(P.ws + WS_XC);
    const int tid = opaque_tid(wv), lane = tid & 63, gw = (light ? (int)blockIdx.x - 160 : (int)blockIdx.x) * 8 + (tid >> 6), NGW = (light ? 96 : (int)gridDim.x) * 8;
    unsigned char* ws = opq(P.ws); xin_x = opq(xin_x); xin_c = opq(xin_c);
    bf16_t* HX = (bf16_t*)(ws + (buf ? WS_HX2 : WS_HX)); const float* MOD = (const float*)(ws + WS_MOD) + (size_t)layer * 17 * 3072;
    const float* ng = opq(P.norm_g) + layer * DM;
    for (int r = gw; r < RG; r += NGW) {
        const int bl = r / TT, tt = r % TT, b = g * GB + bl;
        const float* xr; int v;
        if (tt < CTXL) { xr = xin_c + ((size_t)b * CTXL + tt) * DM; v = 16; } else { xr = xin_x + ((size_t)b * SEQ + (tt - CTXL)) * DM; v = b; }
        const float* md = MOD + (size_t)v * 3072;
        f32x4 xv[4]; float ss = 0.f;
#pragma unroll
        for (int q = 0; q < 4; ++q) { xv[q] = *(const f32x4*)(xr + 4 * lane + 256 * q); ss += (xv[q][0] * xv[q][0] + xv[q][1] * xv[q][1]) + (xv[q][2] * xv[q][2] + xv[q][3] * xv[q][3]); }
        const float rstd = rsqrtf(wave_sum(ss, lane) * (1.f / DM) + EPSV);
#pragma unroll
        for (int q = 0; q < 4; ++q) { const int c0 = 4 * lane + 256 * q;
            const f32x4 gv = *(const f32x4*)(ng + c0), sh = *(const f32x4*)(md + c0), sc = *(const f32x4*)(md + 1024 + c0);
            const f32x4 y = xv[q] * rstd * gv * (sc + 1.f) + sh;
            u32x2 o; o.x = cvt_pk_bf16(y[0], y[1]); o.y = cvt_pk_bf16(y[2], y[3]);
            *(u32x2*)(HX + (size_t)r * DM + c0) = o; }
    }
}
__device__ __forceinline__ void conv_valid(int r, bool& pv, bool& nv) {
    const int tt = r % TT;
    if (tt < CTXL) { pv = tt != 0; nv = tt != CTXL - 1; } else { pv = (tt & 63) != 0; nv = (tt & 63) != 63; }
}
__device__ __forceinline__ void phase_convmix(int j, int g, int wv) {
    const Params P = load_params();
    unsigned char* ws = opq(P.ws);
    const bf16_t* BIG = (const bf16_t*)(ws + WS_BIG); bf16_t* Y = (bf16_t*)(ws + ((g & 1) ? WS_KT : WS_VT));
    const float* cw = opq(P.conv_w) + (size_t)j * 3 * DI;
    for (int it = blockIdx.x * 512 + opaque_tid(wv); it < GB * CTXL * 256; it += gridDim.x * 512) {
        const int rc = it >> 8, r = (rc >> 8) * TT + (rc & 255), c8 = (it & 255) * 8; bool pv, nv; conv_valid(r, pv, nv);
        const bf16_t* row = BIG + (size_t)r * 8192 + c8;
        float bb[8], cc[8], uu[8], zz[8], cp[8], up[8], cn[8], un[8];
        unpack8(*(const u32x4*)(row), bb); unpack8(*(const u32x4*)(row + 2048), cc); unpack8(*(const u32x4*)(row + 4096), uu); unpack8(*(const u32x4*)(row + 6144), zz);
        const u32x4 z4 = (u32x4){0u, 0u, 0u, 0u};
        unpack8(pv ? *(const u32x4*)(row - 8192 + 2048) : z4, cp); unpack8(pv ? *(const u32x4*)(row - 8192 + 4096) : z4, up);
        unpack8(nv ? *(const u32x4*)(row + 8192 + 2048) : z4, cn); unpack8(nv ? *(const u32x4*)(row + 8192 + 4096) : z4, un);
        float w0[8], w1[8], w2[8], y[8];
        *(f32x4*)(w0) = *(const f32x4*)(cw + c8); *(f32x4*)(w0 + 4) = *(const f32x4*)(cw + c8 + 4);
        *(f32x4*)(w1) = *(const f32x4*)(cw + DI + c8); *(f32x4*)(w1 + 4) = *(const f32x4*)(cw + DI + c8 + 4);
        *(f32x4*)(w2) = *(const f32x4*)(cw + 2 * DI + c8); *(f32x4*)(w2 + 4) = *(const f32x4*)(cw + 2 * DI + c8 + 4);
#pragma unroll
        for (int e = 0; e < 8; ++e) { const float s = w0[e] * (cp[e] * up[e]) + w1[e] * (cc[e] * uu[e]) + w2[e] * (cn[e] * un[e]); y[e] = bb[e] * s * silu_f(zz[e]); }
        *(u32x4*)(Y + (size_t)r * DI + c8) = pack8(y);
    }
}
__device__ __forceinline__ void phase_uc(int j, int wv) {
    const Params P = load_params();
    unsigned char* ws = opq(P.ws);
    const bf16_t* UZO = (const bf16_t*)(ws + WS_BIG); bf16_t* UC = (bf16_t*)(ws + WS_UC);
    const float* cw = opq(P.m_conv_w) + (size_t)j * 3 * DI;
    for (int it = blockIdx.x * 512 + opaque_tid(wv); it < RG * 256; it += gridDim.x * 512) {
        const int r = it >> 8, c8 = (it & 255) * 8; bool pv, nv; conv_valid(r, pv, nv);
        const bf16_t* row = UZO + (size_t)r * 6144 + c8;
        float uu[8], up[8], un[8], y[8];
        const u32x4 z4 = (u32x4){0u, 0u, 0u, 0u};
        unpack8(*(const u32x4*)(row), uu);
        unpack8(pv ? *(const u32x4*)(row - 6144) : z4, up);
        unpack8(nv ? *(const u32x4*)(row + 6144) : z4, un);
        float w0[8], w1[8], w2[8];
        *(f32x4*)(w0) = *(const f32x4*)(cw + c8); *(f32x4*)(w0 + 4) = *(const f32x4*)(cw + c8 + 4);
        *(f32x4*)(w1) = *(const f32x4*)(cw + DI + c8); *(f32x4*)(w1 + 4) = *(const f32x4*)(cw + DI + c8 + 4);
        *(f32x4*)(w2) = *(const f32x4*)(cw + 2 * DI + c8); *(f32x4*)(w2 + 4) = *(const f32x4*)(cw + 2 * DI + c8 + 4);
#pragma unroll
        for (int e = 0; e < 8; ++e) { const float s = w0[e] * up[e] + w1[e] * uu[e] + w2[e] * un[e]; y[e] = silu_f(s); }
        *(u32x4*)(UC + (size_t)r * DI + c8) = pack8(y);
    }
}
__device__ __forceinline__ void phase_gating(int j, int wv) {
    const Params P = load_params();
    const int tid = opaque_tid(wv), lane = tid & 63, gw = blockIdx.x * 8 + (tid >> 6), NGW = gridDim.x * 8;
    unsigned char* ws = opq(P.ws); const float* mng = opq(P.m_norm_g) + (size_t)j * DI; const float* msk = opq(P.m_skip) + (size_t)j * DI;
    const bf16_t* QKV = (const bf16_t*)(ws + WS_QKV); const bf16_t* UZO = (const bf16_t*)(ws + WS_BIG); const bf16_t* UC = (const bf16_t*)(ws + WS_UC);
    bf16_t* Y = (bf16_t*)(ws + WS_KT);
    u32x4 nhf, nhb, nzz, noo, nuc;
#define GATE_LOAD(IT) { const int r_ = (IT) >> 2, c_ = ((IT) & 3) * 512 + 8 * lane; \
        nhf = *(const u32x4*)(QKV + (size_t)r_ * 6144 + 2048 + c_); nhb = *(const u32x4*)(QKV + (size_t)r_ * 6144 + 4096 + c_); \
        nzz = *(const u32x4*)(UZO + (size_t)r_ * 6144 + 2048 + c_); noo = *(const u32x4*)(UZO + (size_t)r_ * 6144 + 4096 + c_); nuc = *(const u32x4*)(UC + (size_t)r_ * DI + c_); }
    if (gw < RG * 4) GATE_LOAD(gw)
    for (int it = gw; it < RG * 4; it += NGW) {
        const int r = it >> 2, h = it & 3, c0 = h * 512 + 8 * lane;
        float hf[8], hb[8], zz[8], oo[8], uc[8], y[8];
        unpack8(nhf, hf); unpack8(nhb, hb); unpack8(nzz, zz); unpack8(noo, oo); unpack8(nuc, uc);
        { const int itn = (it + NGW < RG * 4) ? it + NGW : it; GATE_LOAD(itn) }
        float s = 0.f;
#pragma unroll
        for (int e = 0; e < 8; ++e) { hf[e] += hb[e]; s += hf[e]; }
        const float mean = wave_sum(s, lane) * (1.f / DH); float s2 = 0.f;
#pragma unroll
        for (int e = 0; e < 8; ++e) { hf[e] -= mean; s2 += hf[e] * hf[e]; }
        const float rstd = rsqrtf(wave_sum(s2, lane) * (1.f / DH) + EPSV);
        float ng[8], sk[8];
        *(f32x4*)(ng) = *(const f32x4*)(mng + c0); *(f32x4*)(ng + 4) = *(const f32x4*)(mng + c0 + 4);
        *(f32x4*)(sk) = *(const f32x4*)(msk + c0); *(f32x4*)(sk + 4) = *(const f32x4*)(msk + c0 + 4);
#pragma unroll
        for (int e = 0; e < 8; ++e) y[e] = (sigmoid_f(oo[e]) * (hf[e] * rstd * ng[e]) + sk[e] * uc[e]) * silu_f(zz[e]);
        *(u32x4*)(Y + (size_t)r * DI + c0) = pack8(y);
    }
#undef GATE_LOAD
}
__device__ __forceinline__ void phase_final(int r0, int r1, bool light, int wv) {
    if (light && blockIdx.x < 144) return;
    const Params P = load_params();
    const int tid = opaque_tid(wv), lane = tid & 63, gw = (light ? (int)blockIdx.x - 144 : (int)blockIdx.x) * 8 + (tid >> 6), NGW = (light ? 112 : (int)gridDim.x) * 8;
    float* outp = opq(P.out); const float* fg = opq(P.final_g);
    for (int r = r0 + gw; r < r1; r += NGW) {
        float* xr = outp + (size_t)r * DM;
        f32x4 xv[4]; float ss = 0.f;
#pragma unroll
        for (int q = 0; q < 4; ++q) { xv[q] = *(const f32x4*)(xr + 4 * lane + 256 * q); ss += (xv[q][0] * xv[q][0] + xv[q][1] * xv[q][1]) + (xv[q][2] * xv[q][2] + xv[q][3] * xv[q][3]); }
        const float rstd = rsqrtf(wave_sum(ss, lane) * (1.f / DM) + EPSV);
#pragma unroll
        for (int q = 0; q < 4; ++q) { const f32x4 gv = *(const f32x4*)(fg + 4 * lane + 256 * q); *(f32x4*)(xr + 4 * lane + 256 * q) = xv[q] * rstd * gv; }
    }
}

__device__ __forceinline__ void phase_gatetab(LAS unsigned char* lds, int j, int wv) {
    if (blockIdx.x < 144 || blockIdx.x >= 176) return;
    const Params P = load_params();
    const int tid = opaque_tid(wv), lane = tid & 63, w = __builtin_amdgcn_readfirstlane(tid >> 6);
    unsigned char* ws = P.ws;
    const int sidx = (int)blockIdx.x - 144, dir = sidx & 1, h = (sidx >> 1) & 3, bl = sidx >> 3;
    const float* gt = (const float*)(ws + WS_GATESP) + (size_t)(bl * TT) * 16 + h + (dir ? 8 : 0);
    LAS float* tA = (LAS float*)(lds + 102400); LAS float* tPM = tA + TT; LAS float* tBC = tA + 2 * TT;
    LAS float* cMP = (LAS float*)(lds + 102400 + 3 * TT * 4); LAS float* cM63 = cMP + 36; LAS float* cBL = cMP + 72; LAS float* cAM = cMP + 108;
        {
            const float bi_ = P.m_b_gate[j * 16 + (dir ? 8 : 0) + h], bf_ = P.m_b_gate[j * 16 + (dir ? 8 : 0) + 4 + h];
            for (int cc = w; cc < 36; cc += 8) { const int ac = dir ? (cc < 4 ? 3 - cc : 39 - cc) : cc, t = dir ? 63 - lane : lane, row = ac * 64 + t;
                const float* gp = gt + (size_t)row * 16; float si = bi_, sf = bf_;
#pragma unroll
                for (int ks_ = 0; ks_ < 8; ++ks_) { si += gp[(size_t)ks_ * RG * 16]; sf += gp[(size_t)ks_ * RG * 16 + 4]; }
                const float fp = sf; const float lf = fminf(fp, 0.f) - log1pf(__expf(-fabsf(fp)));
#define DPP_F(oldv, src, ctrl, rmask) __int_as_float(__builtin_amdgcn_update_dpp(__float_as_int(oldv), __float_as_int(src), ctrl, rmask, 0xf, false))
                float bc = lf;
                bc += DPP_F(0.f, bc, 0x111, 0xf); bc += DPP_F(0.f, bc, 0x112, 0xf); bc += DPP_F(0.f, bc, 0x114, 0xf); bc += DPP_F(0.f, bc, 0x118, 0xf);
                bc += DPP_F(0.f, bc, 0x142, 0xa); bc += DPP_F(0.f, bc, 0x143, 0xc);
                const float av = si - bc;
                const float ninf = -__builtin_inff();
                float pmx = av;
                pmx = fmaxf(pmx, DPP_F(ninf, pmx, 0x111, 0xf)); pmx = fmaxf(pmx, DPP_F(ninf, pmx, 0x112, 0xf)); pmx = fmaxf(pmx, DPP_F(ninf, pmx, 0x114, 0xf)); pmx = fmaxf(pmx, DPP_F(ninf, pmx, 0x118, 0xf));
                pmx = fmaxf(pmx, DPP_F(ninf, pmx, 0x142, 0xa)); pmx = fmaxf(pmx, DPP_F(ninf, pmx, 0x143, 0xc));
#undef DPP_F
                tA[row] = av; tPM[row] = pmx; tBC[row] = bc;
                if (lane == 63) { cBL[cc] = bc; cAM[cc] = pmx; } }
            __syncthreads();
            if (tid == 0) { float mp = 0.f; for (int cc = 0; cc < 36; ++cc) { cMP[cc] = mp; const float M63 = fmaxf(mp, cAM[cc]); cM63[cc] = M63; mp = cBL[cc] + M63; } }
            __syncthreads();
        }
    { char* gdst = (char*)(ws + WS_GTAB) + (size_t)sidx * 28224; const LAS f32x4* lsrc = (const LAS f32x4*)tA;
      for (int i = tid; i < 7056 / 4; i += 512) { unsigned off = (unsigned)i * 16u; asm volatile("" : "+v"(off)); *(f32x4*)(gdst + off) = lsrc[i]; } }
    __syncthreads();
}

constexpr int SC_R = 0, SC_V = 81920, SC_VW = 91136, SC_TAB = 100352;
__device__ __forceinline__ bf16x8 mk_frag(unsigned a, unsigned b, unsigned c, unsigned d) { u32x4 t; t.x = a; t.y = b; t.z = c; t.w = d; return __builtin_bit_cast(bf16x8, t); }
__device__ __forceinline__ void phase_scan(LAS unsigned char* lds, int j, int wv) {
    const Params P = load_params();
    const int tid = opaque_tid(wv);
    const int lane = tid & 63, w = __builtin_amdgcn_readfirstlane(tid >> 6), lr = lane & 15, lq = lane >> 4;
    const unsigned qoff = (unsigned)(lr * 6144 + 64 * w + 4 * lq) * 2u;
    const unsigned koff = (unsigned)((64 * w + lr) * TT + 8 * lq) * 2u;
    const unsigned hoff = (unsigned)((4 * lq) * 6144 + lr) * 2u;
    unsigned char* ws = opq(P.ws);
    bf16_t* QKV = (bf16_t*)(ws + WS_QKV); const bf16_t* KT = (const bf16_t*)(ws + WS_KT); const bf16_t* VT = (const bf16_t*)(ws + WS_VT);
    const float* QKR = (const float*)(ws + WS_QKR); const float* GATES = (const float*)(ws + WS_GATESP);
    LAS f32x4* R = (LAS f32x4*)(lds + SC_R);
    LAS bf16_t* sV = (LAS bf16_t*)(lds + SC_V); LAS bf16_t* sVW = (LAS bf16_t*)(lds + SC_VW);
    LAS u32x4* sS = (LAS u32x4*)(lds + 131072);
    LAS float* tA = (LAS float*)(lds + 102400); LAS float* tPM = tA + TT; LAS float* tBC = tA + 2 * TT;
    LAS float* cMP = (LAS float*)(lds + 102400 + 3 * TT * 4); LAS float* cM63 = cMP + 36; LAS float* cBL = cMP + 72; LAS float* cAM = cMP + 108;
    LAS float* tabA = (LAS float*)(lds + SC_TAB); LAS float* tabM = tabA + 64; LAS float* tabWI = tabA + 128; LAS float* tabFL = tabA + 192; LAS float* tabWS = tabA + 256; LAS float* scal = tabA + 320;
    for (int uid = blockIdx.x; uid < GB * NH * 2 * 8; uid += gridDim.x) {
        const int xcd_ = uid & 7, yy_ = uid >> 3, pair_ = xcd_ * 2 + (yy_ >> 4);
        const int es = yy_ & 7, dir = (yy_ >> 3) & 1, h = pair_ & 3, bl = pair_ >> 2;
        const bf16_t* qb = QKV + (size_t)(bl * TT) * 6144 + h * 512;
        const bf16_t* kTb = KT + (size_t)((bl * 4 + h) * 512) * TT;
        const bf16_t* vTb = VT + (size_t)((bl * 4 + h) * 512 + es * 64) * TT;
        const float* qkr = QKR + (size_t)((bl * 4 + h) * TT) * 64;
        const float* gt = GATES + (size_t)(bl * TT) * 16 + h + (dir ? 8 : 0);
        bf16_t* hout = QKV + (size_t)(bl * TT) * 6144 + (dir ? 4096 : 2048) + h * 512 + es * 64;
        f32x4 C[4][5];
#pragma unroll
        for (int a = 0; a < 4; ++a)
#pragma unroll
            for (int b = 0; b < 5; ++b) C[a][b] = (f32x4){0.f, 0.f, 0.f, 0.f};
        { const char* gsrc = (const char*)(ws + WS_GTAB) + (size_t)((bl * 4 + h) * 2 + dir) * 28224; LAS f32x4* ldst = (LAS f32x4*)tA;
          for (int i = tid; i < 7056 / 4; i += 512) { unsigned off = (unsigned)i * 16u; asm volatile("" : "+v"(off)); ldst[i] = *(const f32x4*)(gsrc + off); }
          __syncthreads(); }
        bf16x8 qa0[4], qa1[4];
#define SCAN_LOAD_Q0(T0) { _Pragma("unroll") for (int jt = 0; jt < 4; ++jt) { const char* p_ = (const char*)qb + (size_t)((T0) + 16 * jt) * 12288 + qoff; \
            const u32x2 lo_ = *(const u32x2*)p_, hi_ = *(const u32x2*)(p_ + 32); qa0[jt] = mk_frag(lo_.x, lo_.y, hi_.x, hi_.y); \
            const u32x2 lo2_ = *(const u32x2*)(p_ + 64), hi2_ = *(const u32x2*)(p_ + 96); qa1[jt] = mk_frag(lo2_.x, lo2_.y, hi2_.x, hi2_.y); } }
        SCAN_LOAD_Q0(dir ? 3 * 64 : 0)
        for (int cc = 0; cc < 36; ++cc) {
            const int ac = dir ? (cc < 4 ? 3 - cc : 39 - cc) : cc, t0 = ac * 64;
            const int ccn = cc < 35 ? cc + 1 : 35, acn = dir ? (ccn < 4 ? 3 - ccn : 39 - ccn) : ccn, t0n = acn * 64;
            if (w == 7) { const float mpc = cMP[cc], M63c = cM63[cc]; const float av_ = tA[t0 + lane], Mi_ = fmaxf(mpc, tPM[t0 + lane]);
                tabWS[lane] = __expf(av_ - M63c); tabWI[lane] = __expf(mpc - Mi_); tabFL[lane] = __expf(-(tBC[t0 + lane] + Mi_)); }
#define SCAN_PASS(E0, NE) { f32x4 Pt[4][NE]; \
                _Pragma("unroll") for (int ks = 0; ks < 2; ++ks) { \
                  _Pragma("unroll") for (int e = 0; e < NE; ++e) { const f32x4 c0 = C[2 * ks][E0 + e], c1 = C[2 * ks + 1][E0 + e]; \
                    const bf16x8 cb = mk_frag(cvt_pk_bf16(c0[0], c0[1]), cvt_pk_bf16(c0[2], c0[3]), cvt_pk_bf16(c1[0], c1[1]), cvt_pk_bf16(c1[2], c1[3])); \
                    _Pragma("unroll") for (int jt = 0; jt < 4; ++jt) Pt[jt][e] = __builtin_amdgcn_mfma_f32_16x16x32_bf16(ks == 0 ? qa0[jt] : qa1[jt], cb, ks == 0 ? (f32x4){0.f, 0.f, 0.f, 0.f} : Pt[jt][e], 0, 0, 0); } } \
                if (w >= 4) { _Pragma("unroll") for (int jt = 0; jt < 4; ++jt) _Pragma("unroll") for (int e = 0; e < NE; ++e) R[((w - 4) * 20 + jt * 5 + E0 + e) * 64 + lane] = Pt[jt][e]; } \
                __syncthreads(); \
                if (w < 4) { _Pragma("unroll") for (int jt = 0; jt < 4; ++jt) _Pragma("unroll") for (int e = 0; e < NE; ++e) { const int idx = (w * 20 + jt * 5 + E0 + e) * 64 + lane; const f32x4 sres = Pt[jt][e] + R[idx]; R[idx] = sres; } } }
            SCAN_PASS(0, 2)
            if (w >= 4) {
#pragma unroll
                for (int hlf = 0; hlf < 2; ++hlf) { const int it_ = (tid - 256) + 256 * hlf, ve = it_ >> 3, vs = (it_ & 7) * 8;
                    const u32x4 vraw = *(const u32x4*)(vTb + (size_t)ve * TT + t0 + vs);
                    float vf[8], wv[8]; unpack8(vraw, vf);
                    const f32x4 w0 = *(const LAS f32x4*)(tabWS + vs), w1 = *(const LAS f32x4*)(tabWS + vs + 4);
#pragma unroll
                    for (int e = 0; e < 4; ++e) { wv[e] = vf[e] * w0[e]; wv[4 + e] = vf[4 + e] * w1[e]; }
                    *(LAS u32x4*)(sV + ve * 72 + vs) = vraw;
                    *(LAS u32x4*)(sVW + ve * 72 + vs) = pack8(wv); }
            }
            SCAN_PASS(2, 3)
#undef SCAN_PASS
            if (w >= 4) {
                int jr = 16 * (w - 4) + lr; asm volatile("" : "+v"(jr));
                const float Mj = fmaxf(cMP[cc], tPM[t0 + jr]);
#pragma unroll
                for (int ks = 0; ks < 2; ++ks) { const int s0 = 32 * ks + 8 * lq; const float* qp = qkr + (size_t)(t0 + jr) * 64 + s0;
                    const f32x4 q0 = *(const f32x4*)qp, q1 = *(const f32x4*)(qp + 4);
                    const f32x4 a0 = *(const LAS f32x4*)(tA + t0 + s0), a1 = *(const LAS f32x4*)(tA + t0 + s0 + 4);
                    float sv[8];
#pragma unroll
                    for (int e = 0; e < 4; ++e) { const int sA = s0 + e, sB = s0 + 4 + e;
                        const bool vA = dir ? (sA >= jr) : (sA <= jr), vB = dir ? (sB >= jr) : (sB <= jr);
                        sv[e] = vA ? q0[e] * __expf(a0[e] - Mj) : 0.f; sv[4 + e] = vB ? q1[e] * __expf(a1[e] - Mj) : 0.f; }
                    sS[((w - 4) * 2 + ks) * 64 + lane] = pack8(sv); }
            }
            bf16x8 ka[4][2];
#pragma unroll
            for (int dt = 0; dt < 4; ++dt)
#pragma unroll
                for (int ks = 0; ks < 2; ++ks) ka[dt][ks] = *(const bf16x8*)((const char*)kTb + (size_t)(16 * dt * TT + t0 + 32 * ks) * 2 + koff);
            const int jt_f = w >> 1, eh = w & 1;
            __syncthreads();
            {
                const int jt = jt_f;
                bf16x8 sa[2];
#pragma unroll
                for (int ks = 0; ks < 2; ++ks) { const u32x4 pk = sS[(jt * 2 + ks) * 64 + lane]; sa[ks] = __builtin_bit_cast(bf16x8, pk); }
                const unsigned one2 = (lr == 0) ? 0x3F803F80u : 0u;
                const bf16x8 ones = mk_frag(one2, one2, one2, one2);
                const f32x4 wi = *(const LAS f32x4*)(tabWI + 16 * jt + 4 * lq), fl = *(const LAS f32x4*)(tabFL + 16 * jt + 4 * lq);
                f32x4 num[3];
#pragma unroll
                for (int x = 0; x < 3; ++x) { const int et = (x < 2) ? 2 * eh + x : 4, tile = jt * 5 + et;
                    const f32x4 inter = (R[(0 * 20 + tile) * 64 + lane] + R[(1 * 20 + tile) * 64 + lane]) + (R[(2 * 20 + tile) * 64 + lane] + R[(3 * 20 + tile) * 64 + lane]);
                    f32x4 it = (f32x4){0.f, 0.f, 0.f, 0.f};
#pragma unroll
                    for (int ks = 0; ks < 2; ++ks) { const bf16x8 vb = (x < 2) ? *(const LAS bf16x8*)(sV + (16 * et + lr) * 72 + 32 * ks + 8 * lq) : ones;
                        it = __builtin_amdgcn_mfma_f32_16x16x32_bf16(sa[ks], vb, it, 0, 0, 0); }
                    num[x] = wi * inter + it; }
                f32x4 den;
#pragma unroll
                for (int i = 0; i < 4; ++i) den[i] = fmaxf(fabsf(lane_read(num[2][i], lane & 48)), fl[i]);
#pragma unroll
                for (int x = 0; x < 2; ++x) { const int et = 2 * eh + x;
#pragma unroll
                    for (int i = 0; i < 4; ++i) { const float hv = num[x][i] * __builtin_amdgcn_rcpf(den[i]);
                        *(bf16_t*)((char*)hout + ((size_t)(t0 + 16 * jt + i) * 6144 + 16 * et) * 2 + hoff) = (bf16_t)(cvt_pk_bf16(hv, 0.f) & 0xffffu); } }
            }
            SCAN_LOAD_Q0(t0n)
            {
                const float wd = __expf(cMP[cc] - cM63[cc]);
#pragma unroll
                for (int dt = 0; dt < 4; ++dt)
#pragma unroll
                    for (int et = 0; et < 5; ++et) C[dt][et] = C[dt][et] * wd;
#pragma unroll
                for (int ks = 0; ks < 2; ++ks) {
#pragma unroll
                    for (int et = 0; et < 4; ++et) { const bf16x8 vwb = *(const LAS bf16x8*)(sVW + (16 * et + lr) * 72 + 32 * ks + 8 * lq);
#pragma unroll
                        for (int dt = 0; dt < 4; ++dt) C[dt][et] = __builtin_amdgcn_mfma_f32_16x16x32_bf16(ka[dt][ks], vwb, C[dt][et], 0, 0, 0); }
                    const f32x4 w0 = *(const LAS f32x4*)(tabWS + 32 * ks + 8 * lq), w1 = *(const LAS f32x4*)(tabWS + 32 * ks + 8 * lq + 4);
                    u32x4 wp; wp.x = cvt_pk_bf16(w0[0], w0[1]); wp.y = cvt_pk_bf16(w0[2], w0[3]); wp.z = cvt_pk_bf16(w1[0], w1[1]); wp.w = cvt_pk_bf16(w1[2], w1[3]);
                    if (lr != 0) { wp.x = 0u; wp.y = 0u; wp.z = 0u; wp.w = 0u; }
                    const bf16x8 wb = __builtin_bit_cast(bf16x8, wp);
#pragma unroll
                    for (int dt = 0; dt < 4; ++dt) C[dt][4] = __builtin_amdgcn_mfma_f32_16x16x32_bf16(ka[dt][ks], wb, C[dt][4], 0, 0, 0);
                }
            }
            __syncthreads();
        }
    }
}

__device__ __forceinline__ void run_in_gemm(LAS unsigned char* lds, int j, bool conv, int coff, int g, int buf, int wv) {
    const Params P = load_params(); unsigned char* ws = P.ws;
    if (conv) {
        PhConvFused ph; ph.K = DM; ph.lda = DM; ph.ldb = DM; ph.nM = MT; ph.nN = 32; ph.coff = coff; ph.A = (const bf16_t*)(ws + (buf ? WS_HX2 : WS_HX)); ph.B = (const bf16_t*)(ws + WS_CWIN) + (size_t)j * 8192 * DM;
        ph.BIG = (bf16_t*)(ws + WS_BIG); ph.Y = (bf16_t*)(ws + ((g & 1) ? WS_KT : WS_VT)); ph.cw = P.conv_w + (size_t)j * 3 * DI;
        gemm_phase(lds, ph, wv);
    } else {
        PhPlain ph; ph.K = DM; ph.lda = DM; ph.ldb = DM; ph.nM = MT; ph.coff = coff; ph.A = (const bf16_t*)(ws + (buf ? WS_HX2 : WS_HX)); ph.O = (bf16_t*)(ws + WS_BIG);
        ph.nN = 24; ph.B = (const bf16_t*)(ws + WS_MWIN) + (size_t)j * 6144 * DM; ph.ldc = 6144;
        gemm_phase(lds, ph, wv);
    }
}
__device__ __forceinline__ void run_out_gemm(LAS unsigned char* lds, int layer, int g, int wv) {
    const Params P = load_params(); unsigned char* ws = P.ws; const int j = layer >> 1;
    PhResid ph; ph.K = DI; ph.lda = DI; ph.ldb = DI; ph.nM = MT; ph.nN = 4; ph.coff = 0; ph.A = (const bf16_t*)(ws + (((layer & 1) || (g & 1)) ? WS_KT : WS_VT));
    ph.B = ((layer & 1) ? (const bf16_t*)(ws + WS_MWOUT) : (const bf16_t*)(ws + WS_CWOUT)) + (size_t)j * DM * DI;
    ph.xin_x = (layer == 0) ? P.x : P.out; ph.xin_c = (layer == 0) ? P.ctx : (const float*)(ws + WS_XC); ph.xout_x = P.out; ph.xout_c = (float*)(ws + WS_XC);
    ph.mod = (const float*)(ws + WS_MOD) + (size_t)layer * 17 * 3072; ph.g = g;
    gemm_phase(lds, ph, wv);
}
__device__ __forceinline__ void run_qkv_nat(LAS unsigned char* lds, int j, bool isv, int wv) {
    const Params P = load_params(); unsigned char* ws = P.ws;
    PhQKV ph; ph.K = DH; ph.ldb = DH; ph.nM = MT; ph.W = (const bf16_t*)(ws + WS_MWQKV) + (size_t)j * 3 * 4 * DH * DH; ph.O = (bf16_t*)(ws + WS_QKV);
    if (!isv) { ph.lda = DI; ph.nN = 16; ph.coff = 0; ph.A = (const bf16_t*)(ws + WS_UC); ph.which0 = 0; }
    else { ph.lda = 6144; ph.nN = 8; ph.coff = 256 - 64; ph.A = (const bf16_t*)(ws + WS_BIG); ph.which0 = 2; }
    gemm_phase(lds, ph, wv);
}
__device__ __forceinline__ void run_tr(LAS unsigned char* lds, int j, bool isv, int wv) {
    const Params P = load_params(); unsigned char* ws = P.ws;
    PhTr ph; ph.K = DH; ph.lda = DH; ph.nM = 8; ph.nN = MT;
    const bf16_t* WQKV = (const bf16_t*)(ws + WS_MWQKV) + (size_t)j * 3 * 4 * DH * DH;
    if (!isv) { ph.ldb = DI; ph.coff = 192; ph.W = WQKV + (size_t)1 * 4 * DH * DH; ph.Act = (const bf16_t*)(ws + WS_UC); ph.OT = (bf16_t*)(ws + WS_KT); ph.scale = 0.044194173824159216f; }
    else { ph.ldb = 6144; ph.coff = 160; ph.W = WQKV + (size_t)2 * 4 * DH * DH; ph.Act = (const bf16_t*)(ws + WS_BIG); ph.OT = (bf16_t*)(ws + WS_VT); ph.scale = 1.f; }
    gemm_phase(lds, ph, wv);
}
__device__ __forceinline__ void run_qk(LAS unsigned char* lds, int wv) {
    const Params P = load_params(); unsigned char* ws = P.ws;
    PhQK ph; ph.K = DH; ph.lda = 6144; ph.ldb = 6144; ph.nM = GB * NH * 9; ph.nN = 1; ph.coff = 0; ph.QKV = (const bf16_t*)(ws + WS_QKV); ph.QKR = (float*)(ws + WS_QKR);
    gemm_phase(lds, ph, wv);
}
__device__ __forceinline__ void run_gates(LAS unsigned char* lds, int j, int part, int wv) {
    const Params P = load_params(); unsigned char* ws = P.ws;
    PhGates ph; ph.K = 512; ph.ldb = 2048; ph.nM = MT; ph.nN = 4; ph.poff = 4 * part;
    if (part == 0) { ph.A = (const bf16_t*)(ws + WS_UC); ph.lda = DI; ph.coff = 128; } else { ph.A = (const bf16_t*)(ws + WS_BIG); ph.lda = 6144; ph.coff = 144; }
    ph.WG = (const bf16_t*)(ws + WS_MWG) + (size_t)(j * 2 + part) * 256 * 2048; ph.GATESP = (float*)(ws + WS_GATESP);
    gemm_phase(lds, ph, wv);
}

#define XB_TMO      128
#define XB_XCNT(j)  (256  + 64 * (j))
#define XB_XSUB(j)  (1280 + 64 * (j))
#define XB_XGEN(j)  (2304 + 64 * (j))
#define XB_TOP      3328
#define XB_TOPGEN   3392
#define XCD_BAR_WORDS 3456
#define XB_SPIN_CAP (1u << 22)
__device__ __forceinline__ unsigned xb_ld(unsigned* p)              { return __hip_atomic_load(p, __ATOMIC_RELAXED, __HIP_MEMORY_SCOPE_AGENT); }
__device__ __forceinline__ unsigned xb_add(unsigned* p, unsigned v) { return __hip_atomic_fetch_add(p, v, __ATOMIC_RELAXED, __HIP_MEMORY_SCOPE_AGENT); }
__device__ __forceinline__ unsigned xb_xcc_id() { return (unsigned)__builtin_amdgcn_s_getreg((3 << 11) | 20) & 0xFu; }
#define XB_SPIN(cond, bar) do { unsigned _sp = 0; while (cond) { __builtin_amdgcn_s_sleep(1); \
    if ((++_sp & 255u) == 0u) { if (xb_ld(&(bar)[XB_TMO])) break; if (_sp > XB_SPIN_CAP) { atomicAdd(&(bar)[XB_TMO], 1u); break; } } } } while (0)
struct XcdBarrier { unsigned* bar; unsigned x; volatile LAS unsigned* st; };
__device__ __forceinline__ XcdBarrier xcd_barrier_post(unsigned* bar, volatile LAS unsigned* st) {
    XcdBarrier b; b.bar = bar; b.x = xb_xcc_id(); b.st = st;
    if (threadIdx.x == 0) (void)xb_add(&bar[XB_XCNT(b.x)], 1u);
    return b;
}
__device__ __forceinline__ void xcd_barrier_complete(unsigned* bar, unsigned x, unsigned& nloc, unsigned& nx) {
    const unsigned G = gridDim.x * gridDim.y * gridDim.z;
    unsigned sum, cnt, mine, sp = 0u;
    for (;;) {
        sum = 0u; cnt = 0u; mine = 0u;
#pragma unroll
        for (unsigned j = 0; j < 16; ++j) { const unsigned c = xb_ld(&bar[XB_XCNT(j)]); sum += c; cnt += (c > 0u) ? 1u : 0u; mine = (j == x) ? c : mine; }
        if (sum == G) break;
        __builtin_amdgcn_s_sleep(1);
        if ((++sp & 255u) == 0u) { if (xb_ld(&bar[XB_TMO])) break; if (sp > XB_SPIN_CAP) { atomicAdd(&bar[XB_TMO], 1u); break; } }
    }
    nloc = mine > 0u ? mine : 1u; nx = cnt > 0u ? cnt : 1u;
}
__device__ __forceinline__ void xcd_barrier(const XcdBarrier& b, int wv) {
    asm volatile("s_waitcnt vmcnt(0)" ::: "memory");
    __syncthreads();
    if (opaque_tid(wv) == 0) {
        unsigned* bar = b.bar;
        __builtin_amdgcn_s_waitcnt(0);
        unsigned nloc = b.st[0], nx = b.st[1];
        if (nloc == 0u) { xcd_barrier_complete(bar, b.x, nloc, nx); b.st[0] = nloc; b.st[1] = nx; }
        const unsigned old = xb_add(&bar[XB_XSUB(b.x)], 1u);
        const unsigned gen = old / nloc;
        if (old + 1u == (gen + 1u) * nloc) {
            __builtin_amdgcn_fence(__ATOMIC_RELEASE, "agent");
            asm volatile("s_waitcnt vmcnt(0)" ::: "memory");
            const unsigned og = xb_add(&bar[XB_TOP], 1u);
            const unsigned tg = og / nx;
            if (og + 1u == (tg + 1u) * nx) xb_add(&bar[XB_TOPGEN], 1u);
            else XB_SPIN(xb_ld(&bar[XB_TOPGEN]) == tg, bar);
            __builtin_amdgcn_fence(__ATOMIC_ACQUIRE, "agent");
            xb_add(&bar[XB_XGEN(b.x)], 1u);
            asm volatile("s_waitcnt vmcnt(0)" ::: "memory");
        } else {
            XB_SPIN(xb_ld(&bar[XB_XGEN(b.x)]) == gen, bar);
            __builtin_amdgcn_fence(__ATOMIC_ACQUIRE, "agent");
            asm volatile("s_waitcnt vmcnt(0)" ::: "memory");
        }
    }
    __syncthreads();
}

__global__ void __launch_bounds__(512, 2) hybrid_fwd(Params Punused) {
    extern __shared__ __attribute__((aligned(16))) unsigned char lds_raw[];
    LAS unsigned char* lds = (LAS unsigned char*)lds_raw;
    cg::grid_group grid = cg::this_grid();
    const int wv = __builtin_amdgcn_readfirstlane((int)(threadIdx.x >> 6));
    volatile LAS unsigned* bst = (volatile LAS unsigned*)(lds + LDS_BST);
    if (threadIdx.x < 4) bst[threadIdx.x] = 0u;
    __syncthreads();
    { const Params P0 = load_params(); (void)xcd_barrier_post((unsigned*)(P0.ws + WS_BAR), bst); }
#define GSYNC() do { const Params Pb = load_params(); XcdBarrier xb_; xb_.bar = (unsigned*)(Pb.ws + WS_BAR); xb_.x = xb_xcc_id(); xb_.st = (volatile LAS unsigned*)(lds + LDS_BST); xcd_barrier(xb_, wv); } while (0)
    phase_prep(lds, wv);
    grid.sync();
    phase_modreduce(wv);
    GSYNC();
    phase_modulate(0, 0, 0, false, wv);
    GSYNC();
    run_in_gemm(lds, 0, true, 0, 0, 0, wv);
    phase_modulate(0, 1, 1, true, wv);
    GSYNC();
    for (int st = 0; st < 16; ++st) {
        const int layer = st >> 2, g = st & 3, j = st >> 3, nst = st + 1;
        if ((layer & 1) == 0) {
            phase_convmix(j, g, wv);
            GSYNC();
        } else {
            phase_uc(j, wv);
            GSYNC();
            run_qkv_nat(lds, j, false, wv); run_tr(lds, j, false, wv); run_tr(lds, j, true, wv); run_gates(lds, j, 0, wv); run_gates(lds, j, 1, wv);
            GSYNC();
            run_qk(lds, wv); phase_gatetab(lds, j, wv);
            GSYNC();
            phase_scan(lds, j, wv);
            GSYNC();
            phase_gating(j, wv);
            GSYNC();
        }
        run_out_gemm(lds, layer, g, wv);
        if (nst < 16) run_in_gemm(lds, nst >> 3, ((nst >> 2) & 1) == 0, 256 - 144, nst & 3, nst & 1, wv);
        if (st == 15) phase_final(0, 3 * GB * SEQ, true, wv);
        if (st + 2 < 16) phase_modulate((st + 2) >> 2, (st + 2) & 3, st & 1, true, wv);
        GSYNC();
    }
    phase_final(3 * GB * SEQ, NB * SEQ, false, wv);
}

extern "C" void kernel_launch(void* const* d_in, const int* in_sizes, int n_in, void* d_out, int out_size, void* d_ws, size_t ws_size, hipStream_t stream) {
    static int grid_blocks = 0;
    if (grid_blocks == 0) {
        if (n_in != 21 || out_size != NB * SEQ * DM || ws_size < WS_END) { fprintf(stderr, "kernel_launch: unexpected shapes (n_in %d out %d ws %zu)\n", n_in, out_size, ws_size); grid_blocks = -1; return; }
        int dev = 0, cus = 0, per_cu = 0;
        if (hipGetDevice(&dev) != hipSuccess || hipDeviceGetAttribute(&cus, hipDeviceAttributeMultiprocessorCount, dev) != hipSuccess) { grid_blocks = -1; return; }
        if (hipFuncSetAttribute((const void*)hybrid_fwd, hipFuncAttributeMaxDynamicSharedMemorySize, LDS_BYTES) != hipSuccess) { fprintf(stderr, "kernel_launch: hipFuncSetAttribute failed\n"); grid_blocks = -1; return; }
        if (hipOccupancyMaxActiveBlocksPerMultiprocessor(&per_cu, (const void*)hybrid_fwd, 512, LDS_BYTES) != hipSuccess || per_cu < 1) { fprintf(stderr, "kernel_launch: occupancy query says %d\n", per_cu); per_cu = 1; }
        (void)hipGetLastError();
        grid_blocks = cus;
    }
    if (grid_blocks < 0) return;
    if (hipMemsetAsync((char*)d_ws + WS_BAR, 0, XCD_BAR_WORDS * sizeof(unsigned), stream) != hipSuccess) { fprintf(stderr, "kernel_launch: memset of the barrier words failed\n"); return; }
    Params p{};
    const float** pp = (const float**)&p;
    for (int i = 0; i < 21; ++i) pp[i] = (const float*)d_in[i];
    p.out = (float*)d_out; p.ws = (unsigned char*)d_ws;
    void* args[] = {&p};
    hipError_t e = hipLaunchCooperativeKernel((const void*)hybrid_fwd, dim3(grid_blocks), dim3(512), args, LDS_BYTES, stream);
    if (e != hipSuccess) fprintf(stderr, "cooperative launch failed: %s (grid %d)\n", hipGetErrorString(e), grid_blocks);
}
```

```cpp
#include <hip/hip_runtime.h>
#include <hip/hip_cooperative_groups.h>
#include <cstdio>
namespace cg = cooperative_groups;

#define LAS __attribute__((address_space(3)))
typedef unsigned short bf16_t;
typedef short bf16x8 __attribute__((ext_vector_type(8)));
typedef float f32x4 __attribute__((ext_vector_type(4)));
typedef unsigned u32x4 __attribute__((ext_vector_type(4)));
typedef unsigned u32x2 __attribute__((ext_vector_type(2)));

constexpr int DM = 1024, DI = 2048, NB = 16, SEQ = 2048, CTXL = 256, TT = 2304  , NH = 4, DH = 512;
constexpr int GB = 4  , RG = GB * TT  , MT = RG / 256  ;
constexpr float EPSV = 1e-6f;
constexpr size_t MIB = 1ull << 20;
constexpr size_t WS_CWIN = 0, WS_CWOUT = 32 * MIB, WS_MWIN = 40 * MIB, WS_MWQKV = 64 * MIB, WS_MWOUT = 76 * MIB, WS_MWG = 84 * MIB,
                 WS_MODP = 90 * MIB, WS_MOD = 97 * MIB, WS_XC = 98 * MIB, WS_HX = 114 * MIB, WS_BIG = 132 * MIB, WS_UC = WS_BIG + 108 * MIB,
                 WS_QKV = 276 * MIB, WS_KT = 384 * MIB, WS_VT = 420 * MIB, WS_QKR = 456 * MIB, WS_GATES = 465 * MIB, WS_BAR = 466 * MIB, WS_GATESP = 468 * MIB  , WS_HX2 = 474 * MIB  , WS_GTAB = 492 * MIB  , WS_END = 493 * MIB;
constexpr int LDS_BST = 139264;
constexpr int LDS_BYTES = LDS_BST + 16;

struct Params {
    const float *x, *c, *ctx, *c_ctx, *norm_g, *mod_w, *mod_b, *conv_w_in, *conv_w, *conv_w_out, *m_w_in, *m_conv_w, *m_wq, *m_wk, *m_wv,
        *m_w_gate, *m_b_gate, *m_norm_g, *m_skip, *m_w_out, *final_g;
    float* out; unsigned char* ws;
};

__device__ __forceinline__ unsigned cvt_pk_bf16(float lo, float hi) { unsigned r; asm volatile("v_cvt_pk_bf16_f32 %0, %1, %2" : "=v"(r) : "v"(lo), "v"(hi)); return r; }
__device__ __forceinline__ float bf_lo(unsigned w) { return __uint_as_float(w << 16); }
__device__ __forceinline__ float bf_hi(unsigned w) { return __uint_as_float(w & 0xffff0000u); }
__device__ __forceinline__ void unpack8(u32x4 v, float* f) { f[0] = bf_lo(v.x); f[1] = bf_hi(v.x); f[2] = bf_lo(v.y); f[3] = bf_hi(v.y); f[4] = bf_lo(v.z); f[5] = bf_hi(v.z); f[6] = bf_lo(v.w); f[7] = bf_hi(v.w); }
__device__ __forceinline__ u32x4 pack8(const float* f) { u32x4 o; o.x = cvt_pk_bf16(f[0], f[1]); o.y = cvt_pk_bf16(f[2], f[3]); o.z = cvt_pk_bf16(f[4], f[5]); o.w = cvt_pk_bf16(f[6], f[7]); return o; }
__device__ __forceinline__ float silu_f(float v) { return v * __builtin_amdgcn_rcpf(1.f + __expf(-v)); }
__device__ __forceinline__ float sigmoid_f(float v) { return __builtin_amdgcn_rcpf(1.f + __expf(-v)); }
__device__ __forceinline__ float lane_read(float v, int srclane) { return __int_as_float(__builtin_amdgcn_ds_bpermute(srclane << 2, __float_as_int(v))); }
__device__ __forceinline__ float wave_sum(float v, int lane) {
    (void)lane;
#define DPPS(x, ctrl, rmask) __int_as_float(__builtin_amdgcn_update_dpp(0, __float_as_int(x), ctrl, rmask, 0xf, false))
    v += DPPS(v, 0x111, 0xf); v += DPPS(v, 0x112, 0xf); v += DPPS(v, 0x114, 0xf); v += DPPS(v, 0x118, 0xf);
    v += DPPS(v, 0x142, 0xa); v += DPPS(v, 0x143, 0xc);
#undef DPPS
    return __int_as_float(__builtin_amdgcn_readlane(__float_as_int(v), 63));
}
#define LDS_WAIT() asm volatile("s_waitcnt lgkmcnt(0)" ::: "memory")
template <class T> __device__ __forceinline__ T* opq(T* p) { return p; }
#define CAS __attribute__((address_space(4)))
#define GAS __attribute__((address_space(1)))
__device__ __forceinline__ Params load_params() {
    int z = 0; asm volatile("" : "+s"(z));
    const CAS unsigned long long* kp = (const CAS unsigned long long*)((const CAS char*)__builtin_amdgcn_kernarg_segment_ptr() + z);
    Params r;
#define LP_F(i, name) r.name = (const float*)(const GAS float*)kp[i];
    LP_F(0, x) LP_F(1, c) LP_F(2, ctx) LP_F(3, c_ctx) LP_F(4, norm_g) LP_F(5, mod_w) LP_F(6, mod_b) LP_F(7, conv_w_in) LP_F(8, conv_w) LP_F(9, conv_w_out) LP_F(10, m_w_in)
    LP_F(11, m_conv_w) LP_F(12, m_wq) LP_F(13, m_wk) LP_F(14, m_wv) LP_F(15, m_w_gate) LP_F(16, m_b_gate) LP_F(17, m_norm_g) LP_F(18, m_skip) LP_F(19, m_w_out) LP_F(20, final_g)
#undef LP_F
    r.out = (float*)(GAS float*)kp[21]; r.ws = (unsigned char*)(GAS unsigned char*)kp[22];
    return r;
}
__device__ __forceinline__ int opaque_tid(int wv) {
    int ln; asm volatile("v_mbcnt_lo_u32_b32 %0, -1, 0\n\tv_mbcnt_hi_u32_b32 %0, -1, %0" : "=&v"(ln)); return wv * 64 + ln; }

constexpr int BM = 256, BK = 64, HALF = 128, HTB = HALF * BK * 2, NXCD = 8, WGM = 8;
__device__ __forceinline__ int lds_byte(int r, int c) { const int st = (r >> 4) * 2 + (c >> 5), rr = r & 15, cc = c & 31, ob = rr * 64 + cc * 2; return st * 1024 + (ob ^ (((ob >> 9) & 1) << 5)); }
__device__ __forceinline__ void stage_rc(int b, int& R, int& C) { const int st = b / 1024, sb = b % 1024, swz = sb ^ (((sb >> 9) & 1) << 5); R = (st >> 1) * 16 + swz / 64; C = (st & 1) * 32 + (swz % 64) / 2; }
__device__ __forceinline__ int perm32(int rho) { const int n = rho >> 4, i = rho & 15; return 8 * (i >> 2) + 4 * n + (i & 3); }
struct Unit { int pm, pn; };
__device__ __forceinline__ bool tile_next(int i, int G, int c, int nM, int nN, Unit& u, int tailc = 0) {
    const int nwg = nM * nN; long L = (long)i * G + c;
    if (tailc > 0) { const int fr_ = nwg / G, full = fr_ * G, rem = nwg - full;
        if (i >= fr_) { const int k = i - fr_; if (k == 0) { if (c >= tailc) return false; L = full + c; } else if (k == 1) { if (c >= rem - tailc) return false; L = full + tailc + c; } else return false; } }
    if (L >= nwg) return false;
    int wgid = (int)L; { const int q = nwg / NXCD, r = nwg % NXCD, xcd = wgid % NXCD, off = wgid / NXCD; wgid = (xcd < r ? xcd * (q + 1) : r * (q + 1) + (xcd - r) * q) + off; }
    const int nig = WGM * nN, gid = wgid / nig, fm = gid * WGM, gsz = (nM - fm) < WGM ? (nM - fm) : WGM;
    u.pm = fm + ((wgid % nig) % gsz); u.pn = (wgid % nig) / gsz; return true;
}

__device__ __forceinline__ void store_bf16_tile(const f32x4 (&acc)[2][2][4][2], bf16_t* base, size_t ldc, float scale, int wr, int wc, int fr, int fq) {
    bf16_t* p0 = base + (size_t)(wr * 64 + fr) * ldc + wc * 32 + 8 * fq;
#pragma unroll
    for (int ai = 0; ai < 2; ++ai)
#pragma unroll
        for (int m = 0; m < 4; ++m) { bf16_t* rowp = p0 + (size_t)(ai * HALF + m * 16) * ldc;
#pragma unroll
            for (int bj = 0; bj < 2; ++bj) { const f32x4 v0 = acc[ai][bj][m][0] * scale, v1 = acc[ai][bj][m][1] * scale;
                u32x4 w; w.x = cvt_pk_bf16(v0[0], v0[1]); w.y = cvt_pk_bf16(v0[2], v0[3]); w.z = cvt_pk_bf16(v1[0], v1[1]); w.w = cvt_pk_bf16(v1[2], v1[3]);
                *(u32x4*)(rowp + bj * HALF) = w; } }
}

template <class PH>
__device__ __forceinline__ void gemm_phase(LAS unsigned char* lds, const PH& S, int wv) {
    const int tid = opaque_tid(wv);
    const int wid = __builtin_amdgcn_readfirstlane(tid >> 6), lane = tid & 63, wr = wid >> 2, wc = wid & 3, fr = lane & 15, fq = lane >> 4;
    const int K = S.K, nt = K / BK;
    const int G = gridDim.x, cblk = (int)((blockIdx.x + (unsigned)S.coff) % gridDim.x);
    unsigned voffA[2], voffB[2];
#pragma unroll
    for (int i = 0; i < 2; ++i) { int R, C; stage_rc(tid * 16 + i * 8192, R, C); const int Rb = PH::PERM ? ((R & ~31) + perm32(R & 31)) : R;
        voffA[i] = (unsigned)(R * S.lda + C) * 2u; voffB[i] = (unsigned)(Rb * S.ldb + C) * 2u; }
    const size_t kstep = (size_t)(BK * 2);
    const size_t hstepA = (size_t)HALF * S.lda * 2, hstepB = (size_t)HALF * S.ldb * 2;
    const unsigned ldsw = (unsigned)wid * 1024u;
    const int aoff = lds_byte(wr * 64 + fr, fq * 8), boff = lds_byte(wc * 32 + fr, fq * 8);
#define PG8_SA(b, h) (((b) * 2 + (h)) * HTB)
#define PG8_SB(b, h) ((4 + (b) * 2 + (h)) * HTB)
#define PG8_STAGE(bufoff, gbase, voff) do { _Pragma("unroll") for (int _i = 0; _i < 2; ++_i) \
        __builtin_amdgcn_global_load_lds((const unsigned*)((const char*)(gbase) + (voff)[_i]), (LAS unsigned*)(lds + (bufoff) + ldsw + _i * 8192), 16, 0, 0); } while (0)
#define PG8_LDA(dst, b, h) do { _Pragma("unroll") for (int m = 0; m < 4; ++m) _Pragma("unroll") for (int k = 0; k < 2; ++k) dst[m][k] = *(const LAS bf16x8*)(lds + PG8_SA(b, h) + aoff + m * 2048 + k * 1024); } while (0)
#define PG8_LDB(dst, b, h) do { _Pragma("unroll") for (int n = 0; n < 2; ++n) _Pragma("unroll") for (int k = 0; k < 2; ++k) dst[n][k] = *(const LAS bf16x8*)(lds + PG8_SB(b, h) + boff + n * 2048 + k * 1024); } while (0)
#define PG8_MMA(ai, bj, At, Bt) do { __builtin_amdgcn_s_setprio(1); _Pragma("unroll") for (int m = 0; m < 4; ++m) _Pragma("unroll") for (int n = 0; n < 2; ++n) _Pragma("unroll") for (int k = 0; k < 2; ++k) \
        acc[ai][bj][m][n] = __builtin_amdgcn_mfma_f32_16x16x32_bf16(Bt[n][k], At[m][k], acc[ai][bj][m][n], 0, 0, 0); __builtin_amdgcn_s_setprio(0); } while (0)
#define PG8_WAIT_V(n) asm volatile("s_waitcnt vmcnt(" #n ")" ::: "memory")
#define PG8_WAIT_L(n) asm volatile("s_waitcnt lgkmcnt(" #n ")" ::: "memory")
#define PG8_BAR __builtin_amdgcn_s_barrier()
#define PG8_SCHED __builtin_amdgcn_sched_barrier(0)
    Unit cur, nxt; int ui = 0;
    if (!tile_next(0, G, cblk, S.nM, S.nN, cur, S.coff != 0 ? PH::TAILC : 0)) return;
    f32x4 acc[2][2][4][2];
#pragma unroll
    for (int a = 0; a < 2; ++a)
#pragma unroll
        for (int b = 0; b < 2; ++b)
#pragma unroll
            for (int m = 0; m < 4; ++m)
#pragma unroll
                for (int n = 0; n < 2; ++n) acc[a][b][m][n] = (f32x4){0.f, 0.f, 0.f, 0.f};
    bf16x8 At[4][2], B0[2][2], B1[2][2];
    const char* cA = S.aptr(cur); const char* cB = S.bptr(cur);
    PG8_STAGE(PG8_SB(0, 0), cB, voffB); PG8_STAGE(PG8_SA(0, 0), cA, voffA); PG8_STAGE(PG8_SB(0, 1), cB + hstepB, voffB); PG8_STAGE(PG8_SA(0, 1), cA + hstepA, voffA);
    if (wr == 1) PG8_BAR;
    PG8_WAIT_V(4); PG8_BAR;
    PG8_STAGE(PG8_SB(1, 0), cB + kstep, voffB); PG8_STAGE(PG8_SA(1, 0), cA + kstep, voffA); PG8_STAGE(PG8_SB(1, 1), cB + hstepB + kstep, voffB);
    PG8_WAIT_V(6); PG8_BAR;
    for (;;) {
        const bool has_next = tile_next(ui + 1, G, cblk, S.nM, S.nN, nxt, S.coff != 0 ? PH::TAILC : 0);
        const char* nA = has_next ? S.aptr(nxt) : cA; const char* nB = has_next ? S.bptr(nxt) : cB;
        for (int t = 0; t < nt; t += 2) {
            const bool last = (t == nt - 2);
            const char* a1 = cA + (size_t)(t + 1) * kstep;
            const char* a2 = last ? nA : cA + (size_t)(t + 2) * kstep; const char* b2 = last ? nB : cB + (size_t)(t + 2) * kstep;
            const char* a3 = a2 + kstep; const char* b3 = b2 + kstep;
            PG8_LDB(B0, 0, 0); PG8_SCHED; PG8_LDA(At, 0, 0); PG8_STAGE(PG8_SA(1, 1), a1 + hstepA, voffA);
            PG8_WAIT_L(8); PG8_BAR; PG8_WAIT_L(0); PG8_MMA(0, 0, At, B0); PG8_BAR; PG8_SCHED;
            PG8_LDB(B1, 0, 1); PG8_STAGE(PG8_SB(0, 0), b2, voffB);
            PG8_BAR; PG8_WAIT_L(0); PG8_MMA(0, 1, At, B1); PG8_BAR;
            PG8_LDA(At, 0, 1); PG8_STAGE(PG8_SA(0, 0), a2, voffA);
            PG8_BAR; PG8_WAIT_L(0); PG8_MMA(1, 0, At, B0); PG8_BAR; PG8_SCHED;
            PG8_STAGE(PG8_SB(0, 1), b2 + hstepB, voffB);
            PG8_WAIT_V(6); PG8_BAR; PG8_MMA(1, 1, At, B1); PG8_BAR;
            PG8_LDB(B0, 1, 0); PG8_SCHED; PG8_LDA(At, 1, 0); PG8_STAGE(PG8_SA(0, 1), a2 + hstepA, voffA);
            PG8_WAIT_L(8); PG8_BAR; PG8_WAIT_L(0); PG8_MMA(0, 0, At, B0); PG8_BAR; PG8_SCHED;
            PG8_LDB(B1, 1, 1); PG8_STAGE(PG8_SB(1, 0), b3, voffB);
            PG8_BAR; PG8_WAIT_L(0); PG8_MMA(0, 1, At, B1); PG8_BAR;
            PG8_LDA(At, 1, 1); PG8_STAGE(PG8_SA(1, 0), a3, voffA);
            PG8_BAR; PG8_WAIT_L(0); PG8_MMA(1, 0, At, B0); PG8_BAR; PG8_SCHED;
            PG8_STAGE(PG8_SB(1, 1), b3 + hstepB, voffB);
            PG8_WAIT_V(6); PG8_BAR; PG8_MMA(1, 1, At, B1); PG8_BAR;
        }
        S.epi(acc, cur, wr, wc, fr, fq);
        if (!has_next) break;
#pragma unroll
        for (int a = 0; a < 2; ++a)
#pragma unroll
            for (int b = 0; b < 2; ++b)
#pragma unroll
                for (int m = 0; m < 4; ++m)
#pragma unroll
                    for (int n = 0; n < 2; ++n) acc[a][b][m][n] = (f32x4){0.f, 0.f, 0.f, 0.f};
        cur = nxt; cA = nA; cB = nB; ++ui;
    }
    PG8_WAIT_V(0);
    if (wr == 0) PG8_BAR;
    PG8_BAR;
#undef PG8_SA
#undef PG8_SB
#undef PG8_STAGE
#undef PG8_LDA
#undef PG8_LDB
#undef PG8_MMA
#undef PG8_WAIT_V
#undef PG8_WAIT_L
#undef PG8_BAR
#undef PG8_SCHED
}

struct PhPlain {
    static constexpr bool PERM = true; static constexpr int TAILC = 0;
    int K, lda, ldb, nM, nN, coff; const bf16_t *A, *B; bf16_t* O; int ldc;
    __device__ __forceinline__ const char* aptr(const Unit& u) const { return (const char*)(A + (size_t)u.pm * 256 * lda); }
    __device__ __forceinline__ const char* bptr(const Unit& u) const { return (const char*)(B + (size_t)u.pn * 256 * ldb); }
    __device__ __forceinline__ void epi(const f32x4 (&acc)[2][2][4][2], const Unit& u, int wr, int wc, int fr, int fq) const {
        store_bf16_tile(acc, O + (size_t)u.pm * 256 * ldc + (size_t)u.pn * 256, (size_t)ldc, 1.f, wr, wc, fr, fq);
    }
};
#define DPP4(dst, src, ctrl) { _Pragma("unroll") for (int i_ = 0; i_ < 4; ++i_) dst[i_] = __int_as_float(__builtin_amdgcn_update_dpp(0, __float_as_int(src[i_]), ctrl, 0xf, 0xf, false)); }
struct PhConvFused {
    static constexpr bool PERM = true; static constexpr int TAILC = 112;
    int K, lda, ldb, nM, nN, coff; const bf16_t *A, *B; bf16_t* BIG; bf16_t* Y; const float* cw;
    __device__ __forceinline__ const char* aptr(const Unit& u) const { return (const char*)(A + (size_t)u.pm * 256 * lda); }
    __device__ __forceinline__ const char* bptr(const Unit& u) const { return (const char*)(B + (size_t)u.pn * 256 * ldb); }
    __device__ __forceinline__ void epi(const f32x4 (&acc)[2][2][4][2], const Unit& u, int wr, int wc, int fr, int fq) const {
        const int jc = u.pn * 64 + 16 * wc + 4 * fq;
        if (u.pm % 9 == 0) {
#pragma unroll
            for (int ai = 0; ai < 2; ++ai)
#pragma unroll
                for (int m = 0; m < 4; ++m) { bf16_t* rowp = BIG + (size_t)(u.pm * 256 + ai * HALF + wr * 64 + m * 16 + fr) * 8192 + jc;
#pragma unroll
                    for (int bj = 0; bj < 2; ++bj)
#pragma unroll
                        for (int n = 0; n < 2; ++n) { const f32x4 v = acc[ai][bj][m][n]; u32x2 o; o.x = cvt_pk_bf16(v[0], v[1]); o.y = cvt_pk_bf16(v[2], v[3]);
                            *(u32x2*)(rowp + (2 * bj + n) * 2048) = o; } }
            return;
        }
        const f32x4 w0 = *(const f32x4*)(cw + jc), w1 = *(const f32x4*)(cw + DI + jc), w2 = *(const f32x4*)(cw + 2 * DI + jc);
#pragma unroll
        for (int ai = 0; ai < 2; ++ai) {
            f32x4 cu[4];
#pragma unroll
            for (int m = 0; m < 4; ++m) cu[m] = acc[ai][0][m][1] * acc[ai][1][m][0];
#pragma unroll
            for (int m = 0; m < 4; ++m) {
                f32x4 pv, nx, t;
                DPP4(pv, cu[m], 0x111)
                if (m > 0) { DPP4(t, cu[m - 1], 0x121) if (fr == 0) pv = t; }
                DPP4(nx, cu[m], 0x101)
                if (m < 3) { DPP4(t, cu[m + 1], 0x12F) if (fr == 15) nx = t; }
                const f32x4 bb = acc[ai][0][m][0], zz = acc[ai][1][m][1];
                f32x4 y;
#pragma unroll
                for (int i = 0; i < 4; ++i) y[i] = bb[i] * (w0[i] * pv[i] + w1[i] * cu[m][i] + w2[i] * nx[i]) * silu_f(zz[i]);
                u32x2 o; o.x = cvt_pk_bf16(y[0], y[1]); o.y = cvt_pk_bf16(y[2], y[3]);
                *(u32x2*)(Y + (size_t)(u.pm * 256 + ai * HALF + wr * 64 + m * 16 + fr) * DI + jc) = o;
            }
        }
    }
};
struct PhQKV {
    static constexpr bool PERM = true; static constexpr int TAILC = 0;
    int K, lda, ldb, nM, nN, coff; const bf16_t* A; const bf16_t* W  ; bf16_t* O; int which0;
    __device__ __forceinline__ const char* aptr(const Unit& u) const { const int h = (u.pn >> 1) & 3; return (const char*)(A + (size_t)u.pm * 256 * lda + h * 512); }
    __device__ __forceinline__ const char* bptr(const Unit& u) const { const int which = which0 + (u.pn >> 3), h = (u.pn >> 1) & 3, half = u.pn & 1;
        return (const char*)(W + ((size_t)(which * 4 + h) * 512 + half * 256) * 512); }
    __device__ __forceinline__ void epi(const f32x4 (&acc)[2][2][4][2], const Unit& u, int wr, int wc, int fr, int fq) const {
        const int which = which0 + (u.pn >> 3), h = (u.pn >> 1) & 3, half = u.pn & 1;
        store_bf16_tile(acc, O + (size_t)u.pm * 256 * 6144 + which * 2048 + h * 512 + half * 256, 6144, which == 1 ? 0.044194173824159216f : 1.f, wr, wc, fr, fq);
    }
};
struct PhTr {
    static constexpr bool PERM = true; static constexpr int TAILC = 0;
    int K, lda, ldb, nM, nN, coff; const bf16_t* W  ; const bf16_t* Act; bf16_t* OT; float scale;
    __device__ __forceinline__ const char* aptr(const Unit& u) const { const int h = u.pm >> 1, mh = u.pm & 1; return (const char*)(W + ((size_t)h * 512 + mh * 256) * 512); }
    __device__ __forceinline__ const char* bptr(const Unit& u) const { const int h = u.pm >> 1; return (const char*)(Act + (size_t)u.pn * 256 * ldb + h * 512); }
    __device__ __forceinline__ void epi(const f32x4 (&acc)[2][2][4][2], const Unit& u, int wr, int wc, int fr, int fq) const {
        const int h = u.pm >> 1, mh = u.pm & 1, bl = u.pn / 9, w = u.pn % 9;
        store_bf16_tile(acc, OT + ((size_t)(bl * 4 + h) * 512 + mh * 256) * TT + w * 256, (size_t)TT, scale, wr, wc, fr, fq);
    }
};
struct PhQK {
    static constexpr bool PERM = false; static constexpr int TAILC = 0;
    int K, lda, ldb, nM, nN, coff; const bf16_t* QKV; float* QKR;
    __device__ __forceinline__ const char* aptr(const Unit& u) const { const int bl = u.pm / 36, h = (u.pm / 9) & 3, w = u.pm % 9; return (const char*)(QKV + (size_t)(bl * TT + w * 256) * 6144 + h * 512); }
    __device__ __forceinline__ const char* bptr(const Unit& u) const { const int bl = u.pm / 36, h = (u.pm / 9) & 3, w = u.pm % 9; return (const char*)(QKV + (size_t)(bl * TT + w * 256) * 6144 + 2048 + h * 512); }
    __device__ __forceinline__ void epi(const f32x4 (&acc)[2][2][4][2], const Unit& u, int wr, int wc, int fr, int fq) const {
        if (wr != (wc >> 1)) return;
        const int bl = u.pm / 36, h = (u.pm / 9) & 3, w = u.pm % 9;
        float* base = QKR + ((size_t)(bl * 4 + h) * TT + w * 256 + wr * 64 + fr) * 64 + 32 * (wc & 1) + 4 * fq;
#pragma unroll
        for (int ai = 0; ai < 2; ++ai)
#pragma unroll
            for (int m = 0; m < 4; ++m)
#pragma unroll
                for (int n = 0; n < 2; ++n) *(f32x4*)(base + (size_t)(ai * 128 + m * 16) * 64 + n * 16) = acc[ai][ai][m][n];
    }
};
struct PhGates {
    static constexpr bool PERM = false; static constexpr int TAILC = 0;
    int K, lda, ldb, nM, nN, coff; const bf16_t* A; const bf16_t* WG; float* GATESP; int poff;
    __device__ __forceinline__ const char* aptr(const Unit& u) const { return (const char*)(A + (size_t)u.pm * 256 * lda + u.pn * 512); }
    __device__ __forceinline__ const char* bptr(const Unit& u) const { return (const char*)(WG + u.pn * 512); }
    __device__ __forceinline__ void epi(const f32x4 (&acc)[2][2][4][2], const Unit& u, int wr, int wc, int fr, int fq) const {
        if (wc != 0) return;
        float* base = GATESP + (size_t)(poff + u.pn) * RG * 16 + (size_t)(u.pm * 256 + wr * 64 + fr) * 16 + 4 * fq;
#pragma unroll
        for (int ai = 0; ai < 2; ++ai)
#pragma unroll
            for (int m = 0; m < 4; ++m) *(f32x4*)(base + (size_t)(ai * 128 + m * 16) * 16) = acc[ai][0][m][0];
    }
};
struct PhResid {
    static constexpr bool PERM = false; static constexpr int TAILC = 0;
    int K, lda, ldb, nM, nN, coff; const bf16_t *A, *B; const float *xin_x, *xin_c; float *xout_x, *xout_c; const float* mod  ; int g;
    __device__ __forceinline__ const char* aptr(const Unit& u) const { return (const char*)(A + (size_t)u.pm * 256 * lda); }
    __device__ __forceinline__ const char* bptr(const Unit& u) const { return (const char*)(B + (size_t)u.pn * 256 * ldb); }
    __device__ __forceinline__ void epi(const f32x4 (&acc)[2][2][4][2], const Unit& u, int wr, int wc, int fr, int fq) const {
        const int bl = u.pm / 9, w = u.pm % 9, b = g * GB + bl;
        const float* xin; float* xout; size_t rbase; int v;
        if (w == 0) { rbase = (size_t)b * CTXL; xin = xin_c; xout = xout_c; v = 16; } else { rbase = (size_t)b * SEQ + (w - 1) * 256; xin = xin_x; xout = xout_x; v = b; }
        const int col0 = u.pn * 256 + wc * 32 + 4 * fq;
        const float* gate = mod + (size_t)v * 3072 + 2048 + col0;
        f32x4 gv[2][2];
#pragma unroll
        for (int bj = 0; bj < 2; ++bj)
#pragma unroll
            for (int n = 0; n < 2; ++n) gv[bj][n] = *(const f32x4*)(gate + bj * HALF + n * 16);
#pragma unroll
        for (int ai = 0; ai < 2; ++ai)
#pragma unroll
            for (int m = 0; m < 4; ++m) { const size_t off = (rbase + wr * 64 + fr + ai * HALF + m * 16) * DM + col0;
#pragma unroll
                for (int bj = 0; bj < 2; ++bj)
#pragma unroll
                    for (int n = 0; n < 2; ++n) { const f32x4 xv = *(const f32x4*)(xin + off + bj * HALF + n * 16);
                        *(f32x4*)(xout + off + bj * HALF + n * 16) = xv + gv[bj][n] * acc[ai][bj][m][n]; } }
    }
};

__device__ __forceinline__ int convin_dst_row(int ns) { const int g = ns >> 11, rem = ns & 2047, pn = rem >> 6, jc = rem & 63;
    return 256 * pn + 128 * (g >> 1) + 32 * (jc >> 4) + 8 * ((jc >> 2) & 3) + 4 * (g & 1) + (jc & 3); }
__device__ __forceinline__ void transpose_item(const float* W, int K, int N, bf16_t* WT, LAS float* scr, int item, int lane, bool perm = false) {
    const int nblk = N / 32, kb = item / nblk, nb = item % nblk, k0 = 64 * kb, n0 = 32 * nb;
    float tv[32];
#pragma unroll
    for (int i = 0; i < 32; ++i) { const int kk = 2 * i + (lane >> 5); tv[i] = W[(size_t)(k0 + kk) * N + n0 + (lane & 31)]; }
#pragma unroll
    for (int i = 0; i < 32; ++i) { const int kk = 2 * i + (lane >> 5); scr[kk * 33 + (lane & 31)] = tv[i]; }
    LDS_WAIT();
    const int c = lane & 7;
#pragma unroll
    for (int j = 0; j < 4; ++j) { const int n = (lane >> 3) + 8 * j; const LAS float* s = scr + (8 * c) * 33 + n;
        u32x4 o; o.x = cvt_pk_bf16(s[0 * 33], s[1 * 33]); o.y = cvt_pk_bf16(s[2 * 33], s[3 * 33]); o.z = cvt_pk_bf16(s[4 * 33], s[5 * 33]); o.w = cvt_pk_bf16(s[6 * 33], s[7 * 33]);
        *(u32x4*)(WT + (size_t)(perm ? convin_dst_row(n0 + n) : (n0 + n)) * K + k0 + 8 * c) = o; }
    LDS_WAIT();
}
__device__ __forceinline__ void phase_prep(LAS unsigned char* lds, int wv) {
    const Params P = load_params();
    const int tid = opaque_tid(wv), lane = tid & 63, wave = tid >> 6;
    unsigned char* ws = opq(P.ws);
    float* MODP = (float*)(ws + WS_MODP);
    for (int item = blockIdx.x; item < 192; item += gridDim.x) {
        const int i = item / 48, rem = item % 48, ks = rem / 6, nb = rem % 6;
        LAS float* sc = (LAS float*)lds;
        for (int idx = tid; idx < 17 * 128; idx += 512) { const int v = idx >> 7, k = idx & 127; const float cv = (v < 16) ? P.c[v * DM + ks * 128 + k] : P.c_ctx[ks * 128 + k]; sc[idx] = silu_f(cv); }
        __syncthreads();
        const int n = nb * 512 + tid;
        float a[17];
#pragma unroll
        for (int v = 0; v < 17; ++v) a[v] = 0.f;
        const float* wp = P.mod_w + ((size_t)i * DM + ks * 128) * 3072 + n;
        for (int k0 = 0; k0 < 128; k0 += 16) {
            float wv[16];
#pragma unroll
            for (int u = 0; u < 16; ++u) wv[u] = wp[(size_t)(k0 + u) * 3072];
#pragma unroll
            for (int u = 0; u < 16; ++u)
#pragma unroll
                for (int v = 0; v < 17; ++v) a[v] += sc[v * 128 + k0 + u] * wv[u]; }
#pragma unroll
        for (int v = 0; v < 17; ++v) MODP[((size_t)(ks * 4 + i) * 17 + v) * 3072 + n] = a[v];
        __syncthreads();
    }
    LAS float* scr = (LAS float*)(lds + 16384 + wave * 8448);
    const int gw = blockIdx.x * 8 + wave, NGW = gridDim.x * 8;
    constexpr int PERJ = 4096 + 1024 + 3072 + 12 * 128 + 1024;
    for (int it = gw; it < 2 * PERJ; it += NGW) {
        const int j = it / PERJ; int r = it % PERJ;
        if (r < 4096) { transpose_item(P.conv_w_in + (size_t)j * DM * 8192, DM, 8192, (bf16_t*)(ws + WS_CWIN) + (size_t)j * 8192 * DM, scr, r, lane, true); continue; } r -= 4096;
        if (r < 1024) { transpose_item(P.conv_w_out + (size_t)j * DI * DM, DI, DM, (bf16_t*)(ws + WS_CWOUT) + (size_t)j * DM * DI, scr, r, lane); continue; } r -= 1024;
        if (r < 3072) { transpose_item(P.m_w_in + (size_t)j * DM * 6144, DM, 6144, (bf16_t*)(ws + WS_MWIN) + (size_t)j * 6144 * DM, scr, r, lane); continue; } r -= 3072;
        if (r < 1536) { const int wh = r / 128, which = wh >> 2, h = wh & 3; const float* src = (which == 0 ? P.m_wq : (which == 1 ? P.m_wk : P.m_wv)) + (size_t)(j * 4 + h) * DH * DH;
            transpose_item(src, DH, DH, (bf16_t*)(ws + WS_MWQKV) + ((size_t)(j * 3 + which) * 4 + h) * DH * DH, scr, r % 128, lane); continue; } r -= 1536;
        transpose_item(P.m_w_out + (size_t)j * DI * DM, DI, DM, (bf16_t*)(ws + WS_MWOUT) + (size_t)j * DM * DI, scr, r, lane);
    }
    bf16_t* MWG2 = (bf16_t*)(ws + WS_MWG);
    for (int item = gw; item < 2 * 2 * 2048; item += NGW) {
        const int j = item >> 12, part = (item >> 11) & 1, kg = item & 2047, h = kg >> 9, d = kg & 511;
        float acc[16];
#pragma unroll
        for (int n = 0; n < 16; ++n) acc[n] = 0.f;
        for (int pass = 0; pass < (part == 0 ? 2 : 1); ++pass) {
            const int which = part == 0 ? pass : 2; const float scl = which == 1 ? 0.044194173824159216f : 1.f;
            const float* wrow = (which == 0 ? P.m_wq : (which == 1 ? P.m_wk : P.m_wv)) + ((size_t)(j * 4 + h) * DH + d) * DH;
            const float* wgp = P.m_w_gate + ((size_t)j * 6144 + which * 2048 + h * 512) * 16;
#pragma unroll
            for (int q = 0; q < 8; ++q) { const int e = lane + 64 * q; const float wvv = wrow[e] * scl;
                const f32x4 g0 = *(const f32x4*)(wgp + (size_t)e * 16), g1 = *(const f32x4*)(wgp + (size_t)e * 16 + 4), g2 = *(const f32x4*)(wgp + (size_t)e * 16 + 8), g3 = *(const f32x4*)(wgp + (size_t)e * 16 + 12);
#pragma unroll
                for (int i = 0; i < 4; ++i) { acc[i] += wvv * g0[i]; acc[4 + i] += wvv * g1[i]; acc[8 + i] += wvv * g2[i]; acc[12 + i] += wvv * g3[i]; } }
        }
        float mine = 0.f;
#pragma unroll
        for (int n = 0; n < 16; ++n) { const float t = wave_sum(acc[n], lane); mine = (lane == n) ? t : mine; }
        if (lane < 16) MWG2[((size_t)(j * 2 + part) * 256 + lane) * 2048 + kg] = (bf16_t)(cvt_pk_bf16(mine, 0.f) & 0xffffu);
    }
    for (size_t idx = (size_t)blockIdx.x * 512 + tid; idx < (size_t)4 * 240 * 2048; idx += (size_t)gridDim.x * 512) {
        const int m4 = (int)(idx / (240 * 2048)); const int rem = (int)(idx % (240 * 2048));
        MWG2[((size_t)m4 * 256 + 16) * 2048 + rem] = (bf16_t)0;
    }
    __syncthreads();
}
__device__ __forceinline__ void phase_modreduce(int wv) {
    const Params P = load_params();
    unsigned char* ws = opq(P.ws);
    const float* MODP = (const float*)(ws + WS_MODP); float* MOD = (float*)(ws + WS_MOD);
    for (int idx = blockIdx.x * 512 + opaque_tid(wv); idx < 4 * 17 * 3072; idx += gridDim.x * 512) {
        const int i = idx / (17 * 3072), n = idx % 3072;
        float s = P.mod_b[i * 3072 + n];
#pragma unroll
        for (int ks = 0; ks < 8; ++ks) s += MODP[(size_t)ks * 4 * 17 * 3072 + idx];
        MOD[idx] = s;
    }
}

__device__ __forceinline__ void phase_modulate(int layer, int g, int buf, bool light, int wv) {
    if (light && blockIdx.x < 160) return;
    const Params P = load_params();
    const float* xin_x = (layer == 0) ? P.x : P.out; const float* xin_c = (layer == 0) ? P.ctx : (const float*)(P.ws + WS_XC);
    const int tid = opaque_tid(wv), lane = tid & 63, gw = (light ? (int)blockIdx.x - 160 : (int)blockIdx.x) * 8 + (tid >> 6), NGW = (light ? 96 : (int)gridDim.x) * 8;
    unsigned char* ws = opq(P.ws); xin_x = opq(xin_x); xin_c = opq(xin_c);
    bf16_t* HX = (bf16_t*)(ws + (buf ? WS_HX2 : WS_HX)); const float* MOD = (const float*)(ws + WS_MOD) + (size_t)layer * 17 * 3072;
    const float* ng = opq(P.norm_g) + layer * DM;
    for (int r = gw; r < RG; r += NGW) {
        const int bl = r / TT, tt = r % TT, b = g * GB + bl;
        const float* xr; int v;
        if (tt < CTXL) { xr = xin_c + ((size_t)b * CTXL + tt) * DM; v = 16; } else { xr = xin_x + ((size_t)b * SEQ + (tt - CTXL)) * DM; v = b; }
        const float* md = MOD + (size_t)v * 3072;
        f32x4 xv[4]; float ss = 0.f;
#pragma unroll
        for (int q = 0; q < 4; ++q) { xv[q] = *(const f32x4*)(xr + 4 * lane + 256 * q); ss += (xv[q][0] * xv[q][0] + xv[q][1] * xv[q][1]) + (xv[q][2] * xv[q][2] + xv[q][3] * xv[q][3]); }
        const float rstd = rsqrtf(wave_sum(ss, lane) * (1.f / DM) + EPSV);
#pragma unroll
        for (int q = 0; q < 4; ++q) { const int c0 = 4 * lane + 256 * q;
            const f32x4 gv = *(const f32x4*)(ng + c0), sh = *(const f32x4*)(md + c0), sc = *(const f32x4*)(md + 1024 + c0);
            const f32x4 y = xv[q] * rstd * gv * (sc + 1.f) + sh;
            u32x2 o; o.x = cvt_pk_bf16(y[0], y[1]); o.y = cvt_pk_bf16(y[2], y[3]);
            *(u32x2*)(HX + (size_t)r * DM + c0) = o; }
    }
}
__device__ __forceinline__ void conv_valid(int r, bool& pv, bool& nv) {
    const int tt = r % TT;
    if (tt < CTXL) { pv = tt != 0; nv = tt != CTXL - 1; } else { pv = (tt & 63) != 0; nv = (tt & 63) != 63; }
}
__device__ __forceinline__ void phase_convmix(int j, int g, int wv) {
    const Params P = load_params();
    unsigned char* ws = opq(P.ws);
    const bf16_t* BIG = (const bf16_t*)(ws + WS_BIG); bf16_t* Y = (bf16_t*)(ws + ((g & 1) ? WS_KT : WS_VT));
    const float* cw = opq(P.conv_w) + (size_t)j * 3 * DI;
    for (int it = blockIdx.x * 512 + opaque_tid(wv); it < GB * CTXL * 256; it += gridDim.x * 512) {
        const int rc = it >> 8, r = (rc >> 8) * TT + (rc & 255), c8 = (it & 255) * 8; bool pv, nv; conv_valid(r, pv, nv);
        const bf16_t* row = BIG + (size_t)r * 8192 + c8;
        float bb[8], cc[8], uu[8], zz[8], cp[8], up[8], cn[8], un[8];
        unpack8(*(const u32x4*)(row), bb); unpack8(*(const u32x4*)(row + 2048), cc); unpack8(*(const u32x4*)(row + 4096), uu); unpack8(*(const u32x4*)(row + 6144), zz);
        const u32x4 z4 = (u32x4){0u, 0u, 0u, 0u};
        unpack8(pv ? *(const u32x4*)(row - 8192 + 2048) : z4, cp); unpack8(pv ? *(const u32x4*)(row - 8192 + 4096) : z4, up);
        unpack8(nv ? *(const u32x4*)(row + 8192 + 2048) : z4, cn); unpack8(nv ? *(const u32x4*)(row + 8192 + 4096) : z4, un);
        float w0[8], w1[8], w2[8], y[8];
        *(f32x4*)(w0) = *(const f32x4*)(cw + c8); *(f32x4*)(w0 + 4) = *(const f32x4*)(cw + c8 + 4);
        *(f32x4*)(w1) = *(const f32x4*)(cw + DI + c8); *(f32x4*)(w1 + 4) = *(const f32x4*)(cw + DI + c8 + 4);
        *(f32x4*)(w2) = *(const f32x4*)(cw + 2 * DI + c8); *(f32x4*)(w2 + 4) = *(const f32x4*)(cw + 2 * DI + c8 + 4);
#pragma unroll
        for (int e = 0; e < 8; ++e) { const float s = w0[e] * (cp[e] * up[e]) + w1[e] * (cc[e] * uu[e]) + w2[e] * (cn[e] * un[e]); y[e] = bb[e] * s * silu_f(zz[e]); }
        *(u32x4*)(Y + (size_t)r * DI + c8) = pack8(y);
    }
}
__device__ __forceinline__ void phase_uc(int j, int wv) {
    const Params P = load_params();
    unsigned char* ws = opq(P.ws);
    const bf16_t* UZO = (const bf16_t*)(ws + WS_BIG); bf16_t* UC = (bf16_t*)(ws + WS_UC);
    const float* cw = opq(P.m_conv_w) + (size_t)j * 3 * DI;
    for (int it = blockIdx.x * 512 + opaque_tid(wv); it < RG * 256; it += gridDim.x * 512) {
        const int r = it >> 8, c8 = (it & 255) * 8; bool pv, nv; conv_valid(r, pv, nv);
        const bf16_t* row = UZO + (size_t)r * 6144 + c8;
        float uu[8], up[8], un[8], y[8];
        const u32x4 z4 = (u32x4){0u, 0u, 0u, 0u};
        unpack8(*(const u32x4*)(row), uu);
        unpack8(pv ? *(const u32x4*)(row - 6144) : z4, up);
        unpack8(nv ? *(const u32x4*)(row + 6144) : z4, un);
        float w0[8], w1[8], w2[8];
        *(f32x4*)(w0) = *(const f32x4*)(cw + c8); *(f32x4*)(w0 + 4) = *(const f32x4*)(cw + c8 + 4);
        *(f32x4*)(w1) = *(const f32x4*)(cw + DI + c8); *(f32x4*)(w1 + 4) = *(const f32x4*)(cw + DI + c8 + 4);
        *(f32x4*)(w2) = *(const f32x4*)(cw + 2 * DI + c8); *(f32x4*)(w2 + 4) = *(const f32x4*)(cw + 2 * DI + c8 + 4);
#pragma unroll
        for (int e = 0; e < 8; ++e) { const float s = w0[e] * up[e] + w1[e] * uu[e] + w2[e] * un[e]; y[e] = silu_f(s); }
        *(u32x4*)(UC + (size_t)r * DI + c8) = pack8(y);
    }
}
__device__ __forceinline__ void phase_gating(int j, int wv) {
    const Params P = load_params();
    const int tid = opaque_tid(wv), lane = tid & 63, gw = blockIdx.x * 8 + (tid >> 6), NGW = gridDim.x * 8;
    unsigned char* ws = opq(P.ws); const float* mng = opq(P.m_norm_g) + (size_t)j * DI; const float* msk = opq(P.m_skip) + (size_t)j * DI;
    const bf16_t* QKV = (const bf16_t*)(ws + WS_QKV); const bf16_t* UZO = (const bf16_t*)(ws + WS_BIG); const bf16_t* UC = (const bf16_t*)(ws + WS_UC);
    bf16_t* Y = (bf16_t*)(ws + WS_KT);
    u32x4 nhf, nhb, nzz, noo, nuc;
#define GATE_LOAD(IT) { const int r_ = (IT) >> 2, c_ = ((IT) & 3) * 512 + 8 * lane; \
        nhf = *(const u32x4*)(QKV + (size_t)r_ * 6144 + 2048 + c_); nhb = *(const u32x4*)(QKV + (size_t)r_ * 6144 + 4096 + c_); \
        nzz = *(const u32x4*)(UZO + (size_t)r_ * 6144 + 2048 + c_); noo = *(const u32x4*)(UZO + (size_t)r_ * 6144 + 4096 + c_); nuc = *(const u32x4*)(UC + (size_t)r_ * DI + c_); }
    if (gw < RG * 4) GATE_LOAD(gw)
    for (int it = gw; it < RG * 4; it += NGW) {
        const int r = it >> 2, h = it & 3, c0 = h * 512 + 8 * lane;
        float hf[8], hb[8], zz[8], oo[8], uc[8], y[8];
        unpack8(nhf, hf); unpack8(nhb, hb); unpack8(nzz, zz); unpack8(noo, oo); unpack8(nuc, uc);
        { const int itn = (it + NGW < RG * 4) ? it + NGW : it; GATE_LOAD(itn) }
        float s = 0.f;
#pragma unroll
        for (int e = 0; e < 8; ++e) { hf[e] += hb[e]; s += hf[e]; }
        const float mean = wave_sum(s, lane) * (1.f / DH); float s2 = 0.f;
#pragma unroll
        for (int e = 0; e < 8; ++e) { hf[e] -= mean; s2 += hf[e] * hf[e]; }
        const float rstd = rsqrtf(wave_sum(s2, lane) * (1.f / DH) + EPSV);
        float ng[8], sk[8];
        *(f32x4*)(ng) = *(const f32x4*)(mng + c0); *(f32x4*)(ng + 4) = *(const f32x4*)(mng + c0 + 4);
        *(f32x4*)(sk) = *(const f32x4*)(msk + c0); *(f32x4*)(sk + 4) = *(const f32x4*)(msk + c0 + 4);
#pragma unroll
        for (int e = 0; e < 8; ++e) y[e] = (sigmoid_f(oo[e]) * (hf[e] * rstd * ng[e]) + sk[e] * uc[e]) * silu_f(zz[e]);
        *(u32x4*)(Y + (size_t)r * DI + c0) = pack8(y);
    }
#undef GATE_LOAD
}
__device__ __forceinline__ void phase_final(int r0, int r1, bool light, int wv) {
    if (light && blockIdx.x < 144) return;
    const Params P = load_params();
    const int tid = opaque_tid(wv), lane = tid & 63, gw = (light ? (int)blockIdx.x - 144 : (int)blockIdx.x) * 8 + (tid >> 6), NGW = (light ? 112 : (int)gridDim.x) * 8;
    float* outp = opq(P.out); const float* fg = opq(P.final_g);
    for (int r = r0 + gw; r < r1; r += NGW) {
        float* xr = outp + (size_t)r * DM;
        f32x4 xv[4]; float ss = 0.f;
#pragma unroll
        for (int q = 0; q < 4; ++q) { xv[q] = *(const f32x4*)(xr + 4 * lane + 256 * q); ss += (xv[q][0] * xv[q][0] + xv[q][1] * xv[q][1]) + (xv[q][2] * xv[q][2] + xv[q][3] * xv[q][3]); }
        const float rstd = rsqrtf(wave_sum(ss, lane) * (1.f / DM) + EPSV);
#pragma unroll
        for (int q = 0; q < 4; ++q) { const f32x4 gv = *(const f32x4*)(fg + 4 * lane + 256 * q); *(f32x4*)(xr + 4 * lane + 256 * q) = xv[q] * rstd * gv; }
    }
}

__device__ __forceinline__ void phase_gatetab(LAS unsigned char* lds, int j, int wv) {
    if (blockIdx.x < 144 || blockIdx.x >= 176) return;
    const Params P = load_params();
    const int tid = opaque_tid(wv), lane = tid & 63, w = __builtin_amdgcn_readfirstlane(tid >> 6);
    unsigned char* ws = P.ws;
    const int sidx = (int)blockIdx.x - 144, dir = sidx & 1, h = (sidx >> 1) & 3, bl = sidx >> 3;
    const float* gt = (const float*)(ws + WS_GATESP) + (size_t)(bl * TT) * 16 + h + (dir ? 8 : 0);
    LAS float* tA = (LAS float*)(lds + 102400); LAS float* tPM = tA + TT; LAS float* tBC = tA + 2 * TT;
    LAS float* cMP = (LAS float*)(lds + 102400 + 3 * TT * 4); LAS float* cM63 = cMP + 36; LAS float* cBL = cMP + 72; LAS float* cAM = cMP + 108;
        {
            const float bi_ = P.m_b_gate[j * 16 + (dir ? 8 : 0) + h], bf_ = P.m_b_gate[j * 16 + (dir ? 8 : 0) + 4 + h];
            for (int cc = w; cc < 36; cc += 8) { const int ac = dir ? (cc < 4 ? 3 - cc : 39 - cc) : cc, t = dir ? 63 - lane : lane, row = ac * 64 + t;
                const float* gp = gt + (size_t)row * 16; float si = bi_, sf = bf_;
#pragma unroll
                for (int ks_ = 0; ks_ < 8; ++ks_) { si += gp[(size_t)ks_ * RG * 16]; sf += gp[(size_t)ks_ * RG * 16 + 4]; }
                const float fp = sf; const float lf = fminf(fp, 0.f) - log1pf(__expf(-fabsf(fp)));
#define DPP_F(oldv, src, ctrl, rmask) __int_as_float(__builtin_amdgcn_update_dpp(__float_as_int(oldv), __float_as_int(src), ctrl, rmask, 0xf, false))
                float bc = lf;
                bc += DPP_F(0.f, bc, 0x111, 0xf); bc += DPP_F(0.f, bc, 0x112, 0xf); bc += DPP_F(0.f, bc, 0x114, 0xf); bc += DPP_F(0.f, bc, 0x118, 0xf);
                bc += DPP_F(0.f, bc, 0x142, 0xa); bc += DPP_F(0.f, bc, 0x143, 0xc);
                const float av = si - bc;
                const float ninf = -__builtin_inff();
                float pmx = av;
                pmx = fmaxf(pmx, DPP_F(ninf, pmx, 0x111, 0xf)); pmx = fmaxf(pmx, DPP_F(ninf, pmx, 0x112, 0xf)); pmx = fmaxf(pmx, DPP_F(ninf, pmx, 0x114, 0xf)); pmx = fmaxf(pmx, DPP_F(ninf, pmx, 0x118, 0xf));
                pmx = fmaxf(pmx, DPP_F(ninf, pmx, 0x142, 0xa)); pmx = fmaxf(pmx, DPP_F(ninf, pmx, 0x143, 0xc));
#undef DPP_F
                tA[row] = av; tPM[row] = pmx; tBC[row] = bc;
                if (lane == 63) { cBL[cc] = bc; cAM[cc] = pmx; } }
            __syncthreads();
            if (tid == 0) { float mp = 0.f; for (int cc = 0; cc < 36; ++cc) { cMP[cc] = mp; const float M63 = fmaxf(mp, cAM[cc]); cM63[cc] = M63; mp = cBL[cc] + M63; } }
            __syncthreads();
        }
    { char* gdst = (char*)(ws + WS_GTAB) + (size_t)sidx * 28224; const LAS f32x4* lsrc = (const LAS f32x4*)tA;
      for (int i = tid; i < 7056 / 4; i += 512) { unsigned off = (unsigned)i * 16u; asm volatile("" : "+v"(off)); *(f32x4*)(gdst + off) = lsrc[i]; } }
    __syncthreads();
}

constexpr int SC_R = 0, SC_V = 81920, SC_VW = 91136, SC_TAB = 100352;
__device__ __forceinline__ bf16x8 mk_frag(unsigned a, unsigned b, unsigned c, unsigned d) { u32x4 t; t.x = a; t.y = b; t.z = c; t.w = d; return __builtin_bit_cast(bf16x8, t); }
__device__ __forceinline__ void phase_scan(LAS unsigned char* lds, int j, int wv) {
    const Params P = load_params();
    const int tid = opaque_tid(wv);
    const int lane = tid & 63, w = __builtin_amdgcn_readfirstlane(tid >> 6), lr = lane & 15, lq = lane >> 4;
    const unsigned qoff = (unsigned)(lr * 6144 + 64 * w + 4 * lq) * 2u;
    const unsigned koff = (unsigned)((64 * w + lr) * TT + 8 * lq) * 2u;
    const unsigned hoff = (unsigned)((4 * lq) * 6144 + lr) * 2u;
    unsigned char* ws = opq(P.ws);
    bf16_t* QKV = (bf16_t*)(ws + WS_QKV); const bf16_t* KT = (const bf16_t*)(ws + WS_KT); const bf16_t* VT = (const bf16_t*)(ws + WS_VT);
    const float* QKR = (const float*)(ws + WS_QKR); const float* GATES = (const float*)(ws + WS_GATESP);
    LAS f32x4* R = (LAS f32x4*)(lds + SC_R);
    LAS bf16_t* sV = (LAS bf16_t*)(lds + SC_V); LAS bf16_t* sVW = (LAS bf16_t*)(lds + SC_VW);
    LAS u32x4* sS = (LAS u32x4*)(lds + 131072);
    LAS float* tA = (LAS float*)(lds + 102400); LAS float* tPM = tA + TT; LAS float* tBC = tA + 2 * TT;
    LAS float* cMP = (LAS float*)(lds + 102400 + 3 * TT * 4); LAS float* cM63 = cMP + 36; LAS float* cBL = cMP + 72; LAS float* cAM = cMP + 108;
    LAS float* tabA = (LAS float*)(lds + SC_TAB); LAS float* tabM = tabA + 64; LAS float* tabWI = tabA + 128; LAS float* tabFL = tabA + 192; LAS float* tabWS = tabA + 256; LAS float* scal = tabA + 320;
    for (int uid = blockIdx.x; uid < GB * NH * 2 * 8; uid += gridDim.x) {
        const int xcd_ = uid & 7, yy_ = uid >> 3, pair_ = xcd_ * 2 + (yy_ >> 4);
        const int es = yy_ & 7, dir = (yy_ >> 3) & 1, h = pair_ & 3, bl = pair_ >> 2;
        const bf16_t* qb = QKV + (size_t)(bl * TT) * 6144 + h * 512;
        const bf16_t* kTb = KT + (size_t)((bl * 4 + h) * 512) * TT;
        const bf16_t* vTb = VT + (size_t)((bl * 4 + h) * 512 + es * 64) * TT;
        const float* qkr = QKR + (size_t)((bl * 4 + h) * TT) * 64;
        const float* gt = GATES + (size_t)(bl * TT) * 16 + h + (dir ? 8 : 0);
        bf16_t* hout = QKV + (size_t)(bl * TT) * 6144 + (dir ? 4096 : 2048) + h * 512 + es * 64;
        f32x4 C[4][5];
#pragma unroll
        for (int a = 0; a < 4; ++a)
#pragma unroll
            for (int b = 0; b < 5; ++b) C[a][b] = (f32x4){0.f, 0.f, 0.f, 0.f};
        { const char* gsrc = (const char*)(ws + WS_GTAB) + (size_t)((bl * 4 + h) * 2 + dir) * 28224; LAS f32x4* ldst = (LAS f32x4*)tA;
          for (int i = tid; i < 7056 / 4; i += 512) { unsigned off = (unsigned)i * 16u; asm volatile("" : "+v"(off)); ldst[i] = *(const f32x4*)(gsrc + off); }
          __syncthreads(); }
        bf16x8 qa0[4], qa1[4];
#define SCAN_LOAD_Q0(T0) { _Pragma("unroll") for (int jt = 0; jt < 4; ++jt) { const char* p_ = (const char*)qb + (size_t)((T0) + 16 * jt) * 12288 + qoff; \
            const u32x2 lo_ = *(const u32x2*)p_, hi_ = *(const u32x2*)(p_ + 32); qa0[jt] = mk_frag(lo_.x, lo_.y, hi_.x, hi_.y); \
            const u32x2 lo2_ = *(const u32x2*)(p_ + 64), hi2_ = *(const u32x2*)(p_ + 96); qa1[jt] = mk_frag(lo2_.x, lo2_.y, hi2_.x, hi2_.y); } }
        SCAN_LOAD_Q0(dir ? 3 * 64 : 0)
        for (int cc = 0; cc < 36; ++cc) {
            const int ac = dir ? (cc < 4 ? 3 - cc : 39 - cc) : cc, t0 = ac * 64;
            const int ccn = cc < 35 ? cc + 1 : 35, acn = dir ? (ccn < 4 ? 3 - ccn : 39 - ccn) : ccn, t0n = acn * 64;
            if (w == 7) { const float mpc = cMP[cc], M63c = cM63[cc]; const float av_ = tA[t0 + lane], Mi_ = fmaxf(mpc, tPM[t0 + lane]);
                tabWS[lane] = __expf(av_ - M63c); tabWI[lane] = __expf(mpc - Mi_); tabFL[lane] = __expf(-(tBC[t0 + lane] + Mi_)); }
#define SCAN_PASS(E0, NE) { f32x4 Pt[4][NE]; \
                _Pragma("unroll") for (int ks = 0; ks < 2; ++ks) { \
                  _Pragma("unroll") for (int e = 0; e < NE; ++e) { const f32x4 c0 = C[2 * ks][E0 + e], c1 = C[2 * ks + 1][E0 + e]; \
                    const bf16x8 cb = mk_frag(cvt_pk_bf16(c0[0], c0[1]), cvt_pk_bf16(c0[2], c0[3]), cvt_pk_bf16(c1[0], c1[1]), cvt_pk_bf16(c1[2], c1[3])); \
                    _Pragma("unroll") for (int jt = 0; jt < 4; ++jt) Pt[jt][e] = __builtin_amdgcn_mfma_f32_16x16x32_bf16(ks == 0 ? qa0[jt] : qa1[jt], cb, ks == 0 ? (f32x4){0.f, 0.f, 0.f, 0.f} : Pt[jt][e], 0, 0, 0); } } \
                if (w >= 4) { _Pragma("unroll") for (int jt = 0; jt < 4; ++jt) _Pragma("unroll") for (int e = 0; e < NE; ++e) R[((w - 4) * 20 + jt * 5 + E0 + e) * 64 + lane] = Pt[jt][e]; } \
                __syncthreads(); \
                if (w < 4) { _Pragma("unroll") for (int jt = 0; jt < 4; ++jt) _Pragma("unroll") for (int e = 0; e < NE; ++e) { const int idx = (w * 20 + jt * 5 + E0 + e) * 64 + lane; const f32x4 sres = Pt[jt][e] + R[idx]; R[idx] = sres; } } }
            SCAN_PASS(0, 2)
            if (w >= 4) {
#pragma unroll
                for (int hlf = 0; hlf < 2; ++hlf) { const int it_ = (tid - 256) + 256 * hlf, ve = it_ >> 3, vs = (it_ & 7) * 8;
                    const u32x4 vraw = *(const u32x4*)(vTb + (size_t)ve * TT + t0 + vs);
                    float vf[8], wv[8]; unpack8(vraw, vf);
                    const f32x4 w0 = *(const LAS f32x4*)(tabWS + vs), w1 = *(const LAS f32x4*)(tabWS + vs + 4);
#pragma unroll
                    for (int e = 0; e < 4; ++e) { wv[e] = vf[e] * w0[e]; wv[4 + e] = vf[4 + e] * w1[e]; }
                    *(LAS u32x4*)(sV + ve * 72 + vs) = vraw;
                    *(LAS u32x4*)(sVW + ve * 72 + vs) = pack8(wv); }
            }
            SCAN_PASS(2, 3)
#undef SCAN_PASS
            if (w >= 4) {
                int jr = 16 * (w - 4) + lr; asm volatile("" : "+v"(jr));
                const float Mj = fmaxf(cMP[cc], tPM[t0 + jr]);
#pragma unroll
                for (int ks = 0; ks < 2; ++ks) { const int s0 = 32 * ks + 8 * lq; const float* qp = qkr + (size_t)(t0 + jr) * 64 + s0;
                    const f32x4 q0 = *(const f32x4*)qp, q1 = *(const f32x4*)(qp + 4);
                    const f32x4 a0 = *(const LAS f32x4*)(tA + t0 + s0), a1 = *(const LAS f32x4*)(tA + t0 + s0 + 4);
                    float sv[8];
#pragma unroll
                    for (int e = 0; e < 4; ++e) { const int sA = s0 + e, sB = s0 + 4 + e;
                        const bool vA = dir ? (sA >= jr) : (sA <= jr), vB = dir ? (sB >= jr) : (sB <= jr);
                        sv[e] = vA ? q0[e] * __expf(a0[e] - Mj) : 0.f; sv[4 + e] = vB ? q1[e] * __expf(a1[e] - Mj) : 0.f; }
                    sS[((w - 4) * 2 + ks) * 64 + lane] = pack8(sv); }
            }
            bf16x8 ka[4][2];
#pragma unroll
            for (int dt = 0; dt < 4; ++dt)
#pragma unroll
                for (int ks = 0; ks < 2; ++ks) ka[dt][ks] = *(const bf16x8*)((const char*)kTb + (size_t)(16 * dt * TT + t0 + 32 * ks) * 2 + koff);
            const int jt_f = w >> 1, eh = w & 1;
            __syncthreads();
            {
                const int jt = jt_f;
                bf16x8 sa[2];
#pragma unroll
                for (int ks = 0; ks < 2; ++ks) { const u32x4 pk = sS[(jt * 2 + ks) * 64 + lane]; sa[ks] = __builtin_bit_cast(bf16x8, pk); }
                const unsigned one2 = (lr == 0) ? 0x3F803F80u : 0u;
                const bf16x8 ones = mk_frag(one2, one2, one2, one2);
                const f32x4 wi = *(const LAS f32x4*)(tabWI + 16 * jt + 4 * lq), fl = *(const LAS f32x4*)(tabFL + 16 * jt + 4 * lq);
                f32x4 num[3];
#pragma unroll
                for (int x = 0; x < 3; ++x) { const int et = (x < 2) ? 2 * eh + x : 4, tile = jt * 5 + et;
                    const f32x4 inter = (R[(0 * 20 + tile) * 64 + lane] + R[(1 * 20 + tile) * 64 + lane]) + (R[(2 * 20 + tile) * 64 + lane] + R[(3 * 20 + tile) * 64 + lane]);
                    f32x4 it = (f32x4){0.f, 0.f, 0.f, 0.f};
#pragma unroll
                    for (int ks = 0; ks < 2; ++ks) { const bf16x8 vb = (x < 2) ? *(const LAS bf16x8*)(sV + (16 * et + lr) * 72 + 32 * ks + 8 * lq) : ones;
                        it = __builtin_amdgcn_mfma_f32_16x16x32_bf16(sa[ks], vb, it, 0, 0, 0); }
                    num[x] = wi * inter + it; }
                f32x4 den;
#pragma unroll
                for (int i = 0; i < 4; ++i) den[i] = fmaxf(fabsf(lane_read(num[2][i], lane & 48)), fl[i]);
#pragma unroll
                for (int x = 0; x < 2; ++x) { const int et = 2 * eh + x;
#pragma unroll
                    for (int i = 0; i < 4; ++i) { const float hv = num[x][i] * __builtin_amdgcn_rcpf(den[i]);
                        *(bf16_t*)((char*)hout + ((size_t)(t0 + 16 * jt + i) * 6144 + 16 * et) * 2 + hoff) = (bf16_t)(cvt_pk_bf16(hv, 0.f) & 0xffffu); } }
            }
            SCAN_LOAD_Q0(t0n)
            {
                const float wd = __expf(cMP[cc] - cM63[cc]);
#pragma unroll
                for (int dt = 0; dt < 4; ++dt)
#pragma unroll
                    for (int et = 0; et < 5; ++et) C[dt][et] = C[dt][et] * wd;
#pragma unroll
                for (int ks = 0; ks < 2; ++ks) {
#pragma unroll
                    for (int et = 0; et < 4; ++et) { const bf16x8 vwb = *(const LAS bf16x8*)(sVW + (16 * et + lr) * 72 + 32 * ks + 8 * lq);
#pragma unroll
                        for (int dt = 0; dt < 4; ++dt) C[dt][et] = __builtin_amdgcn_mfma_f32_16x16x32_bf16(ka[dt][ks], vwb, C[dt][et], 0, 0, 0); }
                    const f32x4 w0 = *(const LAS f32x4*)(tabWS + 32 * ks + 8 * lq), w1 = *(const LAS f32x4*)(tabWS + 32 * ks + 8 * lq + 4);
                    u32x4 wp; wp.x = cvt_pk_bf16(w0[0], w0[1]); wp.y = cvt_pk_bf16(w0[2], w0[3]); wp.z = cvt_pk_bf16(w1[0], w1[1]); wp.w = cvt_pk_bf16(w1[2], w1[3]);
                    if (lr != 0) { wp.x = 0u; wp.y = 0u; wp.z = 0u; wp.w = 0u; }
                    const bf16x8 wb = __builtin_bit_cast(bf16x8, wp);
#pragma unroll
                    for (int dt = 0; dt < 4; ++dt) C[dt][4] = __builtin_amdgcn_mfma_f32_16x16x32_bf16(ka[dt][ks], wb, C[dt][4], 0, 0, 0);
                }
            }
            __syncthreads();
        }
    }
}

__device__ __forceinline__ void run_in_gemm(LAS unsigned char* lds, int j, bool conv, int coff, int g, int buf, int wv) {
    const Params P = load_params(); unsigned char* ws = P.ws;
    if (conv) {
        PhConvFused ph; ph.K = DM; ph.lda = DM; ph.ldb = DM; ph.nM = MT; ph.nN = 32; ph.coff = coff; ph.A = (const bf16_t*)(ws + (buf ? WS_HX2 : WS_HX)); ph.B = (const bf16_t*)(ws + WS_CWIN) + (size_t)j * 8192 * DM;
        ph.BIG = (bf16_t*)(ws + WS_BIG); ph.Y = (bf16_t*)(ws + ((g & 1) ? WS_KT : WS_VT)); ph.cw = P.conv_w + (size_t)j * 3 * DI;
        gemm_phase(lds, ph, wv);
    } else {
        PhPlain ph; ph.K = DM; ph.lda = DM; ph.ldb = DM; ph.nM = MT; ph.coff = coff; ph.A = (const bf16_t*)(ws + (buf ? WS_HX2 : WS_HX)); ph.O = (bf16_t*)(ws + WS_BIG);
        ph.nN = 24; ph.B = (const bf16_t*)(ws + WS_MWIN) + (size_t)j * 6144 * DM; ph.ldc = 6144;
        gemm_phase(lds, ph, wv);
    }
}
__device__ __forceinline__ void run_out_gemm(LAS unsigned char* lds, int layer, int g, int wv) {
    const Params P = load_params(); unsigned char* ws = P.ws; const int j = layer >> 1;
    PhResid ph; ph.K = DI; ph.lda = DI; ph.ldb = DI; ph.nM = MT; ph.nN = 4; ph.coff = 0; ph.A = (const bf16_t*)(ws + (((layer & 1) || (g & 1)) ? WS_KT : WS_VT));
    ph.B = ((layer & 1) ? (const bf16_t*)(ws + WS_MWOUT) : (const bf16_t*)(ws + WS_CWOUT)) + (size_t)j * DM * DI;
    ph.xin_x = (layer == 0) ? P.x : P.out; ph.xin_c = (layer == 0) ? P.ctx : (const float*)(ws + WS_XC); ph.xout_x = P.out; ph.xout_c = (float*)(ws + WS_XC);
    ph.mod = (const float*)(ws + WS_MOD) + (size_t)layer * 17 * 3072; ph.g = g;
    gemm_phase(lds, ph, wv);
}
__device__ __forceinline__ void run_qkv_nat(LAS unsigned char* lds, int j, bool isv, int wv) {
    const Params P = load_params(); unsigned char* ws = P.ws;
    PhQKV ph; ph.K = DH; ph.ldb = DH; ph.nM = MT; ph.W = (const bf16_t*)(ws + WS_MWQKV) + (size_t)j * 3 * 4 * DH * DH; ph.O = (bf16_t*)(ws + WS_QKV);
    if (!isv) { ph.lda = DI; ph.nN = 16; ph.coff = 0; ph.A = (const bf16_t*)(ws + WS_UC); ph.which0 = 0; }
    else { ph.lda = 6144; ph.nN = 8; ph.coff = 256 - 64; ph.A = (const bf16_t*)(ws + WS_BIG); ph.which0 = 2; }
    gemm_phase(lds, ph, wv);
}
__device__ __forceinline__ void run_tr(LAS unsigned char* lds, int j, bool isv, int wv) {
    const Params P = load_params(); unsigned char* ws = P.ws;
    PhTr ph; ph.K = DH; ph.lda = DH; ph.nM = 8; ph.nN = MT;
    const bf16_t* WQKV = (const bf16_t*)(ws + WS_MWQKV) + (size_t)j * 3 * 4 * DH * DH;
    if (!isv) { ph.ldb = DI; ph.coff = 192; ph.W = WQKV + (size_t)1 * 4 * DH * DH; ph.Act = (const bf16_t*)(ws + WS_UC); ph.OT = (bf16_t*)(ws + WS_KT); ph.scale = 0.044194173824159216f; }
    else { ph.ldb = 6144; ph.coff = 160; ph.W = WQKV + (size_t)2 * 4 * DH * DH; ph.Act = (const bf16_t*)(ws + WS_BIG); ph.OT = (bf16_t*)(ws + WS_VT); ph.scale = 1.f; }
    gemm_phase(lds, ph, wv);
}
__device__ __forceinline__ void run_qk(LAS unsigned char* lds, int wv) {
    const Params P = load_params(); unsigned char* ws = P.ws;
    PhQK ph; ph.K = DH; ph.lda = 6144; ph.ldb = 6144; ph.nM = GB * NH * 9; ph.nN = 1; ph.coff = 0; ph.QKV = (const bf16_t*)(ws + WS_QKV); ph.QKR = (float*)(ws + WS_QKR);
    gemm_phase(lds, ph, wv);
}
__device__ __forceinline__ void run_gates(LAS unsigned char* lds, int j, int part, int wv) {
    const Params P = load_params(); unsigned char* ws = P.ws;
    PhGates ph; ph.K = 512; ph.ldb = 2048; ph.nM = MT; ph.nN = 4; ph.poff = 4 * part;
    if (part == 0) { ph.A = (const bf16_t*)(ws + WS_UC); ph.lda = DI; ph.coff = 128; } else { ph.A = (const bf16_t*)(ws + WS_BIG); ph.lda = 6144; ph.coff = 144; }
    ph.WG = (const bf16_t*)(ws + WS_MWG) + (size_t)(j * 2 + part) * 256 * 2048; ph.GATESP = (float*)(ws + WS_GATESP);
    gemm_phase(lds, ph, wv);
}

#define XB_TMO      128
#define XB_XCNT(j)  (256  + 64 * (j))
#define XB_XSUB(j)  (1280 + 64 * (j))
#define XB_XGEN(j)  (2304 + 64 * (j))
#define XB_TOP      3328
#define XB_TOPGEN   3392
#define XCD_BAR_WORDS 3456
#define XB_SPIN_CAP (1u << 22)
__device__ __forceinline__ unsigned xb_ld(unsigned* p)              { return __hip_atomic_load(p, __ATOMIC_RELAXED, __HIP_MEMORY_SCOPE_AGENT); }
__device__ __forceinline__ unsigned xb_add(unsigned* p, unsigned v) { return __hip_atomic_fetch_add(p, v, __ATOMIC_RELAXED, __HIP_MEMORY_SCOPE_AGENT); }
__device__ __forceinline__ unsigned xb_xcc_id() { return (unsigned)__builtin_amdgcn_s_getreg((3 << 11) | 20) & 0xFu; }
#define XB_SPIN(cond, bar) do { unsigned _sp = 0; while (cond) { __builtin_amdgcn_s_sleep(1); \
    if ((++_sp & 255u) == 0u) { if (xb_ld(&(bar)[XB_TMO])) break; if (_sp > XB_SPIN_CAP) { atomicAdd(&(bar)[XB_TMO], 1u); break; } } } } while (0)
struct XcdBarrier { unsigned* bar; unsigned x; volatile LAS unsigned* st; };
__device__ __forceinline__ XcdBarrier xcd_barrier_post(unsigned* bar, volatile LAS unsigned* st) {
    XcdBarrier b; b.bar = bar; b.x = xb_xcc_id(); b.st = st;
    if (threadIdx.x == 0) (void)xb_add(&bar[XB_XCNT(b.x)], 1u);
    return b;
}
__device__ __forceinline__ void xcd_barrier_complete(unsigned* bar, unsigned x, unsigned& nloc, unsigned& nx) {
    const unsigned G = gridDim.x * gridDim.y * gridDim.z;
    unsigned sum, cnt, mine, sp = 0u;
    for (;;) {
        sum = 0u; cnt = 0u; mine = 0u;
#pragma unroll
        for (unsigned j = 0; j < 16; ++j) { const unsigned c = xb_ld(&bar[XB_XCNT(j)]); sum += c; cnt += (c > 0u) ? 1u : 0u; mine = (j == x) ? c : mine; }
        if (sum == G) break;
        __builtin_amdgcn_s_sleep(1);
        if ((++sp & 255u) == 0u) { if (xb_ld(&bar[XB_TMO])) break; if (sp > XB_SPIN_CAP) { atomicAdd(&bar[XB_TMO], 1u); break; } }
    }
    nloc = mine > 0u ? mine : 1u; nx = cnt > 0u ? cnt : 1u;
}
__device__ __forceinline__ void xcd_barrier(const XcdBarrier& b, int wv) {
    asm volatile("s_waitcnt vmcnt(0)" ::: "memory");
    __syncthreads();
    if (opaque_tid(wv) == 0) {
        unsigned* bar = b.bar;
        __builtin_amdgcn_s_waitcnt(0);
        unsigned nloc = b.st[0], nx = b.st[1];
        if (nloc == 0u) { xcd_barrier_complete(bar, b.x, nloc, nx); b.st[0] = nloc; b.st[1] = nx; }
        const unsigned old = xb_add(&bar[XB_XSUB(b.x)], 1u);
        const unsigned gen = old / nloc;
        if (old + 1u == (gen + 1u) * nloc) {
            __builtin_amdgcn_fence(__ATOMIC_RELEASE, "agent");
            asm volatile("s_waitcnt vmcnt(0)" ::: "memory");
            const unsigned og = xb_add(&bar[XB_TOP], 1u);
            const unsigned tg = og / nx;
            if (og + 1u == (tg + 1u) * nx) xb_add(&bar[XB_TOPGEN], 1u);
            else XB_SPIN(xb_ld(&bar[XB_TOPGEN]) == tg, bar);
            __builtin_amdgcn_fence(__ATOMIC_ACQUIRE, "agent");
            xb_add(&bar[XB_XGEN(b.x)], 1u);
            asm volatile("s_waitcnt vmcnt(0)" ::: "memory");
        } else {
            XB_SPIN(xb_ld(&bar[XB_XGEN(b.x)]) == gen, bar);
            __builtin_amdgcn_fence(__ATOMIC_ACQUIRE, "agent");
            asm volatile("s_waitcnt vmcnt(0)" ::: "memory");
        }
    }
    __syncthreads();
}

__global__ void __launch_bounds__(512, 2) hybrid_fwd(Params Punused) {
    extern __shared__ __attribute__((aligned(16))) unsigned char lds_raw[];
    LAS unsigned char* lds = (LAS unsigned char*)lds_raw;
    cg::grid_group grid = cg::this_grid();
    const int wv = __builtin_amdgcn_readfirstlane((int)(threadIdx.x >> 6));
    volatile LAS unsigned* bst = (volatile LAS unsigned*)(lds + LDS_BST);
    if (threadIdx.x < 4) bst[threadIdx.x] = 0u;
    __syncthreads();
    { const Params P0 = load_params(); (void)xcd_barrier_post((unsigned*)(P0.ws + WS_BAR), bst); }
#define GSYNC() do { const Params Pb = load_params(); XcdBarrier xb_; xb_.bar = (unsigned*)(Pb.ws + WS_BAR); xb_.x = xb_xcc_id(); xb_.st = (volatile LAS unsigned*)(lds + LDS_BST); xcd_barrier(xb_, wv); } while (0)
    phase_prep(lds, wv);
    grid.sync();
    phase_modreduce(wv);
    GSYNC();
    phase_modulate(0, 0, 0, false, wv);
    GSYNC();
    run_in_gemm(lds, 0, true, 0, 0, 0, wv);
    phase_modulate(0, 1, 1, true, wv);
    GSYNC();
    for (int st = 0; st < 16; ++st) {
        const int layer = st >> 2, g = st & 3, j = st >> 3, nst = st + 1;
        if ((layer & 1) == 0) {
            phase_convmix(j, g, wv);
            GSYNC();
        } else {
            phase_uc(j, wv);
            GSYNC();
            run_qkv_nat(lds, j, false, wv); run_tr(lds, j, false, wv); run_tr(lds, j, true, wv); run_gates(lds, j, 0, wv); run_gates(lds, j, 1, wv);
            GSYNC();
            run_qk(lds, wv); phase_gatetab(lds, j, wv);
            GSYNC();
            phase_scan(lds, j, wv);
            GSYNC();
            phase_gating(j, wv);
            GSYNC();
        }
        run_out_gemm(lds, layer, g, wv);
        if (nst < 16) run_in_gemm(lds, nst >> 3, ((nst >> 2) & 1) == 0, 256 - 144, nst & 3, nst & 1, wv);
        if (st == 15) phase_final(0, 3 * GB * SEQ, true, wv);
        if (st + 2 < 16) phase_modulate((st + 2) >> 2, (st + 2) & 3, st & 1, true, wv);
        GSYNC();
    }
    phase_final(3 * GB * SEQ, NB * SEQ, false, wv);
}

extern "C" void kernel_launch(void* const* d_in, const int* in_sizes, int n_in, void* d_out, int out_size, void* d_ws, size_t ws_size, hipStream_t stream) {
    static int grid_blocks = 0;
    if (grid_blocks == 0) {
        if (n_in != 21 || out_size != NB * SEQ * DM || ws_size < WS_END) { fprintf(stderr, "kernel_launch: unexpected shapes (n_in %d out %d ws %zu)\n", n_in, out_size, ws_size); grid_blocks = -1; return; }
        int dev = 0, cus = 0, per_cu = 0;
        if (hipGetDevice(&dev) != hipSuccess || hipDeviceGetAttribute(&cus, hipDeviceAttributeMultiprocessorCount, dev) != hipSuccess) { grid_blocks = -1; return; }
        if (hipFuncSetAttribute((const void*)hybrid_fwd, hipFuncAttributeMaxDynamicSharedMemorySize, LDS_BYTES) != hipSuccess) { fprintf(stderr, "kernel_launch: hipFuncSetAttribute failed\n"); grid_blocks = -1; return; }
        if (hipOccupancyMaxActiveBlocksPerMultiprocessor(&per_cu, (const void*)hybrid_fwd, 512, LDS_BYTES) != hipSuccess || per_cu < 1) { fprintf(stderr, "kernel_launch: occupancy query says %d\n", per_cu); per_cu = 1; }
        (void)hipGetLastError();
        grid_blocks = cus;
    }
    if (grid_blocks < 0) return;
    if (hipMemsetAsync((char*)d_ws + WS_BAR, 0, XCD_BAR_WORDS * sizeof(unsigned), stream) != hipSuccess) { fprintf(stderr, "kernel_launch: memset of the barrier words failed\n"); return; }
    Params p{};
    const float** pp = (const float**)&p;
    for (int i = 0; i < 21; ++i) pp[i] = (const float*)d_in[i];
    p.out = (float*)d_out; p.ws = (unsigned char*)d_ws;
    void* args[] = {&p};
    hipError_t e = hipLaunchCooperativeKernel((const void*)hybrid_fwd, dim3(grid_blocks), dim3(512), args, LDS_BYTES, stream);
    if (e != hipSuccess) fprintf(stderr, "cooperative launch failed: %s (grid %d)\n", hipGetErrorString(e), grid_blocks);
}
```

```cpp
#include <hip/hip_runtime.h>
#include <hip/hip_cooperative_groups.h>
#include <cstdio>
namespace cg = cooperative_groups;

#define LAS __attribute__((address_space(3)))
typedef unsigned short bf16_t;
typedef short bf16x8 __attribute__((ext_vector_type(8)));
typedef float f32x4 __attribute__((ext_vector_type(4)));
typedef unsigned u32x4 __attribute__((ext_vector_type(4)));
typedef unsigned u32x2 __attribute__((ext_vector_type(2)));

constexpr int DM = 1024, DI = 2048, NB = 16, SEQ = 2048, CTXL = 256, TT = 2304  , NH = 4, DH = 512;
constexpr int GB = 4  , RG = GB * TT  , MT = RG / 256  ;
constexpr float EPSV = 1e-6f;
constexpr size_t MIB = 1ull << 20;
constexpr size_t WS_CWIN = 0, WS_CWOUT = 32 * MIB, WS_MWIN = 40 * MIB, WS_MWQKV = 64 * MIB, WS_MWOUT = 76 * MIB, WS_MWG = 84 * MIB,
                 WS_MODP = 90 * MIB, WS_MOD = 97 * MIB, WS_XC = 98 * MIB, WS_HX = 114 * MIB, WS_BIG = 132 * MIB, WS_UC = WS_BIG + 108 * MIB,
                 WS_QKV = 276 * MIB, WS_KT = 384 * MIB, WS_VT = 420 * MIB, WS_QKR = 456 * MIB, WS_GATES = 465 * MIB, WS_BAR = 466 * MIB, WS_GATESP = 468 * MIB  , WS_HX2 = 474 * MIB  , WS_GTAB = 492 * MIB  , WS_END = 493 * MIB;
constexpr int LDS_BST = 139264;
constexpr int LDS_BYTES = LDS_BST + 16;

struct Params {
    const float *x, *c, *ctx, *c_ctx, *norm_g, *mod_w, *mod_b, *conv_w_in, *conv_w, *conv_w_out, *m_w_in, *m_conv_w, *m_wq, *m_wk, *m_wv,
        *m_w_gate, *m_b_gate, *m_norm_g, *m_skip, *m_w_out, *final_g;
    float* out; unsigned char* ws;
};

__device__ __forceinline__ unsigned cvt_pk_bf16(float lo, float hi) { unsigned r; asm volatile("v_cvt_pk_bf16_f32 %0, %1, %2" : "=v"(r) : "v"(lo), "v"(hi)); return r; }
__device__ __forceinline__ float bf_lo(unsigned w) { return __uint_as_float(w << 16); }
__device__ __forceinline__ float bf_hi(unsigned w) { return __uint_as_float(w & 0xffff0000u); }
__device__ __forceinline__ void unpack8(u32x4 v, float* f) { f[0] = bf_lo(v.x); f[1] = bf_hi(v.x); f[2] = bf_lo(v.y); f[3] = bf_hi(v.y); f[4] = bf_lo(v.z); f[5] = bf_hi(v.z); f[6] = bf_lo(v.w); f[7] = bf_hi(v.w); }
__device__ __forceinline__ u32x4 pack8(const float* f) { u32x4 o; o.x = cvt_pk_bf16(f[0], f[1]); o.y = cvt_pk_bf16(f[2], f[3]); o.z = cvt_pk_bf16(f[4], f[5]); o.w = cvt_pk_bf16(f[6], f[7]); return o; }
__device__ __forceinline__ float silu_f(float v) { return v * __builtin_amdgcn_rcpf(1.f + __expf(-v)); }
__device__ __forceinline__ float sigmoid_f(float v) { return __builtin_amdgcn_rcpf(1.f + __expf(-v)); }
__device__ __forceinline__ float lane_read(float v, int srclane) { return __int_as_float(__builtin_amdgcn_ds_bpermute(srclane << 2, __float_as_int(v))); }
__device__ __forceinline__ float wave_sum(float v, int lane) {
    (void)lane;
#define DPPS(x, ctrl, rmask) __int_as_float(__builtin_amdgcn_update_dpp(0, __float_as_int(x), ctrl, rmask, 0xf, false))
    v += DPPS(v, 0x111, 0xf); v += DPPS(v, 0x112, 0xf); v += DPPS(v, 0x114, 0xf); v += DPPS(v, 0x118, 0xf);
    v += DPPS(v, 0x142, 0xa); v += DPPS(v, 0x143, 0xc);
#undef DPPS
    return __int_as_float(__builtin_amdgcn_readlane(__float_as_int(v), 63));
}
#define LDS_WAIT() asm volatile("s_waitcnt lgkmcnt(0)" ::: "memory")
template <class T> __device__ __forceinline__ T* opq(T* p) { return p; }
#define CAS __attribute__((address_space(4)))
#define GAS __attribute__((address_space(1)))
__device__ __forceinline__ Params load_params() {
    int z = 0; asm volatile("" : "+s"(z));
    const CAS unsigned long long* kp = (const CAS unsigned long long*)((const CAS char*)__builtin_amdgcn_kernarg_segment_ptr() + z);
    Params r;
#define LP_F(i, name) r.name = (const float*)(const GAS float*)kp[i];
    LP_F(0, x) LP_F(1, c) LP_F(2, ctx) LP_F(3, c_ctx) LP_F(4, norm_g) LP_F(5, mod_w) LP_F(6, mod_b) LP_F(7, conv_w_in) LP_F(8, conv_w) LP_F(9, conv_w_out) LP_F(10, m_w_in)
    LP_F(11, m_conv_w) LP_F(12, m_wq) LP_F(13, m_wk) LP_F(14, m_wv) LP_F(15, m_w_gate) LP_F(16, m_b_gate) LP_F(17, m_norm_g) LP_F(18, m_skip) LP_F(19, m_w_out) LP_F(20, final_g)
#undef LP_F
    r.out = (float*)(GAS float*)kp[21]; r.ws = (unsigned char*)(GAS unsigned char*)kp[22];
    return r;
}
__device__ __forceinline__ int opaque_tid(int wv) {
    int ln; asm volatile("v_mbcnt_lo_u32_b32 %0, -1, 0\n\tv_mbcnt_hi_u32_b32 %0, -1, %0" : "=&v"(ln)); return wv * 64 + ln; }

constexpr int BM = 256, BK = 64, HALF = 128, HTB = HALF * BK * 2, NXCD = 8, WGM = 8;
__device__ __forceinline__ int lds_byte(int r, int c) { const int st = (r >> 4) * 2 + (c >> 5), rr = r & 15, cc = c & 31, ob = rr * 64 + cc * 2; return st * 1024 + (ob ^ (((ob >> 9) & 1) << 5)); }
__device__ __forceinline__ void stage_rc(int b, int& R, int& C) { const int st = b / 1024, sb = b % 1024, swz = sb ^ (((sb >> 9) & 1) << 5); R = (st >> 1) * 16 + swz / 64; C = (st & 1) * 32 + (swz % 64) / 2; }
__device__ __forceinline__ int perm32(int rho) { const int n = rho >> 4, i = rho & 15; return 8 * (i >> 2) + 4 * n + (i & 3); }
__device__ __forceinline__ int qperm32(int p) { const int q = p >> 3, jj = p & 7; return jj < 4 ? 4 * q + jj : 16 + 4 * q + (jj - 4); }
struct Unit { int pm, pn; };
__device__ __forceinline__ bool tile_next(int i, int G, int c, int nM, int nN, Unit& u, int tailc = 0) {
    const int nwg = nM * nN; long L = (long)i * G + c;
    if (tailc > 0) { const int fr_ = nwg / G, full = fr_ * G, rem = nwg - full;
        if (i >= fr_) { const int k = i - fr_; if (k == 0) { if (c >= tailc) return false; L = full + c; } else if (k == 1) { if (c >= rem - tailc) return false; L = full + tailc + c; } else return false; } }
    if (L >= nwg) return false;
    int wgid = (int)L; { const int q = nwg / NXCD, r = nwg % NXCD, xcd = wgid % NXCD, off = wgid / NXCD; wgid = (xcd < r ? xcd * (q + 1) : r * (q + 1) + (xcd - r) * q) + off; }
    const int nig = WGM * nN, gid = wgid / nig, fm = gid * WGM, gsz = (nM - fm) < WGM ? (nM - fm) : WGM;
    u.pm = fm + ((wgid % nig) % gsz); u.pn = (wgid % nig) / gsz; return true;
}

__device__ __forceinline__ void store_bf16_tile(const f32x4 (&acc)[2][2][4][2], bf16_t* base, size_t ldc, float scale, int wr, int wc, int fr, int fq) {
    bf16_t* p0 = base + (size_t)(wr * 64 + fr) * ldc + wc * 32 + 8 * fq;
#pragma unroll
    for (int ai = 0; ai < 2; ++ai)
#pragma unroll
        for (int m = 0; m < 4; ++m) { bf16_t* rowp = p0 + (size_t)(ai * HALF + m * 16) * ldc;
#pragma unroll
            for (int bj = 0; bj < 2; ++bj) { const f32x4 v0 = acc[ai][bj][m][0] * scale, v1 = acc[ai][bj][m][1] * scale;
                u32x4 w; w.x = cvt_pk_bf16(v0[0], v0[1]); w.y = cvt_pk_bf16(v0[2], v0[3]); w.z = cvt_pk_bf16(v1[0], v1[1]); w.w = cvt_pk_bf16(v1[2], v1[3]);
                *(u32x4*)(rowp + bj * HALF) = w; } }
}

template <class PH>
__device__ __forceinline__ void gemm_phase(LAS unsigned char* lds, const PH& S, int wv) {
    const int tid = opaque_tid(wv);
    const int wid = __builtin_amdgcn_readfirstlane(tid >> 6), lane = tid & 63, wr = wid >> 2, wc = wid & 3, fr = lane & 15, fq = lane >> 4;
    const int K = S.K, nt = K / BK;
    const int G = gridDim.x, cblk = (int)((blockIdx.x + (unsigned)S.coff) % gridDim.x);
    unsigned voffA[2], voffB[2];
#pragma unroll
    for (int i = 0; i < 2; ++i) { int R, C; stage_rc(tid * 16 + i * 8192, R, C); const int Rb = PH::PERM ? ((R & ~31) + perm32(R & 31)) : R;
        const int Rs = PH::QPERM ? ((Rb & ~31) + qperm32(Rb & 31)) : Rb;
        voffA[i] = (unsigned)(R * S.lda + C) * 2u; voffB[i] = (unsigned)(Rs * S.ldb + C) * 2u; }
    const size_t kstep = (size_t)(BK * 2);
    const size_t hstepA = (size_t)HALF * S.lda * 2, hstepB = (size_t)HALF * S.ldb * 2;
    const unsigned ldsw = (unsigned)wid * 1024u;
    const int aoff = lds_byte(wr * 64 + fr, fq * 8), boff = lds_byte(wc * 32 + fr, fq * 8);
#define PG8_SA(b, h) (((b) * 2 + (h)) * HTB)
#define PG8_SB(b, h) ((4 + (b) * 2 + (h)) * HTB)
#define PG8_STAGE(bufoff, gbase, voff) do { _Pragma("unroll") for (int _i = 0; _i < 2; ++_i) \
        __builtin_amdgcn_global_load_lds((const unsigned*)((const char*)(gbase) + (voff)[_i]), (LAS unsigned*)(lds + (bufoff) + ldsw + _i * 8192), 16, 0, 0); } while (0)
#define PG8_LDA(dst, b, h) do { _Pragma("unroll") for (int m = 0; m < 4; ++m) _Pragma("unroll") for (int k = 0; k < 2; ++k) dst[m][k] = *(const LAS bf16x8*)(lds + PG8_SA(b, h) + aoff + m * 2048 + k * 1024); } while (0)
#define PG8_LDB(dst, b, h) do { _Pragma("unroll") for (int n = 0; n < 2; ++n) _Pragma("unroll") for (int k = 0; k < 2; ++k) dst[n][k] = *(const LAS bf16x8*)(lds + PG8_SB(b, h) + boff + n * 2048 + k * 1024); } while (0)
#define PG8_MMA(ai, bj, At, Bt) do { __builtin_amdgcn_s_setprio(1); _Pragma("unroll") for (int m = 0; m < 4; ++m) _Pragma("unroll") for (int n = 0; n < 2; ++n) _Pragma("unroll") for (int k = 0; k < 2; ++k) \
        acc[ai][bj][m][n] = __builtin_amdgcn_mfma_f32_16x16x32_bf16(Bt[n][k], At[m][k], acc[ai][bj][m][n], 0, 0, 0); __builtin_amdgcn_s_setprio(0); } while (0)
#define PG8_WAIT_V(n) asm volatile("s_waitcnt vmcnt(" #n ")" ::: "memory")
#define PG8_WAIT_L(n) asm volatile("s_waitcnt lgkmcnt(" #n ")" ::: "memory")
#define PG8_BAR __builtin_amdgcn_s_barrier()
#define PG8_SCHED __builtin_amdgcn_sched_barrier(0)
    Unit cur, nxt; int ui = 0;
    if (!tile_next(0, G, cblk, S.nM, S.nN, cur, S.coff != 0 ? PH::TAILC : 0)) return;
    f32x4 acc[2][2][4][2];
#pragma unroll
    for (int a = 0; a < 2; ++a)
#pragma unroll
        for (int b = 0; b < 2; ++b)
#pragma unroll
            for (int m = 0; m < 4; ++m)
#pragma unroll
                for (int n = 0; n < 2; ++n) acc[a][b][m][n] = (f32x4){0.f, 0.f, 0.f, 0.f};
    bf16x8 At[4][2], B0[2][2], B1[2][2];
    const char* cA = S.aptr(cur); const char* cB = S.bptr(cur);
    PG8_STAGE(PG8_SB(0, 0), cB, voffB); PG8_STAGE(PG8_SA(0, 0), cA, voffA); PG8_STAGE(PG8_SB(0, 1), cB + hstepB, voffB); PG8_STAGE(PG8_SA(0, 1), cA + hstepA, voffA);
    if (wr == 1) PG8_BAR;
    PG8_WAIT_V(4); PG8_BAR;
    PG8_STAGE(PG8_SB(1, 0), cB + kstep, voffB); PG8_STAGE(PG8_SA(1, 0), cA + kstep, voffA); PG8_STAGE(PG8_SB(1, 1), cB + hstepB + kstep, voffB);
    PG8_WAIT_V(6); PG8_BAR;
    for (;;) {
        const bool has_next = tile_next(ui + 1, G, cblk, S.nM, S.nN, nxt, S.coff != 0 ? PH::TAILC : 0);
        const char* nA = has_next ? S.aptr(nxt) : cA; const char* nB = has_next ? S.bptr(nxt) : cB;
        for (int t = 0; t < nt; t += 2) {
            const bool last = (t == nt - 2);
            const char* a1 = cA + (size_t)(t + 1) * kstep;
            const char* a2 = last ? nA : cA + (size_t)(t + 2) * kstep; const char* b2 = last ? nB : cB + (size_t)(t + 2) * kstep;
            const char* a3 = a2 + kstep; const char* b3 = b2 + kstep;
            PG8_LDB(B0, 0, 0); PG8_SCHED; PG8_LDA(At, 0, 0); PG8_STAGE(PG8_SA(1, 1), a1 + hstepA, voffA);
            PG8_WAIT_L(8); PG8_BAR; PG8_WAIT_L(0); PG8_MMA(0, 0, At, B0); PG8_BAR; PG8_SCHED;
            PG8_LDB(B1, 0, 1); PG8_STAGE(PG8_SB(0, 0), b2, voffB);
            PG8_BAR; PG8_WAIT_L(0); PG8_MMA(0, 1, At, B1); PG8_BAR;
            PG8_LDA(At, 0, 1); PG8_STAGE(PG8_SA(0, 0), a2, voffA);
            PG8_BAR; PG8_WAIT_L(0); PG8_MMA(1, 0, At, B0); PG8_BAR; PG8_SCHED;
            PG8_STAGE(PG8_SB(0, 1), b2 + hstepB, voffB);
            PG8_WAIT_V(6); PG8_BAR; PG8_MMA(1, 1, At, B1); PG8_BAR;
            PG8_LDB(B0, 1, 0); PG8_SCHED; PG8_LDA(At, 1, 0); PG8_STAGE(PG8_SA(0, 1), a2 + hstepA, voffA);
            PG8_WAIT_L(8); PG8_BAR; PG8_WAIT_L(0); PG8_MMA(0, 0, At, B0); PG8_BAR; PG8_SCHED;
            PG8_LDB(B1, 1, 1); PG8_STAGE(PG8_SB(1, 0), b3, voffB);
            PG8_BAR; PG8_WAIT_L(0); PG8_MMA(0, 1, At, B1); PG8_BAR;
            PG8_LDA(At, 1, 1); PG8_STAGE(PG8_SA(1, 0), a3, voffA);
            PG8_BAR; PG8_WAIT_L(0); PG8_MMA(1, 0, At, B0); PG8_BAR; PG8_SCHED;
            PG8_STAGE(PG8_SB(1, 1), b3 + hstepB, voffB);
            PG8_WAIT_V(6); PG8_BAR; PG8_MMA(1, 1, At, B1); PG8_BAR;
        }
        S.epi(acc, cur, wr, wc, fr, fq);
        if (!has_next) break;
#pragma unroll
        for (int a = 0; a < 2; ++a)
#pragma unroll
            for (int b = 0; b < 2; ++b)
#pragma unroll
                for (int m = 0; m < 4; ++m)
#pragma unroll
                    for (int n = 0; n < 2; ++n) acc[a][b][m][n] = (f32x4){0.f, 0.f, 0.f, 0.f};
        cur = nxt; cA = nA; cB = nB; ++ui;
    }
    PG8_WAIT_V(0);
    if (wr == 0) PG8_BAR;
    PG8_BAR;
#undef PG8_SA
#undef PG8_SB
#undef PG8_STAGE
#undef PG8_LDA
#undef PG8_LDB
#undef PG8_MMA
#undef PG8_WAIT_V
#undef PG8_WAIT_L
#undef PG8_BAR
#undef PG8_SCHED
}

struct PhPlain {
    static constexpr bool PERM = true; static constexpr int TAILC = 0; static constexpr bool QPERM = false;
    int K, lda, ldb, nM, nN, coff; const bf16_t *A, *B; bf16_t* O; int ldc;
    __device__ __forceinline__ const char* aptr(const Unit& u) const { return (const char*)(A + (size_t)u.pm * 256 * lda); }
    __device__ __forceinline__ const char* bptr(const Unit& u) const { return (const char*)(B + (size_t)u.pn * 256 * ldb); }
    __device__ __forceinline__ void epi(const f32x4 (&acc)[2][2][4][2], const Unit& u, int wr, int wc, int fr, int fq) const {
        store_bf16_tile(acc, O + (size_t)u.pm * 256 * ldc + (size_t)u.pn * 256, (size_t)ldc, 1.f, wr, wc, fr, fq);
    }
};
#define DPP4(dst, src, ctrl) { _Pragma("unroll") for (int i_ = 0; i_ < 4; ++i_) dst[i_] = __int_as_float(__builtin_amdgcn_update_dpp(0, __float_as_int(src[i_]), ctrl, 0xf, 0xf, false)); }
struct PhConvFused {
    static constexpr bool PERM = true; static constexpr int TAILC = 112; static constexpr bool QPERM = false;
    int K, lda, ldb, nM, nN, coff; const bf16_t *A, *B; bf16_t* BIG; bf16_t* Y; const float* cw;
    __device__ __forceinline__ const char* aptr(const Unit& u) const { return (const char*)(A + (size_t)u.pm * 256 * lda); }
    __device__ __forceinline__ const char* bptr(const Unit& u) const { return (const char*)(B + (size_t)u.pn * 256 * ldb); }
    __device__ __forceinline__ void epi(const f32x4 (&acc)[2][2][4][2], const Unit& u, int wr, int wc, int fr, int fq) const {
        const int jc = u.pn * 64 + 16 * wc + 4 * fq;
        if (u.pm % 9 == 0) {
#pragma unroll
            for (int ai = 0; ai < 2; ++ai)
#pragma unroll
                for (int m = 0; m < 4; ++m) { bf16_t* rowp = BIG + (size_t)(u.pm * 256 + ai * HALF + wr * 64 + m * 16 + fr) * 8192 + jc;
#pragma unroll
                    for (int bj = 0; bj < 2; ++bj)
#pragma unroll
                        for (int n = 0; n < 2; ++n) { const f32x4 v = acc[ai][bj][m][n]; u32x2 o; o.x = cvt_pk_bf16(v[0], v[1]); o.y = cvt_pk_bf16(v[2], v[3]);
                            *(u32x2*)(rowp + (2 * bj + n) * 2048) = o; } }
            return;
        }
        const f32x4 w0 = *(const f32x4*)(cw + jc), w1 = *(const f32x4*)(cw + DI + jc), w2 = *(const f32x4*)(cw + 2 * DI + jc);
#pragma unroll
        for (int ai = 0; ai < 2; ++ai) {
            f32x4 cu[4];
#pragma unroll
            for (int m = 0; m < 4; ++m) cu[m] = acc[ai][0][m][1] * acc[ai][1][m][0];
#pragma unroll
            for (int m = 0; m < 4; ++m) {
                f32x4 pv, nx, t;
                DPP4(pv, cu[m], 0x111)
                if (m > 0) { DPP4(t, cu[m - 1], 0x121) if (fr == 0) pv = t; }
                DPP4(nx, cu[m], 0x101)
                if (m < 3) { DPP4(t, cu[m + 1], 0x12F) if (fr == 15) nx = t; }
                const f32x4 bb = acc[ai][0][m][0], zz = acc[ai][1][m][1];
                f32x4 y;
#pragma unroll
                for (int i = 0; i < 4; ++i) y[i] = bb[i] * (w0[i] * pv[i] + w1[i] * cu[m][i] + w2[i] * nx[i]) * silu_f(zz[i]);
                u32x2 o; o.x = cvt_pk_bf16(y[0], y[1]); o.y = cvt_pk_bf16(y[2], y[3]);
                *(u32x2*)(Y + (size_t)(u.pm * 256 + ai * HALF + wr * 64 + m * 16 + fr) * DI + jc) = o;
            }
        }
    }
};
struct PhQKV {
    static constexpr bool PERM = true; static constexpr int TAILC = 0; static constexpr bool QPERM = true;
    int K, lda, ldb, nM, nN, coff; const bf16_t* A; const bf16_t* W  ; bf16_t* O; int which0;
    __device__ __forceinline__ const char* aptr(const Unit& u) const { const int h = (u.pn >> 1) & 3; return (const char*)(A + (size_t)u.pm * 256 * lda + h * 512); }
    __device__ __forceinline__ const char* bptr(const Unit& u) const { const int which = which0 + (u.pn >> 3), h = (u.pn >> 1) & 3, half = u.pn & 1;
        return (const char*)(W + ((size_t)(which * 4 + h) * 512 + half * 256) * 512); }
    __device__ __forceinline__ void epi(const f32x4 (&acc)[2][2][4][2], const Unit& u, int wr, int wc, int fr, int fq) const {
        const int which = which0 + (u.pn >> 3), h = (u.pn >> 1) & 3, half = u.pn & 1;
        store_bf16_tile(acc, O + (size_t)u.pm * 256 * 6144 + which * 2048 + h * 512 + half * 256, 6144, which == 1 ? 0.044194173824159216f : 1.f, wr, wc, fr, fq);
    }
};
struct PhTr {
    static constexpr bool PERM = true; static constexpr int TAILC = 0; static constexpr bool QPERM = false;
    int K, lda, ldb, nM, nN, coff; const bf16_t* W  ; const bf16_t* Act; bf16_t* OT; float scale;
    __device__ __forceinline__ const char* aptr(const Unit& u) const { const int h = u.pm >> 1, mh = u.pm & 1; return (const char*)(W + ((size_t)h * 512 + mh * 256) * 512); }
    __device__ __forceinline__ const char* bptr(const Unit& u) const { const int h = u.pm >> 1; return (const char*)(Act + (size_t)u.pn * 256 * ldb + h * 512); }
    __device__ __forceinline__ void epi(const f32x4 (&acc)[2][2][4][2], const Unit& u, int wr, int wc, int fr, int fq) const {
        const int h = u.pm >> 1, mh = u.pm & 1, bl = u.pn / 9, w = u.pn % 9;
        store_bf16_tile(acc, OT + ((size_t)(bl * 4 + h) * 512 + mh * 256) * TT + w * 256, (size_t)TT, scale, wr, wc, fr, fq);
    }
};
struct PhQK {
    static constexpr bool PERM = false; static constexpr int TAILC = 0; static constexpr bool QPERM = false;
    int K, lda, ldb, nM, nN, coff; const bf16_t* QKV; float* QKR;
    __device__ __forceinline__ const char* aptr(const Unit& u) const { const int bl = u.pm / 36, h = (u.pm / 9) & 3, w = u.pm % 9; return (const char*)(QKV + (size_t)(bl * TT + w * 256) * 6144 + h * 512); }
    __device__ __forceinline__ const char* bptr(const Unit& u) const { const int bl = u.pm / 36, h = (u.pm / 9) & 3, w = u.pm % 9; return (const char*)(QKV + (size_t)(bl * TT + w * 256) * 6144 + 2048 + h * 512); }
    __device__ __forceinline__ void epi(const f32x4 (&acc)[2][2][4][2], const Unit& u, int wr, int wc, int fr, int fq) const {
        if (wr != (wc >> 1)) return;
        const int bl = u.pm / 36, h = (u.pm / 9) & 3, w = u.pm % 9;
        float* base = QKR + ((size_t)(bl * 4 + h) * TT + w * 256 + wr * 64 + fr) * 64 + 32 * (wc & 1) + 4 * fq;
#pragma unroll
        for (int ai = 0; ai < 2; ++ai)
#pragma unroll
            for (int m = 0; m < 4; ++m)
#pragma unroll
                for (int n = 0; n < 2; ++n) *(f32x4*)(base + (size_t)(ai * 128 + m * 16) * 64 + n * 16) = acc[ai][ai][m][n];
    }
};
struct PhGates {
    static constexpr bool PERM = false; static constexpr int TAILC = 0; static constexpr bool QPERM = false;
    int K, lda, ldb, nM, nN, coff; const bf16_t* A; const bf16_t* WG; float* GATESP; int poff;
    __device__ __forceinline__ const char* aptr(const Unit& u) const { return (const char*)(A + (size_t)u.pm * 256 * lda + u.pn * 512); }
    __device__ __forceinline__ const char* bptr(const Unit& u) const { return (const char*)(WG + u.pn * 512); }
    __device__ __forceinline__ void epi(const f32x4 (&acc)[2][2][4][2], const Unit& u, int wr, int wc, int fr, int fq) const {
        if (wc != 0) return;
        float* base = GATESP + (size_t)(poff + u.pn) * RG * 16 + (size_t)(u.pm * 256 + wr * 64 + fr) * 16 + 4 * fq;
#pragma unroll
        for (int ai = 0; ai < 2; ++ai)
#pragma unroll
            for (int m = 0; m < 4; ++m) *(f32x4*)(base + (size_t)(ai * 128 + m * 16) * 16) = acc[ai][0][m][0];
    }
};
struct PhResid {
    static constexpr bool PERM = false; static constexpr int TAILC = 0; static constexpr bool QPERM = false;
    int K, lda, ldb, nM, nN, coff; const bf16_t *A, *B; const float *xin_x, *xin_c; float *xout_x, *xout_c; const float* mod  ; int g;
    __device__ __forceinline__ const char* aptr(const Unit& u) const { return (const char*)(A + (size_t)u.pm * 256 * lda); }
    __device__ __forceinline__ const char* bptr(const Unit& u) const { return (const char*)(B + (size_t)u.pn * 256 * ldb); }
    __device__ __forceinline__ void epi(const f32x4 (&acc)[2][2][4][2], const Unit& u, int wr, int wc, int fr, int fq) const {
        const int bl = u.pm / 9, w = u.pm % 9, b = g * GB + bl;
        const float* xin; float* xout; size_t rbase; int v;
        if (w == 0) { rbase = (size_t)b * CTXL; xin = xin_c; xout = xout_c; v = 16; } else { rbase = (size_t)b * SEQ + (w - 1) * 256; xin = xin_x; xout = xout_x; v = b; }
        const int col0 = u.pn * 256 + wc * 32 + 4 * fq;
        const float* gate = mod + (size_t)v * 3072 + 2048 + col0;
        f32x4 gv[2][2];
#pragma unroll
        for (int bj = 0; bj < 2; ++bj)
#pragma unroll
            for (int n = 0; n < 2; ++n) gv[bj][n] = *(const f32x4*)(gate + bj * HALF + n * 16);
#pragma unroll
        for (int ai = 0; ai < 2; ++ai)
#pragma unroll
            for (int m = 0; m < 4; ++m) { const size_t off = (rbase + wr * 64 + fr + ai * HALF + m * 16) * DM + col0;
#pragma unroll
                for (int bj = 0; bj < 2; ++bj)
#pragma unroll
                    for (int n = 0; n < 2; ++n) { const f32x4 xv = *(const f32x4*)(xin + off + bj * HALF + n * 16);
                        *(f32x4*)(xout + off + bj * HALF + n * 16) = xv + gv[bj][n] * acc[ai][bj][m][n]; } }
    }
};

__device__ __forceinline__ int convin_dst_row(int ns) { const int g = ns >> 11, rem = ns & 2047, pn = rem >> 6, jc = rem & 63;
    return 256 * pn + 128 * (g >> 1) + 32 * (jc >> 4) + 8 * ((jc >> 2) & 3) + 4 * (g & 1) + (jc & 3); }
__device__ __forceinline__ void transpose_item(const float* W, int K, int N, bf16_t* WT, LAS float* scr, int item, int lane, bool perm = false) {
    const int nblk = N / 32, kb = item / nblk, nb = item % nblk, k0 = 64 * kb, n0 = 32 * nb;
    float tv[32];
#pragma unroll
    for (int i = 0; i < 32; ++i) { const int kk = 2 * i + (lane >> 5); tv[i] = W[(size_t)(k0 + kk) * N + n0 + (lane & 31)]; }
#pragma unroll
    for (int i = 0; i < 32; ++i) { const int kk = 2 * i + (lane >> 5); scr[kk * 33 + (lane & 31)] = tv[i]; }
    LDS_WAIT();
    const int c = lane & 7;
#pragma unroll
    for (int j = 0; j < 4; ++j) { const int n = (lane >> 3) + 8 * j; const LAS float* s = scr + (8 * c) * 33 + n;
        u32x4 o; o.x = cvt_pk_bf16(s[0 * 33], s[1 * 33]); o.y = cvt_pk_bf16(s[2 * 33], s[3 * 33]); o.z = cvt_pk_bf16(s[4 * 33], s[5 * 33]); o.w = cvt_pk_bf16(s[6 * 33], s[7 * 33]);
        *(u32x4*)(WT + (size_t)(perm ? convin_dst_row(n0 + n) : (n0 + n)) * K + k0 + 8 * c) = o; }
    LDS_WAIT();
}
__device__ __forceinline__ void phase_prep(LAS unsigned char* lds, int wv) {
    const Params P = load_params();
    const int tid = opaque_tid(wv), lane = tid & 63, wave = tid >> 6;
    unsigned char* ws = opq(P.ws);
    float* MODP = (float*)(ws + WS_MODP);
    for (int item = blockIdx.x; item < 192; item += gridDim.x) {
        const int i = item / 48, rem = item % 48, ks = rem / 6, nb = rem % 6;
        LAS float* sc = (LAS float*)lds;
        for (int idx = tid; idx < 17 * 128; idx += 512) { const int v = idx >> 7, k = idx & 127; const float cv = (v < 16) ? P.c[v * DM + ks * 128 + k] : P.c_ctx[ks * 128 + k]; sc[idx] = silu_f(cv); }
        __syncthreads();
        const int n = nb * 512 + tid;
        float a[17];
#pragma unroll
        for (int v = 0; v < 17; ++v) a[v] = 0.f;
        const float* wp = P.mod_w + ((size_t)i * DM + ks * 128) * 3072 + n;
        for (int k0 = 0; k0 < 128; k0 += 16) {
            float wv[16];
#pragma unroll
            for (int u = 0; u < 16; ++u) wv[u] = wp[(size_t)(k0 + u) * 3072];
#pragma unroll
            for (int u = 0; u < 16; ++u)
#pragma unroll
                for (int v = 0; v < 17; ++v) a[v] += sc[v * 128 + k0 + u] * wv[u]; }
#pragma unroll
        for (int v = 0; v < 17; ++v) MODP[((size_t)(ks * 4 + i) * 17 + v) * 3072 + n] = a[v];
        __syncthreads();
    }
    LAS float* scr = (LAS float*)(lds + 16384 + wave * 8448);
    const int gw = blockIdx.x * 8 + wave, NGW = gridDim.x * 8;
    constexpr int PERJ = 4096 + 1024 + 3072 + 12 * 128 + 1024;
    for (int it = gw; it < 2 * PERJ; it += NGW) {
        const int j = it / PERJ; int r = it % PERJ;
        if (r < 4096) { transpose_item(P.conv_w_in + (size_t)j * DM * 8192, DM, 8192, (bf16_t*)(ws + WS_CWIN) + (size_t)j * 8192 * DM, scr, r, lane, true); continue; } r -= 4096;
        if (r < 1024) { transpose_item(P.conv_w_out + (size_t)j * DI * DM, DI, DM, (bf16_t*)(ws + WS_CWOUT) + (size_t)j * DM * DI, scr, r, lane); continue; } r -= 1024;
        if (r < 3072) { transpose_item(P.m_w_in + (size_t)j * DM * 6144, DM, 6144, (bf16_t*)(ws + WS_MWIN) + (size_t)j * 6144 * DM, scr, r, lane); continue; } r -= 3072;
        if (r < 1536) { const int wh = r / 128, which = wh >> 2, h = wh & 3; const float* src = (which == 0 ? P.m_wq : (which == 1 ? P.m_wk : P.m_wv)) + (size_t)(j * 4 + h) * DH * DH;
            transpose_item(src, DH, DH, (bf16_t*)(ws + WS_MWQKV) + ((size_t)(j * 3 + which) * 4 + h) * DH * DH, scr, r % 128, lane); continue; } r -= 1536;
        transpose_item(P.m_w_out + (size_t)j * DI * DM, DI, DM, (bf16_t*)(ws + WS_MWOUT) + (size_t)j * DM * DI, scr, r, lane);
    }
    bf16_t* MWG2 = (bf16_t*)(ws + WS_MWG);
    for (int item = gw; item < 2 * 2 * 2048; item += NGW) {
        const int j = item >> 12, part = (item >> 11) & 1, kg = item & 2047, h = kg >> 9, d = kg & 511;
        float acc[16];
#pragma unroll
        for (int n = 0; n < 16; ++n) acc[n] = 0.f;
        for (int pass = 0; pass < (part == 0 ? 2 : 1); ++pass) {
            const int which = part == 0 ? pass : 2; const float scl = which == 1 ? 0.044194173824159216f : 1.f;
            const float* wrow = (which == 0 ? P.m_wq : (which == 1 ? P.m_wk : P.m_wv)) + ((size_t)(j * 4 + h) * DH + d) * DH;
            const float* wgp = P.m_w_gate + ((size_t)j * 6144 + which * 2048 + h * 512) * 16;
#pragma unroll
            for (int q = 0; q < 8; ++q) { const int e = lane + 64 * q; const float wvv = wrow[e] * scl;
                const f32x4 g0 = *(const f32x4*)(wgp + (size_t)e * 16), g1 = *(const f32x4*)(wgp + (size_t)e * 16 + 4), g2 = *(const f32x4*)(wgp + (size_t)e * 16 + 8), g3 = *(const f32x4*)(wgp + (size_t)e * 16 + 12);
#pragma unroll
                for (int i = 0; i < 4; ++i) { acc[i] += wvv * g0[i]; acc[4 + i] += wvv * g1[i]; acc[8 + i] += wvv * g2[i]; acc[12 + i] += wvv * g3[i]; } }
        }
        float mine = 0.f;
#pragma unroll
        for (int n = 0; n < 16; ++n) { const float t = wave_sum(acc[n], lane); mine = (lane == n) ? t : mine; }
        if (lane < 16) MWG2[((size_t)(j * 2 + part) * 256 + lane) * 2048 + kg] = (bf16_t)(cvt_pk_bf16(mine, 0.f) & 0xffffu);
    }
    for (size_t idx = (size_t)blockIdx.x * 512 + tid; idx < (size_t)4 * 240 * 2048; idx += (size_t)gridDim.x * 512) {
        const int m4 = (int)(idx / (240 * 2048)); const int rem = (int)(idx % (240 * 2048));
        MWG2[((size_t)m4 * 256 + 16) * 2048 + rem] = (bf16_t)0;
    }
    __syncthreads();
}
__device__ __forceinline__ void phase_modreduce(int wv) {
    const Params P = load_params();
    unsigned char* ws = opq(P.ws);
    const float* MODP = (const float*)(ws + WS_MODP); float* MOD = (float*)(ws + WS_MOD);
    for (int idx = blockIdx.x * 512 + opaque_tid(wv); idx < 4 * 17 * 3072; idx += gridDim.x * 512) {
        const int i = idx / (17 * 3072), n = idx % 3072;
        float s = P.mod_b[i * 3072 + n];
#pragma unroll
        for (int ks = 0; ks < 8; ++ks) s += MODP[(size_t)ks * 4 * 17 * 3072 + idx];
        MOD[idx] = s;
    }
}

__device__ __forceinline__ void phase_modulate(int layer, int g, int buf, bool light, int wv) {
    if (light && blockIdx.x < 160) return;
    const Params P = load_params();
    const float* xin_x = (layer == 0) ? P.x : P.out; const float* xin_c = (layer == 0) ? P.ctx : (const float*)(P.ws + WS_XC);
    const int tid = opaque_tid(wv), lane = tid & 63, gw = (light ? (int)blockIdx.x - 160 : (int)blockIdx.x) * 8 + (tid >> 6), NGW = (light ? 96 : (int)gridDim.x) * 8;
    unsigned char* ws = opq(P.ws); xin_x = opq(xin_x); xin_c = opq(xin_c);
    bf16_t* HX = (bf16_t*)(ws + (buf ? WS_HX2 : WS_HX)); const float* MOD = (const float*)(ws + WS_MOD) + (size_t)layer * 17 * 3072;
    const float* ng = opq(P.norm_g) + layer * DM;
    for (int r = gw; r < RG; r += NGW) {
        const int bl = r / TT, tt = r % TT, b = g * GB + bl;
        const float* xr; int v;
        if (tt < CTXL) { xr = xin_c + ((size_t)b * CTXL + tt) * DM; v = 16; } else { xr = xin_x + ((size_t)b * SEQ + (tt - CTXL)) * DM; v = b; }
        const float* md = MOD + (size_t)v * 3072;
        f32x4 xv[4]; float ss = 0.f;
#pragma unroll
        for (int q = 0; q < 4; ++q) { xv[q] = *(const f32x4*)(xr + 4 * lane + 256 * q); ss += (xv[q][0] * xv[q][0] + xv[q][1] * xv[q][1]) + (xv[q][2] * xv[q][2] + xv[q][3] * xv[q][3]); }
        const float rstd = rsqrtf(wave_sum(ss, lane) * (1.f / DM) + EPSV);
#pragma unroll
        for (int q = 0; q < 4; ++q) { const int c0 = 4 * lane + 256 * q;
            const f32x4 gv = *(const f32x4*)(ng + c0), sh = *(const f32x4*)(md + c0), sc = *(const f32x4*)(md + 1024 + c0);
            const f32x4 y = xv[q] * rstd * gv * (sc + 1.f) + sh;
            u32x2 o; o.x = cvt_pk_bf16(y[0], y[1]); o.y = cvt_pk_bf16(y[2], y[3]);
            *(u32x2*)(HX + (size_t)r * DM + c0) = o; }
    }
}
__device__ __forceinline__ void conv_valid(int r, bool& pv, bool& nv) {
    const int tt = r % TT;
    if (tt < CTXL) { pv = tt != 0; nv = tt != CTXL - 1; } else { pv = (tt & 63) != 0; nv = (tt & 63) != 63; }
}
__device__ __forceinline__ void phase_convmix(int j, int g, int wv) {
    const Params P = load_params();
    unsigned char* ws = opq(P.ws);
    const bf16_t* BIG = (const bf16_t*)(ws + WS_BIG); bf16_t* Y = (bf16_t*)(ws + ((g & 1) ? WS_KT : WS_VT));
    const float* cw = opq(P.conv_w) + (size_t)j * 3 * DI;
    for (int it = blockIdx.x * 512 + opaque_tid(wv); it < GB * CTXL * 256; it += gridDim.x * 512) {
        const int rc = it >> 8, r = (rc >> 8) * TT + (rc & 255), c8 = (it & 255) * 8; bool pv, nv; conv_valid(r, pv, nv);
        const bf16_t* row = BIG + (size_t)r * 8192 + c8;
        float bb[8], cc[8], uu[8], zz[8], cp[8], up[8], cn[8], un[8];
        unpack8(*(const u32x4*)(row), bb); unpack8(*(const u32x4*)(row + 2048), cc); unpack8(*(const u32x4*)(row + 4096), uu); unpack8(*(const u32x4*)(row + 6144), zz);
        const u32x4 z4 = (u32x4){0u, 0u, 0u, 0u};
        unpack8(pv ? *(const u32x4*)(row - 8192 + 2048) : z4, cp); unpack8(pv ? *(const u32x4*)(row - 8192 + 4096) : z4, up);
        unpack8(nv ? *(const u32x4*)(row + 8192 + 2048) : z4, cn); unpack8(nv ? *(const u32x4*)(row + 8192 + 4096) : z4, un);
        float w0[8], w1[8], w2[8], y[8];
        *(f32x4*)(w0) = *(const f32x4*)(cw + c8); *(f32x4*)(w0 + 4) = *(const f32x4*)(cw + c8 + 4);
        *(f32x4*)(w1) = *(const f32x4*)(cw + DI + c8); *(f32x4*)(w1 + 4) = *(const f32x4*)(cw + DI + c8 + 4);
        *(f32x4*)(w2) = *(const f32x4*)(cw + 2 * DI + c8); *(f32x4*)(w2 + 4) = *(const f32x4*)(cw + 2 * DI + c8 + 4);
#pragma unroll
        for (int e = 0; e < 8; ++e) { const float s = w0[e] * (cp[e] * up[e]) + w1[e] * (cc[e] * uu[e]) + w2[e] * (cn[e] * un[e]); y[e] = bb[e] * s * silu_f(zz[e]); }
        *(u32x4*)(Y + (size_t)r * DI + c8) = pack8(y);
    }
}
__device__ __forceinline__ void phase_uc(int j, int wv) {
    const Params P = load_params();
    unsigned char* ws = opq(P.ws);
    const bf16_t* UZO = (const bf16_t*)(ws + WS_BIG); bf16_t* UC = (bf16_t*)(ws + WS_UC);
    const float* cw = opq(P.m_conv_w) + (size_t)j * 3 * DI;
    for (int it = blockIdx.x * 512 + opaque_tid(wv); it < RG * 256; it += gridDim.x * 512) {
        const int r = it >> 8, c8 = (it & 255) * 8; bool pv, nv; conv_valid(r, pv, nv);
        const bf16_t* row = UZO + (size_t)r * 6144 + c8;
        float uu[8], up[8], un[8], y[8];
        const u32x4 z4 = (u32x4){0u, 0u, 0u, 0u};
        unpack8(*(const u32x4*)(row), uu);
        unpack8(pv ? *(const u32x4*)(row - 6144) : z4, up);
        unpack8(nv ? *(const u32x4*)(row + 6144) : z4, un);
        float w0[8], w1[8], w2[8];
        *(f32x4*)(w0) = *(const f32x4*)(cw + c8); *(f32x4*)(w0 + 4) = *(const f32x4*)(cw + c8 + 4);
        *(f32x4*)(w1) = *(const f32x4*)(cw + DI + c8); *(f32x4*)(w1 + 4) = *(const f32x4*)(cw + DI + c8 + 4);
        *(f32x4*)(w2) = *(const f32x4*)(cw + 2 * DI + c8); *(f32x4*)(w2 + 4) = *(const f32x4*)(cw + 2 * DI + c8 + 4);
#pragma unroll
        for (int e = 0; e < 8; ++e) { const float s = w0[e] * up[e] + w1[e] * uu[e] + w2[e] * un[e]; y[e] = silu_f(s); }
        *(u32x4*)(UC + (size_t)r * DI + c8) = pack8(y);
    }
}
__device__ __forceinline__ void phase_gating(int j, int wv) {
    const Params P = load_params();
    const int tid = opaque_tid(wv), lane = tid & 63, gw = blockIdx.x * 8 + (tid >> 6), NGW = gridDim.x * 8;
    unsigned char* ws = opq(P.ws); const float* mng = opq(P.m_norm_g) + (size_t)j * DI; const float* msk = opq(P.m_skip) + (size_t)j * DI;
    const bf16_t* QKV = (const bf16_t*)(ws + WS_QKV); const bf16_t* UZO = (const bf16_t*)(ws + WS_BIG); const bf16_t* UC = (const bf16_t*)(ws + WS_UC);
    bf16_t* Y = (bf16_t*)(ws + WS_KT);
    u32x4 nhf, nhb, nzz, noo, nuc;
#define GATE_LOAD(IT) { const int r_ = (IT) >> 2, c_ = ((IT) & 3) * 512 + 8 * lane; \
        nhf = *(const u32x4*)(QKV + (size_t)r_ * 6144 + 2048 + c_); nhb = *(const u32x4*)(QKV + (size_t)r_ * 6144 + 4096 + c_); \
        nzz = *(const u32x4*)(UZO + (size_t)r_ * 6144 + 2048 + c_); noo = *(const u32x4*)(UZO + (size_t)r_ * 6144 + 4096 + c_); nuc = *(const u32x4*)(UC + (size_t)r_ * DI + c_); }
    if (gw < RG * 4) GATE_LOAD(gw)
    for (int it = gw; it < RG * 4; it += NGW) {
        const int r = it >> 2, h = it & 3, c0 = h * 512 + 8 * lane;
        float hf[8], hb[8], zz[8], oo[8], uc[8], y[8];
        unpack8(nhf, hf); unpack8(nhb, hb); unpack8(nzz, zz); unpack8(noo, oo); unpack8(nuc, uc);
        { const int itn = (it + NGW < RG * 4) ? it + NGW : it; GATE_LOAD(itn) }
        float s = 0.f;
#pragma unroll
        for (int e = 0; e < 8; ++e) { hf[e] += hb[e]; s += hf[e]; }
        const float mean = wave_sum(s, lane) * (1.f / DH); float s2 = 0.f;
#pragma unroll
        for (int e = 0; e < 8; ++e) { hf[e] -= mean; s2 += hf[e] * hf[e]; }
        const float rstd = rsqrtf(wave_sum(s2, lane) * (1.f / DH) + EPSV);
        float ng[8], sk[8];
        *(f32x4*)(ng) = *(const f32x4*)(mng + c0); *(f32x4*)(ng + 4) = *(const f32x4*)(mng + c0 + 4);
        *(f32x4*)(sk) = *(const f32x4*)(msk + c0); *(f32x4*)(sk + 4) = *(const f32x4*)(msk + c0 + 4);
#pragma unroll
        for (int e = 0; e < 8; ++e) y[e] = (sigmoid_f(oo[e]) * (hf[e] * rstd * ng[e]) + sk[e] * uc[e]) * silu_f(zz[e]);
        *(u32x4*)(Y + (size_t)r * DI + c0) = pack8(y);
    }
#undef GATE_LOAD
}
__device__ __forceinline__ void phase_final(int r0, int r1, bool light, int wv) {
    if (light && blockIdx.x < 144) return;
    const Params P = load_params();
    const int tid = opaque_tid(wv), lane = tid & 63, gw = (light ? (int)blockIdx.x - 144 : (int)blockIdx.x) * 8 + (tid >> 6), NGW = (light ? 112 : (int)gridDim.x) * 8;
    float* outp = opq(P.out); const float* fg = opq(P.final_g);
    for (int r = r0 + gw; r < r1; r += NGW) {
        float* xr = outp + (size_t)r * DM;
        f32x4 xv[4]; float ss = 0.f;
#pragma unroll
        for (int q = 0; q < 4; ++q) { xv[q] = *(const f32x4*)(xr + 4 * lane + 256 * q); ss += (xv[q][0] * xv[q][0] + xv[q][1] * xv[q][1]) + (xv[q][2] * xv[q][2] + xv[q][3] * xv[q][3]); }
        const float rstd = rsqrtf(wave_sum(ss, lane) * (1.f / DM) + EPSV);
#pragma unroll
        for (int q = 0; q < 4; ++q) { const f32x4 gv = *(const f32x4*)(fg + 4 * lane + 256 * q); *(f32x4*)(xr + 4 * lane + 256 * q) = xv[q] * rstd * gv; }
    }
}

__device__ __forceinline__ void phase_gatetab(LAS unsigned char* lds, int j, int wv) {
    if (blockIdx.x < 144 || blockIdx.x >= 176) return;
    const Params P = load_params();
    const int tid = opaque_tid(wv), lane = tid & 63, w = __builtin_amdgcn_readfirstlane(tid >> 6);
    unsigned char* ws = P.ws;
    const int sidx = (int)blockIdx.x - 144, dir = sidx & 1, h = (sidx >> 1) & 3, bl = sidx >> 3;
    const float* gt = (const float*)(ws + WS_GATESP) + (size_t)(bl * TT) * 16 + h + (dir ? 8 : 0);
    LAS float* tA = (LAS float*)(lds + 102400); LAS float* tPM = tA + TT; LAS float* tBC = tA + 2 * TT;
    LAS float* cMP = (LAS float*)(lds + 102400 + 3 * TT * 4); LAS float* cM63 = cMP + 36; LAS float* cBL = cMP + 72; LAS float* cAM = cMP + 108;
        {
            const float bi_ = P.m_b_gate[j * 16 + (dir ? 8 : 0) + h], bf_ = P.m_b_gate[j * 16 + (dir ? 8 : 0) + 4 + h];
            for (int cc = w; cc < 36; cc += 8) { const int ac = dir ? (cc < 4 ? 3 - cc : 39 - cc) : cc, t = dir ? 63 - lane : lane, row = ac * 64 + t;
                const float* gp = gt + (size_t)row * 16; float si = bi_, sf = bf_;
#pragma unroll
                for (int ks_ = 0; ks_ < 8; ++ks_) { si += gp[(size_t)ks_ * RG * 16]; sf += gp[(size_t)ks_ * RG * 16 + 4]; }
                const float fp = sf; const float lf = fminf(fp, 0.f) - log1pf(__expf(-fabsf(fp)));
#define DPP_F(oldv, src, ctrl, rmask) __int_as_float(__builtin_amdgcn_update_dpp(__float_as_int(oldv), __float_as_int(src), ctrl, rmask, 0xf, false))
                float bc = lf;
                bc += DPP_F(0.f, bc, 0x111, 0xf); bc += DPP_F(0.f, bc, 0x112, 0xf); bc += DPP_F(0.f, bc, 0x114, 0xf); bc += DPP_F(0.f, bc, 0x118, 0xf);
                bc += DPP_F(0.f, bc, 0x142, 0xa); bc += DPP_F(0.f, bc, 0x143, 0xc);
                const float av = si - bc;
                const float ninf = -__builtin_inff();
                float pmx = av;
                pmx = fmaxf(pmx, DPP_F(ninf, pmx, 0x111, 0xf)); pmx = fmaxf(pmx, DPP_F(ninf, pmx, 0x112, 0xf)); pmx = fmaxf(pmx, DPP_F(ninf, pmx, 0x114, 0xf)); pmx = fmaxf(pmx, DPP_F(ninf, pmx, 0x118, 0xf));
                pmx = fmaxf(pmx, DPP_F(ninf, pmx, 0x142, 0xa)); pmx = fmaxf(pmx, DPP_F(ninf, pmx, 0x143, 0xc));
#undef DPP_F
                tA[row] = av; tPM[row] = pmx; tBC[row] = bc;
                if (lane == 63) { cBL[cc] = bc; cAM[cc] = pmx; } }
            __syncthreads();
            if (tid == 0) { float mp = 0.f; for (int cc = 0; cc < 36; ++cc) { cMP[cc] = mp; const float M63 = fmaxf(mp, cAM[cc]); cM63[cc] = M63; mp = cBL[cc] + M63; } }
            __syncthreads();
        }
    { char* gdst = (char*)(ws + WS_GTAB) + (size_t)sidx * 28224; const LAS f32x4* lsrc = (const LAS f32x4*)tA;
      for (int i = tid; i < 7056 / 4; i += 512) { unsigned off = (unsigned)i * 16u; asm volatile("" : "+v"(off)); *(f32x4*)(gdst + off) = lsrc[i]; } }
    __syncthreads();
}

constexpr int SC_R = 0, SC_V = 81920, SC_VW = 91136, SC_TAB = 100352;
__device__ __forceinline__ bf16x8 mk_frag(unsigned a, unsigned b, unsigned c, unsigned d) { u32x4 t; t.x = a; t.y = b; t.z = c; t.w = d; return __builtin_bit_cast(bf16x8, t); }
__device__ __forceinline__ void phase_scan(LAS unsigned char* lds, int j, int wv) {
    const Params P = load_params();
    const int tid = opaque_tid(wv);
    const int lane = tid & 63, w = __builtin_amdgcn_readfirstlane(tid >> 6), lr = lane & 15, lq = lane >> 4;
    const unsigned qoff = (unsigned)(lr * 6144 + 64 * w + 8 * lq) * 2u;
    const unsigned koff = (unsigned)((64 * w + lr) * TT + 8 * lq) * 2u;
    const unsigned hoff = (unsigned)((4 * lq) * 6144 + lr) * 2u;
    unsigned char* ws = opq(P.ws);
    bf16_t* QKV = (bf16_t*)(ws + WS_QKV); const bf16_t* KT = (const bf16_t*)(ws + WS_KT); const bf16_t* VT = (const bf16_t*)(ws + WS_VT);
    const float* QKR = (const float*)(ws + WS_QKR); const float* GATES = (const float*)(ws + WS_GATESP);
    LAS f32x4* R = (LAS f32x4*)(lds + SC_R);
    LAS bf16_t* sV = (LAS bf16_t*)(lds + SC_V); LAS bf16_t* sVW = (LAS bf16_t*)(lds + SC_VW);
    LAS u32x4* sS = (LAS u32x4*)(lds + 131072);
    LAS float* tA = (LAS float*)(lds + 102400); LAS float* tPM = tA + TT; LAS float* tBC = tA + 2 * TT;
    LAS float* cMP = (LAS float*)(lds + 102400 + 3 * TT * 4); LAS float* cM63 = cMP + 36; LAS float* cBL = cMP + 72; LAS float* cAM = cMP + 108;
    LAS float* tabA = (LAS float*)(lds + SC_TAB); LAS float* tabM = tabA + 64; LAS float* tabWI = tabA + 128; LAS float* tabFL = tabA + 192; LAS float* tabWS = tabA + 256; LAS float* scal = tabA + 320;
    for (int uid = blockIdx.x; uid < GB * NH * 2 * 8; uid += gridDim.x) {
        const int xcd_ = uid & 7, yy_ = uid >> 3, pair_ = xcd_ * 2 + (yy_ >> 4);
        const int es = yy_ & 7, dir = (yy_ >> 3) & 1, h = pair_ & 3, bl = pair_ >> 2;
        const bf16_t* qb = QKV + (size_t)(bl * TT) * 6144 + h * 512;
        const bf16_t* kTb = KT + (size_t)((bl * 4 + h) * 512) * TT;
        const bf16_t* vTb = VT + (size_t)((bl * 4 + h) * 512 + es * 64) * TT;
        const float* qkr = QKR + (size_t)((bl * 4 + h) * TT) * 64;
        const float* gt = GATES + (size_t)(bl * TT) * 16 + h + (dir ? 8 : 0);
        bf16_t* hout = QKV + (size_t)(bl * TT) * 6144 + (dir ? 4096 : 2048) + h * 512 + es * 64;
        f32x4 C[4][5];
#pragma unroll
        for (int a = 0; a < 4; ++a)
#pragma unroll
            for (int b = 0; b < 5; ++b) C[a][b] = (f32x4){0.f, 0.f, 0.f, 0.f};
        { const char* gsrc = (const char*)(ws + WS_GTAB) + (size_t)((bl * 4 + h) * 2 + dir) * 28224; LAS f32x4* ldst = (LAS f32x4*)tA;
          for (int i = tid; i < 7056 / 4; i += 512) { unsigned off = (unsigned)i * 16u; asm volatile("" : "+v"(off)); ldst[i] = *(const f32x4*)(gsrc + off); }
          __syncthreads(); }
        bf16x8 qa0[4], qa1[4];
#define SCAN_LOAD_Q0(T0) { _Pragma("unroll") for (int jt = 0; jt < 4; ++jt) { const char* p_ = (const char*)qb + (size_t)((T0) + 16 * jt) * 12288 + qoff; \
            qa0[jt] = *(const bf16x8*)p_; qa1[jt] = *(const bf16x8*)(p_ + 64); } }
        SCAN_LOAD_Q0(dir ? 3 * 64 : 0)
        for (int cc = 0; cc < 36; ++cc) {
            const int ac = dir ? (cc < 4 ? 3 - cc : 39 - cc) : cc, t0 = ac * 64;
            const int ccn = cc < 35 ? cc + 1 : 35, acn = dir ? (ccn < 4 ? 3 - ccn : 39 - ccn) : ccn, t0n = acn * 64;
            if (w == 7) { const float mpc = cMP[cc], M63c = cM63[cc]; const float av_ = tA[t0 + lane], Mi_ = fmaxf(mpc, tPM[t0 + lane]);
                tabWS[lane] = __expf(av_ - M63c); tabWI[lane] = __expf(mpc - Mi_); tabFL[lane] = __expf(-(tBC[t0 + lane] + Mi_)); }
#define SCAN_PASS(E0, NE) { f32x4 Pt[4][NE]; \
                _Pragma("unroll") for (int ks = 0; ks < 2; ++ks) { \
                  _Pragma("unroll") for (int e = 0; e < NE; ++e) { const f32x4 c0 = C[2 * ks][E0 + e], c1 = C[2 * ks + 1][E0 + e]; \
                    const bf16x8 cb = mk_frag(cvt_pk_bf16(c0[0], c0[1]), cvt_pk_bf16(c0[2], c0[3]), cvt_pk_bf16(c1[0], c1[1]), cvt_pk_bf16(c1[2], c1[3])); \
                    _Pragma("unroll") for (int jt = 0; jt < 4; ++jt) Pt[jt][e] = __builtin_amdgcn_mfma_f32_16x16x32_bf16(ks == 0 ? qa0[jt] : qa1[jt], cb, ks == 0 ? (f32x4){0.f, 0.f, 0.f, 0.f} : Pt[jt][e], 0, 0, 0); } } \
                if (w >= 4) { _Pragma("unroll") for (int jt = 0; jt < 4; ++jt) _Pragma("unroll") for (int e = 0; e < NE; ++e) R[((w - 4) * 20 + jt * 5 + E0 + e) * 64 + lane] = Pt[jt][e]; } \
                __syncthreads(); \
                if (w < 4) { _Pragma("unroll") for (int jt = 0; jt < 4; ++jt) _Pragma("unroll") for (int e = 0; e < NE; ++e) { const int idx = (w * 20 + jt * 5 + E0 + e) * 64 + lane; const f32x4 sres = Pt[jt][e] + R[idx]; R[idx] = sres; } } }
            SCAN_PASS(0, 2)
            if (w >= 4) {
#pragma unroll
                for (int hlf = 0; hlf < 2; ++hlf) { const int it_ = (tid - 256) + 256 * hlf, ve = it_ >> 3, vs = (it_ & 7) * 8;
                    const u32x4 vraw = *(const u32x4*)(vTb + (size_t)ve * TT + t0 + vs);
                    float vf[8], wv[8]; unpack8(vraw, vf);
                    const f32x4 w0 = *(const LAS f32x4*)(tabWS + vs), w1 = *(const LAS f32x4*)(tabWS + vs + 4);
#pragma unroll
                    for (int e = 0; e < 4; ++e) { wv[e] = vf[e] * w0[e]; wv[4 + e] = vf[4 + e] * w1[e]; }
                    *(LAS u32x4*)(sV + ve * 72 + vs) = vraw;
                    *(LAS u32x4*)(sVW + ve * 72 + vs) = pack8(wv); }
            }
            SCAN_PASS(2, 3)
#undef SCAN_PASS
            if (w >= 4) {
                int jr = 16 * (w - 4) + lr; asm volatile("" : "+v"(jr));
                const float Mj = fmaxf(cMP[cc], tPM[t0 + jr]);
#pragma unroll
                for (int ks = 0; ks < 2; ++ks) { const int s0 = 32 * ks + 8 * lq; const float* qp = qkr + (size_t)(t0 + jr) * 64 + s0;
                    const f32x4 q0 = *(const f32x4*)qp, q1 = *(const f32x4*)(qp + 4);
                    const f32x4 a0 = *(const LAS f32x4*)(tA + t0 + s0), a1 = *(const LAS f32x4*)(tA + t0 + s0 + 4);
                    float sv[8];
#pragma unroll
                    for (int e = 0; e < 4; ++e) { const int sA = s0 + e, sB = s0 + 4 + e;
                        const bool vA = dir ? (sA >= jr) : (sA <= jr), vB = dir ? (sB >= jr) : (sB <= jr);
                        sv[e] = vA ? q0[e] * __expf(a0[e] - Mj) : 0.f; sv[4 + e] = vB ? q1[e] * __expf(a1[e] - Mj) : 0.f; }
                    sS[((w - 4) * 2 + ks) * 64 + lane] = pack8(sv); }
            }
            bf16x8 ka[4][2];
#pragma unroll
            for (int dt = 0; dt < 4; ++dt)
#pragma unroll
                for (int ks = 0; ks < 2; ++ks) ka[dt][ks] = *(const bf16x8*)((const char*)kTb + (size_t)(16 * dt * TT + t0 + 32 * ks) * 2 + koff);
            const int jt_f = w >> 1, eh = w & 1;
            __syncthreads();
            {
                const int jt = jt_f;
                bf16x8 sa[2];
#pragma unroll
                for (int ks = 0; ks < 2; ++ks) { const u32x4 pk = sS[(jt * 2 + ks) * 64 + lane]; sa[ks] = __builtin_bit_cast(bf16x8, pk); }
                const unsigned one2 = (lr == 0) ? 0x3F803F80u : 0u;
                const bf16x8 ones = mk_frag(one2, one2, one2, one2);
                const f32x4 wi = *(const LAS f32x4*)(tabWI + 16 * jt + 4 * lq), fl = *(const LAS f32x4*)(tabFL + 16 * jt + 4 * lq);
                f32x4 num[3];
#pragma unroll
                for (int x = 0; x < 3; ++x) { const int et = (x < 2) ? 2 * eh + x : 4, tile = jt * 5 + et;
                    const f32x4 inter = (R[(0 * 20 + tile) * 64 + lane] + R[(1 * 20 + tile) * 64 + lane]) + (R[(2 * 20 + tile) * 64 + lane] + R[(3 * 20 + tile) * 64 + lane]);
                    f32x4 it = (f32x4){0.f, 0.f, 0.f, 0.f};
#pragma unroll
                    for (int ks = 0; ks < 2; ++ks) { const bf16x8 vb = (x < 2) ? *(const LAS bf16x8*)(sV + (16 * et + lr) * 72 + 32 * ks + 8 * lq) : ones;
                        it = __builtin_amdgcn_mfma_f32_16x16x32_bf16(sa[ks], vb, it, 0, 0, 0); }
                    num[x] = wi * inter + it; }
                f32x4 den;
#pragma unroll
                for (int i = 0; i < 4; ++i) den[i] = fmaxf(fabsf(lane_read(num[2][i], lane & 48)), fl[i]);
#pragma unroll
                for (int x = 0; x < 2; ++x) { const int et = 2 * eh + x;
#pragma unroll
                    for (int i = 0; i < 4; ++i) { const float hv = num[x][i] * __builtin_amdgcn_rcpf(den[i]);
                        *(bf16_t*)((char*)hout + ((size_t)(t0 + 16 * jt + i) * 6144 + 16 * et) * 2 + hoff) = (bf16_t)(cvt_pk_bf16(hv, 0.f) & 0xffffu); } }
            }
            SCAN_LOAD_Q0(t0n)
            {
                const float wd = __expf(cMP[cc] - cM63[cc]);
#pragma unroll
                for (int dt = 0; dt < 4; ++dt)
#pragma unroll
                    for (int et = 0; et < 5; ++et) C[dt][et] = C[dt][et] * wd;
#pragma unroll
                for (int ks = 0; ks < 2; ++ks) {
#pragma unroll
                    for (int et = 0; et < 4; ++et) { const bf16x8 vwb = *(const LAS bf16x8*)(sVW + (16 * et + lr) * 72 + 32 * ks + 8 * lq);
#pragma unroll
                        for (int dt = 0; dt < 4; ++dt) C[dt][et] = __builtin_amdgcn_mfma_f32_16x16x32_bf16(ka[dt][ks], vwb, C[dt][et], 0, 0, 0); }
                    const f32x4 w0 = *(const LAS f32x4*)(tabWS + 32 * ks + 8 * lq), w1 = *(const LAS f32x4*)(tabWS + 32 * ks + 8 * lq + 4);
                    u32x4 wp; wp.x = cvt_pk_bf16(w0[0], w0[1]); wp.y = cvt_pk_bf16(w0[2], w0[3]); wp.z = cvt_pk_bf16(w1[0], w1[1]); wp.w = cvt_pk_bf16(w1[2], w1[3]);
                    if (lr != 0) { wp.x = 0u; wp.y = 0u; wp.z = 0u; wp.w = 0u; }
                    const bf16x8 wb = __builtin_bit_cast(bf16x8, wp);
#pragma unroll
                    for (int dt = 0; dt < 4; ++dt) C[dt][4] = __builtin_amdgcn_mfma_f32_16x16x32_bf16(ka[dt][ks], wb, C[dt][4], 0, 0, 0);
                }
            }
            __syncthreads();
        }
    }
}

__device__ __forceinline__ void run_in_gemm(LAS unsigned char* lds, int j, bool conv, int coff, int g, int buf, int wv) {
    const Params P = load_params(); unsigned char* ws = P.ws;
    if (conv) {
        PhConvFused ph; ph.K = DM; ph.lda = DM; ph.ldb = DM; ph.nM = MT; ph.nN = 32; ph.coff = coff; ph.A = (const bf16_t*)(ws + (buf ? WS_HX2 : WS_HX)); ph.B = (const bf16_t*)(ws + WS_CWIN) + (size_t)j * 8192 * DM;
        ph.BIG = (bf16_t*)(ws + WS_BIG); ph.Y = (bf16_t*)(ws + ((g & 1) ? WS_KT : WS_VT)); ph.cw = P.conv_w + (size_t)j * 3 * DI;
        gemm_phase(lds, ph, wv);
    } else {
        PhPlain ph; ph.K = DM; ph.lda = DM; ph.ldb = DM; ph.nM = MT; ph.coff = coff; ph.A = (const bf16_t*)(ws + (buf ? WS_HX2 : WS_HX)); ph.O = (bf16_t*)(ws + WS_BIG);
        ph.nN = 24; ph.B = (const bf16_t*)(ws + WS_MWIN) + (size_t)j * 6144 * DM; ph.ldc = 6144;
        gemm_phase(lds, ph, wv);
    }
}
__device__ __forceinline__ void run_out_gemm(LAS unsigned char* lds, int layer, int g, int wv) {
    const Params P = load_params(); unsigned char* ws = P.ws; const int j = layer >> 1;
    PhResid ph; ph.K = DI; ph.lda = DI; ph.ldb = DI; ph.nM = MT; ph.nN = 4; ph.coff = 0; ph.A = (const bf16_t*)(ws + (((layer & 1) || (g & 1)) ? WS_KT : WS_VT));
    ph.B = ((layer & 1) ? (const bf16_t*)(ws + WS_MWOUT) : (const bf16_t*)(ws + WS_CWOUT)) + (size_t)j * DM * DI;
    ph.xin_x = (layer == 0) ? P.x : P.out; ph.xin_c = (layer == 0) ? P.ctx : (const float*)(ws + WS_XC); ph.xout_x = P.out; ph.xout_c = (float*)(ws + WS_XC);
    ph.mod = (const float*)(ws + WS_MOD) + (size_t)layer * 17 * 3072; ph.g = g;
    gemm_phase(lds, ph, wv);
}
__device__ __forceinline__ void run_qkv_nat(LAS unsigned char* lds, int j, bool isv, int wv) {
    const Params P = load_params(); unsigned char* ws = P.ws;
    PhQKV ph; ph.K = DH; ph.ldb = DH; ph.nM = MT; ph.W = (const bf16_t*)(ws + WS_MWQKV) + (size_t)j * 3 * 4 * DH * DH; ph.O = (bf16_t*)(ws + WS_QKV);
    if (!isv) { ph.lda = DI; ph.nN = 16; ph.coff = 0; ph.A = (const bf16_t*)(ws + WS_UC); ph.which0 = 0; }
    else { ph.lda = 6144; ph.nN = 8; ph.coff = 256 - 64; ph.A = (const bf16_t*)(ws + WS_BIG); ph.which0 = 2; }
    gemm_phase(lds, ph, wv);
}
__device__ __forceinline__ void run_tr(LAS unsigned char* lds, int j, bool isv, int wv) {
    const Params P = load_params(); unsigned char* ws = P.ws;
    PhTr ph; ph.K = DH; ph.lda = DH; ph.nM = 8; ph.nN = MT;
    const bf16_t* WQKV = (const bf16_t*)(ws + WS_MWQKV) + (size_t)j * 3 * 4 * DH * DH;
    if (!isv) { ph.ldb = DI; ph.coff = 192; ph.W = WQKV + (size_t)1 * 4 * DH * DH; ph.Act = (const bf16_t*)(ws + WS_UC); ph.OT = (bf16_t*)(ws + WS_KT); ph.scale = 0.044194173824159216f; }
    else { ph.ldb = 6144; ph.coff = 160; ph.W = WQKV + (size_t)2 * 4 * DH * DH; ph.Act = (const bf16_t*)(ws + WS_BIG); ph.OT = (bf16_t*)(ws + WS_VT); ph.scale = 1.f; }
    gemm_phase(lds, ph, wv);
}
__device__ __forceinline__ void run_qk(LAS unsigned char* lds, int wv) {
    const Params P = load_params(); unsigned char* ws = P.ws;
    PhQK ph; ph.K = DH; ph.lda = 6144; ph.ldb = 6144; ph.nM = GB * NH * 9; ph.nN = 1; ph.coff = 0; ph.QKV = (const bf16_t*)(ws + WS_QKV); ph.QKR = (float*)(ws + WS_QKR);
    gemm_phase(lds, ph, wv);
}
__device__ __forceinline__ void run_gates(LAS unsigned char* lds, int j, int part, int wv) {
    const Params P = load_params(); unsigned char* ws = P.ws;
    PhGates ph; ph.K = 512; ph.ldb = 2048; ph.nM = MT; ph.nN = 4; ph.poff = 4 * part;
    if (part == 0) { ph.A = (const bf16_t*)(ws + WS_UC); ph.lda = DI; ph.coff = 128; } else { ph.A = (const bf16_t*)(ws + WS_BIG); ph.lda = 6144; ph.coff = 144; }
    ph.WG = (const bf16_t*)(ws + WS_MWG) + (size_t)(j * 2 + part) * 256 * 2048; ph.GATESP = (float*)(ws + WS_GATESP);
    gemm_phase(lds, ph, wv);
}

#define XB_TMO      128
#define XB_XCNT(j)  (256  + 64 * (j))
#define XB_XSUB(j)  (1280 + 64 * (j))
#define XB_XGEN(j)  (2304 + 64 * (j))
#define XB_TOP      3328
#define XB_TOPGEN   3392
#define XCD_BAR_WORDS 3456
#define XB_SPIN_CAP (1u << 22)
__device__ __forceinline__ unsigned xb_ld(unsigned* p)              { return __hip_atomic_load(p, __ATOMIC_RELAXED, __HIP_MEMORY_SCOPE_AGENT); }
__device__ __forceinline__ unsigned xb_add(unsigned* p, unsigned v) { return __hip_atomic_fetch_add(p, v, __ATOMIC_RELAXED, __HIP_MEMORY_SCOPE_AGENT); }
__device__ __forceinline__ unsigned xb_xcc_id() { return (unsigned)__builtin_amdgcn_s_getreg((3 << 11) | 20) & 0xFu; }
#define XB_SPIN(cond, bar) do { unsigned _sp = 0; while (cond) { __builtin_amdgcn_s_sleep(1); \
    if ((++_sp & 255u) == 0u) { if (xb_ld(&(bar)[XB_TMO])) break; if (_sp > XB_SPIN_CAP) { atomicAdd(&(bar)[XB_TMO], 1u); break; } } } } while (0)
struct XcdBarrier { unsigned* bar; unsigned x; volatile LAS unsigned* st; };
__device__ __forceinline__ XcdBarrier xcd_barrier_post(unsigned* bar, volatile LAS unsigned* st) {
    XcdBarrier b; b.bar = bar; b.x = xb_xcc_id(); b.st = st;
    if (threadIdx.x == 0) (void)xb_add(&bar[XB_XCNT(b.x)], 1u);
    return b;
}
__device__ __forceinline__ void xcd_barrier_complete(unsigned* bar, unsigned x, unsigned& nloc, unsigned& nx) {
    const unsigned G = gridDim.x * gridDim.y * gridDim.z;
    unsigned sum, cnt, mine, sp = 0u;
    for (;;) {
        sum = 0u; cnt = 0u; mine = 0u;
#pragma unroll
        for (unsigned j = 0; j < 16; ++j) { const unsigned c = xb_ld(&bar[XB_XCNT(j)]); sum += c; cnt += (c > 0u) ? 1u : 0u; mine = (j == x) ? c : mine; }
        if (sum == G) break;
        __builtin_amdgcn_s_sleep(1);
        if ((++sp & 255u) == 0u) { if (xb_ld(&bar[XB_TMO])) break; if (sp > XB_SPIN_CAP) { atomicAdd(&bar[XB_TMO], 1u); break; } }
    }
    nloc = mine > 0u ? mine : 1u; nx = cnt > 0u ? cnt : 1u;
}
__device__ __forceinline__ void xcd_barrier(const XcdBarrier& b, int wv) {
    asm volatile("s_waitcnt vmcnt(0)" ::: "memory");
    __syncthreads();
    if (opaque_tid(wv) == 0) {
        unsigned* bar = b.bar;
        __builtin_amdgcn_s_waitcnt(0);
        unsigned nloc = b.st[0], nx = b.st[1];
        if (nloc == 0u) { xcd_barrier_complete(bar, b.x, nloc, nx); b.st[0] = nloc; b.st[1] = nx; }
        const unsigned old = xb_add(&bar[XB_XSUB(b.x)], 1u);
        const unsigned gen = old / nloc;
        if (old + 1u == (gen + 1u) * nloc) {
            __builtin_amdgcn_fence(__ATOMIC_RELEASE, "agent");
            asm volatile("s_waitcnt vmcnt(0)" ::: "memory");
            const unsigned og = xb_add(&bar[XB_TOP], 1u);
            const unsigned tg = og / nx;
            if (og + 1u == (tg + 1u) * nx) xb_add(&bar[XB_TOPGEN], 1u);
            else XB_SPIN(xb_ld(&bar[XB_TOPGEN]) == tg, bar);
            __builtin_amdgcn_fence(__ATOMIC_ACQUIRE, "agent");
            xb_add(&bar[XB_XGEN(b.x)], 1u);
            asm volatile("s_waitcnt vmcnt(0)" ::: "memory");
        } else {
            XB_SPIN(xb_ld(&bar[XB_XGEN(b.x)]) == gen, bar);
            __builtin_amdgcn_fence(__ATOMIC_ACQUIRE, "agent");
            asm volatile("s_waitcnt vmcnt(0)" ::: "memory");
        }
    }
    __syncthreads();
}

__global__ void __launch_bounds__(512, 2) hybrid_fwd(Params Punused) {
    extern __shared__ __attribute__((aligned(16))) unsigned char lds_raw[];
    LAS unsigned char* lds = (LAS unsigned char*)lds_raw;
    cg::grid_group grid = cg::this_grid();
    const int wv = __builtin_amdgcn_readfirstlane((int)(threadIdx.x >> 6));
    volatile LAS unsigned* bst = (volatile LAS unsigned*)(lds + LDS_BST);
    if (threadIdx.x < 4) bst[threadIdx.x] = 0u;
    __syncthreads();
    { const Params P0 = load_params(); (void)xcd_barrier_post((unsigned*)(P0.ws + WS_BAR), bst); }
#define GSYNC() do { const Params Pb = load_params(); XcdBarrier xb_; xb_.bar = (unsigned*)(Pb.ws + WS_BAR); xb_.x = xb_xcc_id(); xb_.st = (volatile LAS unsigned*)(lds + LDS_BST); xcd_barrier(xb_, wv); } while (0)
    phase_prep(lds, wv);
    grid.sync();
    phase_modreduce(wv);
    GSYNC();
    phase_modulate(0, 0, 0, false, wv);
    GSYNC();
    run_in_gemm(lds, 0, true, 0, 0, 0, wv);
    phase_modulate(0, 1, 1, true, wv);
    GSYNC();
    for (int st = 0; st < 16; ++st) {
        const int layer = st >> 2, g = st & 3, j = st >> 3, nst = st + 1;
        if ((layer & 1) == 0) {
            phase_convmix(j, g, wv);
            GSYNC();
        } else {
            phase_uc(j, wv);
            GSYNC();
            run_qkv_nat(lds, j, false, wv); run_tr(lds, j, false, wv); run_tr(lds, j, true, wv); run_gates(lds, j, 0, wv); run_gates(lds, j, 1, wv);
            GSYNC();
            run_qk(lds, wv); phase_gatetab(lds, j, wv);
            GSYNC();
            phase_scan(lds, j, wv);
            GSYNC();
            phase_gating(j, wv);
            GSYNC();
        }
        run_out_gemm(lds, layer, g, wv);
        if (nst < 16) run_in_gemm(lds, nst >> 3, ((nst >> 2) & 1) == 0, 256 - 144, nst & 3, nst & 1, wv);
        if (st == 15) phase_final(0, 3 * GB * SEQ, true, wv);
        if (st + 2 < 16) phase_modulate((st + 2) >> 2, (st + 2) & 3, st & 1, true, wv);
        GSYNC();
    }
    phase_final(3 * GB * SEQ, NB * SEQ, false, wv);
}

extern "C" void kernel_launch(void* const* d_in, const int* in_sizes, int n_in, void* d_out, int out_size, void* d_ws, size_t ws_size, hipStream_t stream) {
    static int grid_blocks = 0;
    if (grid_blocks == 0) {
        if (n_in != 21 || out_size != NB * SEQ * DM || ws_size < WS_END) { fprintf(stderr, "kernel_launch: unexpected shapes (n_in %d out %d ws %zu)\n", n_in, out_size, ws_size); grid_blocks = -1; return; }
        int dev = 0, cus = 0, per_cu = 0;
        if (hipGetDevice(&dev) != hipSuccess || hipDeviceGetAttribute(&cus, hipDeviceAttributeMultiprocessorCount, dev) != hipSuccess) { grid_blocks = -1; return; }
        if (hipFuncSetAttribute((const void*)hybrid_fwd, hipFuncAttributeMaxDynamicSharedMemorySize, LDS_BYTES) != hipSuccess) { fprintf(stderr, "kernel_launch: hipFuncSetAttribute failed\n"); grid_blocks = -1; return; }
        if (hipOccupancyMaxActiveBlocksPerMultiprocessor(&per_cu, (const void*)hybrid_fwd, 512, LDS_BYTES) != hipSuccess || per_cu < 1) { fprintf(stderr, "kernel_launch: occupancy query says %d\n", per_cu); per_cu = 1; }
        (void)hipGetLastError();
        grid_blocks = cus;
    }
    if (grid_blocks < 0) return;
    if (hipMemsetAsync((char*)d_ws + WS_BAR, 0, XCD_BAR_WORDS * sizeof(unsigned), stream) != hipSuccess) { fprintf(stderr, "kernel_launch: memset of the barrier words failed\n"); return; }
    Params p{};
    const float** pp = (const float**)&p;
    for (int i = 0; i < 21; ++i) pp[i] = (const float*)d_in[i];
    p.out = (float*)d_out; p.ws = (unsigned char*)d_ws;
    void* args[] = {&p};
    hipError_t e = hipLaunchCooperativeKernel((const void*)hybrid_fwd, dim3(grid_blocks), dim3(512), args, LDS_BYTES, stream);
    if (e != hipSuccess) fprintf(stderr, "cooperative launch failed: %s (grid %d)\n", hipGetErrorString(e), grid_blocks);
}
```

```cpp
#include <hip/hip_runtime.h>
#include <hip/hip_cooperative_groups.h>
#include <cstdio>
namespace cg = cooperative_groups;

#define LAS __attribute__((address_space(3)))
typedef unsigned short bf16_t;
typedef short bf16x8 __attribute__((ext_vector_type(8)));
typedef float f32x4 __attribute__((ext_vector_type(4)));
typedef unsigned u32x4 __attribute__((ext_vector_type(4)));
typedef unsigned u32x2 __attribute__((ext_vector_type(2)));

constexpr int DM = 1024, DI = 2048, NB = 16, SEQ = 2048, CTXL = 256, TT = 2304  , NH = 4, DH = 512;
constexpr int GB = 4  , RG = GB * TT  , MT = RG / 256  ;
constexpr float EPSV = 1e-6f;
constexpr size_t MIB = 1ull << 20;
constexpr size_t WS_CWIN = 0, WS_CWOUT = 32 * MIB, WS_MWIN = 40 * MIB, WS_MWQKV = 64 * MIB, WS_MWOUT = 76 * MIB, WS_MWG = 84 * MIB,
                 WS_MODP = 90 * MIB, WS_MOD = 97 * MIB, WS_XC = 98 * MIB, WS_HX = 114 * MIB, WS_BIG = 132 * MIB, WS_UC = WS_BIG + 108 * MIB,
                 WS_QKV = 276 * MIB, WS_KT = 384 * MIB, WS_VT = 420 * MIB, WS_QKR = 456 * MIB, WS_GATES = 465 * MIB, WS_BAR = 466 * MIB, WS_GATESP = 468 * MIB  , WS_HX2 = 474 * MIB  , WS_GTAB = 492 * MIB  , WS_END = 493 * MIB;
constexpr int LDS_BST = 148480;
constexpr int LDS_BYTES = LDS_BST + 16;

struct Params {
    const float *x, *c, *ctx, *c_ctx, *norm_g, *mod_w, *mod_b, *conv_w_in, *conv_w, *conv_w_out, *m_w_in, *m_conv_w, *m_wq, *m_wk, *m_wv,
        *m_w_gate, *m_b_gate, *m_norm_g, *m_skip, *m_w_out, *final_g;
    float* out; unsigned char* ws;
};

__device__ __forceinline__ unsigned cvt_pk_bf16(float lo, float hi) { unsigned r; asm volatile("v_cvt_pk_bf16_f32 %0, %1, %2" : "=v"(r) : "v"(lo), "v"(hi)); return r; }
__device__ __forceinline__ float bf_lo(unsigned w) { return __uint_as_float(w << 16); }
__device__ __forceinline__ float bf_hi(unsigned w) { return __uint_as_float(w & 0xffff0000u); }
__device__ __forceinline__ void unpack8(u32x4 v, float* f) { f[0] = bf_lo(v.x); f[1] = bf_hi(v.x); f[2] = bf_lo(v.y); f[3] = bf_hi(v.y); f[4] = bf_lo(v.z); f[5] = bf_hi(v.z); f[6] = bf_lo(v.w); f[7] = bf_hi(v.w); }
__device__ __forceinline__ u32x4 pack8(const float* f) { u32x4 o; o.x = cvt_pk_bf16(f[0], f[1]); o.y = cvt_pk_bf16(f[2], f[3]); o.z = cvt_pk_bf16(f[4], f[5]); o.w = cvt_pk_bf16(f[6], f[7]); return o; }
__device__ __forceinline__ float silu_f(float v) { return v * __builtin_amdgcn_rcpf(1.f + __expf(-v)); }
__device__ __forceinline__ float sigmoid_f(float v) { return __builtin_amdgcn_rcpf(1.f + __expf(-v)); }
__device__ __forceinline__ float lane_read(float v, int srclane) { return __int_as_float(__builtin_amdgcn_ds_bpermute(srclane << 2, __float_as_int(v))); }
__device__ __forceinline__ float wave_sum(float v, int lane) {
    (void)lane;
#define DPPS(x, ctrl, rmask) __int_as_float(__builtin_amdgcn_update_dpp(0, __float_as_int(x), ctrl, rmask, 0xf, false))
    v += DPPS(v, 0x111, 0xf); v += DPPS(v, 0x112, 0xf); v += DPPS(v, 0x114, 0xf); v += DPPS(v, 0x118, 0xf);
    v += DPPS(v, 0x142, 0xa); v += DPPS(v, 0x143, 0xc);
#undef DPPS
    return __int_as_float(__builtin_amdgcn_readlane(__float_as_int(v), 63));
}
#define LDS_WAIT() asm volatile("s_waitcnt lgkmcnt(0)" ::: "memory")
template <class T> __device__ __forceinline__ T* opq(T* p) { return p; }
#define CAS __attribute__((address_space(4)))
#define GAS __attribute__((address_space(1)))
__device__ __forceinline__ Params load_params() {
    int z = 0; asm volatile("" : "+s"(z));
    const CAS unsigned long long* kp = (const CAS unsigned long long*)((const CAS char*)__builtin_amdgcn_kernarg_segment_ptr() + z);
    Params r;
#define LP_F(i, name) r.name = (const float*)(const GAS float*)kp[i];
    LP_F(0, x) LP_F(1, c) LP_F(2, ctx) LP_F(3, c_ctx) LP_F(4, norm_g) LP_F(5, mod_w) LP_F(6, mod_b) LP_F(7, conv_w_in) LP_F(8, conv_w) LP_F(9, conv_w_out) LP_F(10, m_w_in)
    LP_F(11, m_conv_w) LP_F(12, m_wq) LP_F(13, m_wk) LP_F(14, m_wv) LP_F(15, m_w_gate) LP_F(16, m_b_gate) LP_F(17, m_norm_g) LP_F(18, m_skip) LP_F(19, m_w_out) LP_F(20, final_g)
#undef LP_F
    r.out = (float*)(GAS float*)kp[21]; r.ws = (unsigned char*)(GAS unsigned char*)kp[22];
    return r;
}
__device__ __forceinline__ int opaque_tid(int wv) {
    int ln; asm volatile("v_mbcnt_lo_u32_b32 %0, -1, 0\n\tv_mbcnt_hi_u32_b32 %0, -1, %0" : "=&v"(ln)); return wv * 64 + ln; }

constexpr int BM = 256, BK = 64, HALF = 128, HTB = HALF * BK * 2, NXCD = 8, WGM = 8;
__device__ __forceinline__ int lds_byte(int r, int c) { const int st = (r >> 4) * 2 + (c >> 5), rr = r & 15, cc = c & 31, ob = rr * 64 + cc * 2; return st * 1024 + (ob ^ (((ob >> 9) & 1) << 5)); }
__device__ __forceinline__ void stage_rc(int b, int& R, int& C) { const int st = b / 1024, sb = b % 1024, swz = sb ^ (((sb >> 9) & 1) << 5); R = (st >> 1) * 16 + swz / 64; C = (st & 1) * 32 + (swz % 64) / 2; }
__device__ __forceinline__ int perm32(int rho) { const int n = rho >> 4, i = rho & 15; return 8 * (i >> 2) + 4 * n + (i & 3); }
__device__ __forceinline__ int qperm32(int p) { const int q = p >> 3, jj = p & 7; return jj < 4 ? 4 * q + jj : 16 + 4 * q + (jj - 4); }
struct Unit { int pm, pn; };
__device__ __forceinline__ bool tile_next(int i, int G, int c, int nM, int nN, Unit& u, int tailc = 0) {
    const int nwg = nM * nN; long L = (long)i * G + c;
    if (tailc > 0) { const int fr_ = nwg / G, full = fr_ * G, rem = nwg - full;
        if (i >= fr_) { const int k = i - fr_; if (k == 0) { if (c >= tailc) return false; L = full + c; } else if (k == 1) { if (c >= rem - tailc) return false; L = full + tailc + c; } else return false; } }
    if (L >= nwg) return false;
    int wgid = (int)L; { const int q = nwg / NXCD, r = nwg % NXCD, xcd = wgid % NXCD, off = wgid / NXCD; wgid = (xcd < r ? xcd * (q + 1) : r * (q + 1) + (xcd - r) * q) + off; }
    const int nig = WGM * nN, gid = wgid / nig, fm = gid * WGM, gsz = (nM - fm) < WGM ? (nM - fm) : WGM;
    u.pm = fm + ((wgid % nig) % gsz); u.pn = (wgid % nig) / gsz; return true;
}

__device__ __forceinline__ void store_bf16_tile(const f32x4 (&acc)[2][2][4][2], bf16_t* base, size_t ldc, float scale, int wr, int wc, int fr, int fq) {
    bf16_t* p0 = base + (size_t)(wr * 64 + fr) * ldc + wc * 32 + 8 * fq;
#pragma unroll
    for (int ai = 0; ai < 2; ++ai)
#pragma unroll
        for (int m = 0; m < 4; ++m) { bf16_t* rowp = p0 + (size_t)(ai * HALF + m * 16) * ldc;
#pragma unroll
            for (int bj = 0; bj < 2; ++bj) { const f32x4 v0 = acc[ai][bj][m][0] * scale, v1 = acc[ai][bj][m][1] * scale;
                u32x4 w; w.x = cvt_pk_bf16(v0[0], v0[1]); w.y = cvt_pk_bf16(v0[2], v0[3]); w.z = cvt_pk_bf16(v1[0], v1[1]); w.w = cvt_pk_bf16(v1[2], v1[3]);
                *(u32x4*)(rowp + bj * HALF) = w; } }
}

template <class PH>
__device__ __forceinline__ void gemm_phase(LAS unsigned char* lds, const PH& S, int wv) {
    const int tid = opaque_tid(wv);
    const int wid = __builtin_amdgcn_readfirstlane(tid >> 6), lane = tid & 63, wr = wid >> 2, wc = wid & 3, fr = lane & 15, fq = lane >> 4;
    const int K = S.K, nt = K / BK;
    const int G = gridDim.x, cblk = (int)((blockIdx.x + (unsigned)S.coff) % gridDim.x);
    unsigned voffA[2], voffB[2];
#pragma unroll
    for (int i = 0; i < 2; ++i) { int R, C; stage_rc(tid * 16 + i * 8192, R, C); const int Rb = PH::PERM ? ((R & ~31) + perm32(R & 31)) : R;
        const int Rs = PH::QPERM ? ((Rb & ~31) + qperm32(Rb & 31)) : Rb;
        voffA[i] = (unsigned)(R * S.lda + C) * 2u; voffB[i] = (unsigned)(Rs * S.ldb + C) * 2u; }
    const size_t kstep = (size_t)(BK * 2);
    const size_t hstepA = (size_t)HALF * S.lda * 2, hstepB = (size_t)HALF * S.ldb * 2;
    const unsigned ldsw = (unsigned)wid * 1024u;
    const int aoff = lds_byte(wr * 64 + fr, fq * 8), boff = lds_byte(wc * 32 + fr, fq * 8);
#define PG8_SA(b, h) (((b) * 2 + (h)) * HTB)
#define PG8_SB(b, h) ((4 + (b) * 2 + (h)) * HTB)
#define PG8_STAGE(bufoff, gbase, voff) do { _Pragma("unroll") for (int _i = 0; _i < 2; ++_i) \
        __builtin_amdgcn_global_load_lds((const unsigned*)((const char*)(gbase) + (voff)[_i]), (LAS unsigned*)(lds + (bufoff) + ldsw + _i * 8192), 16, 0, 0); } while (0)
#define PG8_LDA(dst, b, h) do { _Pragma("unroll") for (int m = 0; m < 4; ++m) _Pragma("unroll") for (int k = 0; k < 2; ++k) dst[m][k] = *(const LAS bf16x8*)(lds + PG8_SA(b, h) + aoff + m * 2048 + k * 1024); } while (0)
#define PG8_LDB(dst, b, h) do { _Pragma("unroll") for (int n = 0; n < 2; ++n) _Pragma("unroll") for (int k = 0; k < 2; ++k) dst[n][k] = *(const LAS bf16x8*)(lds + PG8_SB(b, h) + boff + n * 2048 + k * 1024); } while (0)
#define PG8_MMA(ai, bj, At, Bt) do { __builtin_amdgcn_s_setprio(1); _Pragma("unroll") for (int m = 0; m < 4; ++m) _Pragma("unroll") for (int n = 0; n < 2; ++n) _Pragma("unroll") for (int k = 0; k < 2; ++k) \
        acc[ai][bj][m][n] = __builtin_amdgcn_mfma_f32_16x16x32_bf16(Bt[n][k], At[m][k], acc[ai][bj][m][n], 0, 0, 0); __builtin_amdgcn_s_setprio(0); } while (0)
#define PG8_WAIT_V(n) asm volatile("s_waitcnt vmcnt(" #n ")" ::: "memory")
#define PG8_WAIT_L(n) asm volatile("s_waitcnt lgkmcnt(" #n ")" ::: "memory")
#define PG8_BAR __builtin_amdgcn_s_barrier()
#define PG8_SCHED __builtin_amdgcn_sched_barrier(0)
    Unit cur, nxt; int ui = 0;
    if (!tile_next(0, G, cblk, S.nM, S.nN, cur, S.coff != 0 ? PH::TAILC : 0)) return;
    f32x4 acc[2][2][4][2];
#pragma unroll
    for (int a = 0; a < 2; ++a)
#pragma unroll
        for (int b = 0; b < 2; ++b)
#pragma unroll
            for (int m = 0; m < 4; ++m)
#pragma unroll
                for (int n = 0; n < 2; ++n) acc[a][b][m][n] = (f32x4){0.f, 0.f, 0.f, 0.f};
    bf16x8 At[4][2], B0[2][2], B1[2][2];
    const char* cA = S.aptr(cur); const char* cB = S.bptr(cur);
    PG8_STAGE(PG8_SB(0, 0), cB, voffB); PG8_STAGE(PG8_SA(0, 0), cA, voffA); PG8_STAGE(PG8_SB(0, 1), cB + hstepB, voffB); PG8_STAGE(PG8_SA(0, 1), cA + hstepA, voffA);
    if (wr == 1) PG8_BAR;
    PG8_WAIT_V(4); PG8_BAR;
    PG8_STAGE(PG8_SB(1, 0), cB + kstep, voffB); PG8_STAGE(PG8_SA(1, 0), cA + kstep, voffA); PG8_STAGE(PG8_SB(1, 1), cB + hstepB + kstep, voffB);
    PG8_WAIT_V(6); PG8_BAR;
    for (;;) {
        const bool has_next = tile_next(ui + 1, G, cblk, S.nM, S.nN, nxt, S.coff != 0 ? PH::TAILC : 0);
        const char* nA = has_next ? S.aptr(nxt) : cA; const char* nB = has_next ? S.bptr(nxt) : cB;
        for (int t = 0; t < nt; t += 2) {
            const bool last = (t == nt - 2);
            const char* a1 = cA + (size_t)(t + 1) * kstep;
            const char* a2 = last ? nA : cA + (size_t)(t + 2) * kstep; const char* b2 = last ? nB : cB + (size_t)(t + 2) * kstep;
            const char* a3 = a2 + kstep; const char* b3 = b2 + kstep;
            PG8_LDB(B0, 0, 0); PG8_SCHED; PG8_LDA(At, 0, 0); PG8_STAGE(PG8_SA(1, 1), a1 + hstepA, voffA);
            PG8_WAIT_L(8); PG8_BAR; PG8_WAIT_L(0); PG8_MMA(0, 0, At, B0); PG8_BAR; PG8_SCHED;
            PG8_LDB(B1, 0, 1); PG8_STAGE(PG8_SB(0, 0), b2, voffB);
            PG8_BAR; PG8_WAIT_L(0); PG8_MMA(0, 1, At, B1); PG8_BAR;
            PG8_LDA(At, 0, 1); PG8_STAGE(PG8_SA(0, 0), a2, voffA);
            PG8_BAR; PG8_WAIT_L(0); PG8_MMA(1, 0, At, B0); PG8_BAR; PG8_SCHED;
            PG8_STAGE(PG8_SB(0, 1), b2 + hstepB, voffB);
            PG8_WAIT_V(6); PG8_BAR; PG8_MMA(1, 1, At, B1); PG8_BAR;
            PG8_LDB(B0, 1, 0); PG8_SCHED; PG8_LDA(At, 1, 0); PG8_STAGE(PG8_SA(0, 1), a2 + hstepA, voffA);
            PG8_WAIT_L(8); PG8_BAR; PG8_WAIT_L(0); PG8_MMA(0, 0, At, B0); PG8_BAR; PG8_SCHED;
            PG8_LDB(B1, 1, 1); PG8_STAGE(PG8_SB(1, 0), b3, voffB);
            PG8_BAR; PG8_WAIT_L(0); PG8_MMA(0, 1, At, B1); PG8_BAR;
            PG8_LDA(At, 1, 1); PG8_STAGE(PG8_SA(1, 0), a3, voffA);
            PG8_BAR; PG8_WAIT_L(0); PG8_MMA(1, 0, At, B0); PG8_BAR; PG8_SCHED;
            PG8_STAGE(PG8_SB(1, 1), b3 + hstepB, voffB);
            PG8_WAIT_V(6); PG8_BAR; PG8_MMA(1, 1, At, B1); PG8_BAR;
        }
        S.epi(acc, cur, wr, wc, fr, fq);
        if (!has_next) break;
#pragma unroll
        for (int a = 0; a < 2; ++a)
#pragma unroll
            for (int b = 0; b < 2; ++b)
#pragma unroll
                for (int m = 0; m < 4; ++m)
#pragma unroll
                    for (int n = 0; n < 2; ++n) acc[a][b][m][n] = (f32x4){0.f, 0.f, 0.f, 0.f};
        cur = nxt; cA = nA; cB = nB; ++ui;
    }
    PG8_WAIT_V(0);
    if (wr == 0) PG8_BAR;
    PG8_BAR;
#undef PG8_SA
#undef PG8_SB
#undef PG8_STAGE
#undef PG8_LDA
#undef PG8_LDB
#undef PG8_MMA
#undef PG8_WAIT_V
#undef PG8_WAIT_L
#undef PG8_BAR
#undef PG8_SCHED
}

struct PhPlain {
    static constexpr bool PERM = true; static constexpr int TAILC = 0; static constexpr bool QPERM = false;
    int K, lda, ldb, nM, nN, coff; const bf16_t *A, *B; bf16_t* O; int ldc;
    __device__ __forceinline__ const char* aptr(const Unit& u) const { return (const char*)(A + (size_t)u.pm * 256 * lda); }
    __device__ __forceinline__ const char* bptr(const Unit& u) const { return (const char*)(B + (size_t)u.pn * 256 * ldb); }
    __device__ __forceinline__ void epi(const f32x4 (&acc)[2][2][4][2], const Unit& u, int wr, int wc, int fr, int fq) const {
        store_bf16_tile(acc, O + (size_t)u.pm * 256 * ldc + (size_t)u.pn * 256, (size_t)ldc, 1.f, wr, wc, fr, fq);
    }
};
#define DPP4(dst, src, ctrl) { _Pragma("unroll") for (int i_ = 0; i_ < 4; ++i_) dst[i_] = __int_as_float(__builtin_amdgcn_update_dpp(0, __float_as_int(src[i_]), ctrl, 0xf, 0xf, false)); }
struct PhConvFused {
    static constexpr bool PERM = true; static constexpr int TAILC = 112; static constexpr bool QPERM = false;
    int K, lda, ldb, nM, nN, coff; const bf16_t *A, *B; bf16_t* BIG; bf16_t* Y; const float* cw;
    __device__ __forceinline__ const char* aptr(const Unit& u) const { return (const char*)(A + (size_t)u.pm * 256 * lda); }
    __device__ __forceinline__ const char* bptr(const Unit& u) const { return (const char*)(B + (size_t)u.pn * 256 * ldb); }
    __device__ __forceinline__ void epi(const f32x4 (&acc)[2][2][4][2], const Unit& u, int wr, int wc, int fr, int fq) const {
        const int jc = u.pn * 64 + 16 * wc + 4 * fq;
        if (u.pm % 9 == 0) {
#pragma unroll
            for (int ai = 0; ai < 2; ++ai)
#pragma unroll
                for (int m = 0; m < 4; ++m) { bf16_t* rowp = BIG + (size_t)(u.pm * 256 + ai * HALF + wr * 64 + m * 16 + fr) * 8192 + jc;
#pragma unroll
                    for (int bj = 0; bj < 2; ++bj)
#pragma unroll
                        for (int n = 0; n < 2; ++n) { const f32x4 v = acc[ai][bj][m][n]; u32x2 o; o.x = cvt_pk_bf16(v[0], v[1]); o.y = cvt_pk_bf16(v[2], v[3]);
                            *(u32x2*)(rowp + (2 * bj + n) * 2048) = o; } }
            return;
        }
        const f32x4 w0 = *(const f32x4*)(cw + jc), w1 = *(const f32x4*)(cw + DI + jc), w2 = *(const f32x4*)(cw + 2 * DI + jc);
#pragma unroll
        for (int ai = 0; ai < 2; ++ai) {
            f32x4 cu[4];
#pragma unroll
            for (int m = 0; m < 4; ++m) cu[m] = acc[ai][0][m][1] * acc[ai][1][m][0];
#pragma unroll
            for (int m = 0; m < 4; ++m) {
                f32x4 pv, nx, t;
                DPP4(pv, cu[m], 0x111)
                if (m > 0) { DPP4(t, cu[m - 1], 0x121) if (fr == 0) pv = t; }
                DPP4(nx, cu[m], 0x101)
                if (m < 3) { DPP4(t, cu[m + 1], 0x12F) if (fr == 15) nx = t; }
                const f32x4 bb = acc[ai][0][m][0], zz = acc[ai][1][m][1];
                f32x4 y;
#pragma unroll
                for (int i = 0; i < 4; ++i) y[i] = bb[i] * (w0[i] * pv[i] + w1[i] * cu[m][i] + w2[i] * nx[i]) * silu_f(zz[i]);
                u32x2 o; o.x = cvt_pk_bf16(y[0], y[1]); o.y = cvt_pk_bf16(y[2], y[3]);
                *(u32x2*)(Y + (size_t)(u.pm * 256 + ai * HALF + wr * 64 + m * 16 + fr) * DI + jc) = o;
            }
        }
    }
};
struct PhQKV {
    static constexpr bool PERM = true; static constexpr int TAILC = 0; static constexpr bool QPERM = true;
    int K, lda, ldb, nM, nN, coff; const bf16_t* A; const bf16_t* W  ; bf16_t* O; int which0;
    __device__ __forceinline__ const char* aptr(const Unit& u) const { const int h = (u.pn >> 1) & 3; return (const char*)(A + (size_t)u.pm * 256 * lda + h * 512); }
    __device__ __forceinline__ const char* bptr(const Unit& u) const { const int which = which0 + (u.pn >> 3), h = (u.pn >> 1) & 3, half = u.pn & 1;
        return (const char*)(W + ((size_t)(which * 4 + h) * 512 + half * 256) * 512); }
    __device__ __forceinline__ void epi(const f32x4 (&acc)[2][2][4][2], const Unit& u, int wr, int wc, int fr, int fq) const {
        const int which = which0 + (u.pn >> 3), h = (u.pn >> 1) & 3, half = u.pn & 1;
        store_bf16_tile(acc, O + (size_t)u.pm * 256 * 6144 + which * 2048 + h * 512 + half * 256, 6144, which == 1 ? 0.044194173824159216f : 1.f, wr, wc, fr, fq);
    }
};
struct PhTr {
    static constexpr bool PERM = true; static constexpr int TAILC = 0; static constexpr bool QPERM = false;
    int K, lda, ldb, nM, nN, coff; const bf16_t* W  ; const bf16_t* Act; bf16_t* OT; float scale;
    __device__ __forceinline__ const char* aptr(const Unit& u) const { const int h = u.pm >> 1, mh = u.pm & 1; return (const char*)(W + ((size_t)h * 512 + mh * 256) * 512); }
    __device__ __forceinline__ const char* bptr(const Unit& u) const { const int h = u.pm >> 1; return (const char*)(Act + (size_t)u.pn * 256 * ldb + h * 512); }
    __device__ __forceinline__ void epi(const f32x4 (&acc)[2][2][4][2], const Unit& u, int wr, int wc, int fr, int fq) const {
        const int h = u.pm >> 1, mh = u.pm & 1, bl = u.pn / 9, w = u.pn % 9;
        store_bf16_tile(acc, OT + ((size_t)(bl * 4 + h) * 512 + mh * 256) * TT + w * 256, (size_t)TT, scale, wr, wc, fr, fq);
    }
};
struct PhQK {
    static constexpr bool PERM = false; static constexpr int TAILC = 0; static constexpr bool QPERM = false;
    int K, lda, ldb, nM, nN, coff; const bf16_t* QKV; float* QKR;
    __device__ __forceinline__ const char* aptr(const Unit& u) const { const int bl = u.pm / 36, h = (u.pm / 9) & 3, w = u.pm % 9; return (const char*)(QKV + (size_t)(bl * TT + w * 256) * 6144 + h * 512); }
    __device__ __forceinline__ const char* bptr(const Unit& u) const { const int bl = u.pm / 36, h = (u.pm / 9) & 3, w = u.pm % 9; return (const char*)(QKV + (size_t)(bl * TT + w * 256) * 6144 + 2048 + h * 512); }
    __device__ __forceinline__ void epi(const f32x4 (&acc)[2][2][4][2], const Unit& u, int wr, int wc, int fr, int fq) const {
        if (wr != (wc >> 1)) return;
        const int bl = u.pm / 36, h = (u.pm / 9) & 3, w = u.pm % 9;
        float* base = QKR + ((size_t)(bl * 4 + h) * TT + w * 256 + wr * 64 + fr) * 64 + 32 * (wc & 1) + 4 * fq;
#pragma unroll
        for (int ai = 0; ai < 2; ++ai)
#pragma unroll
            for (int m = 0; m < 4; ++m)
#pragma unroll
                for (int n = 0; n < 2; ++n) *(f32x4*)(base + (size_t)(ai * 128 + m * 16) * 64 + n * 16) = acc[ai][ai][m][n];
    }
};
struct PhGates {
    static constexpr bool PERM = false; static constexpr int TAILC = 0; static constexpr bool QPERM = false;
    int K, lda, ldb, nM, nN, coff; const bf16_t* A; const bf16_t* WG; float* GATESP; int poff;
    __device__ __forceinline__ const char* aptr(const Unit& u) const { return (const char*)(A + (size_t)u.pm * 256 * lda + u.pn * 512); }
    __device__ __forceinline__ const char* bptr(const Unit& u) const { return (const char*)(WG + u.pn * 512); }
    __device__ __forceinline__ void epi(const f32x4 (&acc)[2][2][4][2], const Unit& u, int wr, int wc, int fr, int fq) const {
        if (wc != 0) return;
        float* base = GATESP + (size_t)(poff + u.pn) * RG * 16 + (size_t)(u.pm * 256 + wr * 64 + fr) * 16 + 4 * fq;
#pragma unroll
        for (int ai = 0; ai < 2; ++ai)
#pragma unroll
            for (int m = 0; m < 4; ++m) *(f32x4*)(base + (size_t)(ai * 128 + m * 16) * 16) = acc[ai][0][m][0];
    }
};
struct PhResid {
    static constexpr bool PERM = false; static constexpr int TAILC = 0; static constexpr bool QPERM = false;
    int K, lda, ldb, nM, nN, coff; const bf16_t *A, *B; const float *xin_x, *xin_c; float *xout_x, *xout_c; const float* mod  ; int g;
    __device__ __forceinline__ const char* aptr(const Unit& u) const { return (const char*)(A + (size_t)u.pm * 256 * lda); }
    __device__ __forceinline__ const char* bptr(const Unit& u) const { return (const char*)(B + (size_t)u.pn * 256 * ldb); }
    __device__ __forceinline__ void epi(const f32x4 (&acc)[2][2][4][2], const Unit& u, int wr, int wc, int fr, int fq) const {
        const int bl = u.pm / 9, w = u.pm % 9, b = g * GB + bl;
        const float* xin; float* xout; size_t rbase; int v;
        if (w == 0) { rbase = (size_t)b * CTXL; xin = xin_c; xout = xout_c; v = 16; } else { rbase = (size_t)b * SEQ + (w - 1) * 256; xin = xin_x; xout = xout_x; v = b; }
        const int col0 = u.pn * 256 + wc * 32 + 4 * fq;
        const float* gate = mod + (size_t)v * 3072 + 2048 + col0;
        f32x4 gv[2][2];
#pragma unroll
        for (int bj = 0; bj < 2; ++bj)
#pragma unroll
            for (int n = 0; n < 2; ++n) gv[bj][n] = *(const f32x4*)(gate + bj * HALF + n * 16);
#pragma unroll
        for (int ai = 0; ai < 2; ++ai)
#pragma unroll
            for (int m = 0; m < 4; ++m) { const size_t off = (rbase + wr * 64 + fr + ai * HALF + m * 16) * DM + col0;
#pragma unroll
                for (int bj = 0; bj < 2; ++bj)
#pragma unroll
                    for (int n = 0; n < 2; ++n) { const f32x4 xv = *(const f32x4*)(xin + off + bj * HALF + n * 16);
                        *(f32x4*)(xout + off + bj * HALF + n * 16) = xv + gv[bj][n] * acc[ai][bj][m][n]; } }
    }
};

__device__ __forceinline__ int convin_dst_row(int ns) { const int g = ns >> 11, rem = ns & 2047, pn = rem >> 6, jc = rem & 63;
    return 256 * pn + 128 * (g >> 1) + 32 * (jc >> 4) + 8 * ((jc >> 2) & 3) + 4 * (g & 1) + (jc & 3); }
__device__ __forceinline__ void transpose_item(const float* W, int K, int N, bf16_t* WT, LAS float* scr, int item, int lane, bool perm = false) {
    const int nblk = N / 32, kb = item / nblk, nb = item % nblk, k0 = 64 * kb, n0 = 32 * nb;
    float tv[32];
#pragma unroll
    for (int i = 0; i < 32; ++i) { const int kk = 2 * i + (lane >> 5); tv[i] = W[(size_t)(k0 + kk) * N + n0 + (lane & 31)]; }
#pragma unroll
    for (int i = 0; i < 32; ++i) { const int kk = 2 * i + (lane >> 5); scr[kk * 33 + (lane & 31)] = tv[i]; }
    LDS_WAIT();
    const int c = lane & 7;
#pragma unroll
    for (int j = 0; j < 4; ++j) { const int n = (lane >> 3) + 8 * j; const LAS float* s = scr + (8 * c) * 33 + n;
        u32x4 o; o.x = cvt_pk_bf16(s[0 * 33], s[1 * 33]); o.y = cvt_pk_bf16(s[2 * 33], s[3 * 33]); o.z = cvt_pk_bf16(s[4 * 33], s[5 * 33]); o.w = cvt_pk_bf16(s[6 * 33], s[7 * 33]);
        *(u32x4*)(WT + (size_t)(perm ? convin_dst_row(n0 + n) : (n0 + n)) * K + k0 + 8 * c) = o; }
    LDS_WAIT();
}
__device__ __forceinline__ void phase_prep(LAS unsigned char* lds, int wv) {
    const Params P = load_params();
    const int tid = opaque_tid(wv), lane = tid & 63, wave = tid >> 6;
    unsigned char* ws = opq(P.ws);
    float* MODP = (float*)(ws + WS_MODP);
    for (int item = blockIdx.x; item < 192; item += gridDim.x) {
        const int i = item / 48, rem = item % 48, ks = rem / 6, nb = rem % 6;
        LAS float* sc = (LAS float*)lds;
        for (int idx = tid; idx < 17 * 128; idx += 512) { const int v = idx >> 7, k = idx & 127; const float cv = (v < 16) ? P.c[v * DM + ks * 128 + k] : P.c_ctx[ks * 128 + k]; sc[idx] = silu_f(cv); }
        __syncthreads();
        const int n = nb * 512 + tid;
        float a[17];
#pragma unroll
        for (int v = 0; v < 17; ++v) a[v] = 0.f;
        const float* wp = P.mod_w + ((size_t)i * DM + ks * 128) * 3072 + n;
        for (int k0 = 0; k0 < 128; k0 += 16) {
            float wv[16];
#pragma unroll
            for (int u = 0; u < 16; ++u) wv[u] = wp[(size_t)(k0 + u) * 3072];
#pragma unroll
            for (int u = 0; u < 16; ++u)
#pragma unroll
                for (int v = 0; v < 17; ++v) a[v] += sc[v * 128 + k0 + u] * wv[u]; }
#pragma unroll
        for (int v = 0; v < 17; ++v) MODP[((size_t)(ks * 4 + i) * 17 + v) * 3072 + n] = a[v];
        __syncthreads();
    }
    LAS float* scr = (LAS float*)(lds + 16384 + wave * 8448);
    const int gw = blockIdx.x * 8 + wave, NGW = gridDim.x * 8;
    constexpr int PERJ = 4096 + 1024 + 3072 + 12 * 128 + 1024;
    for (int it = gw; it < 2 * PERJ; it += NGW) {
        const int j = it / PERJ; int r = it % PERJ;
        if (r < 4096) { transpose_item(P.conv_w_in + (size_t)j * DM * 8192, DM, 8192, (bf16_t*)(ws + WS_CWIN) + (size_t)j * 8192 * DM, scr, r, lane, true); continue; } r -= 4096;
        if (r < 1024) { transpose_item(P.conv_w_out + (size_t)j * DI * DM, DI, DM, (bf16_t*)(ws + WS_CWOUT) + (size_t)j * DM * DI, scr, r, lane); continue; } r -= 1024;
        if (r < 3072) { transpose_item(P.m_w_in + (size_t)j * DM * 6144, DM, 6144, (bf16_t*)(ws + WS_MWIN) + (size_t)j * 6144 * DM, scr, r, lane); continue; } r -= 3072;
        if (r < 1536) { const int wh = r / 128, which = wh >> 2, h = wh & 3; const float* src = (which == 0 ? P.m_wq : (which == 1 ? P.m_wk : P.m_wv)) + (size_t)(j * 4 + h) * DH * DH;
            transpose_item(src, DH, DH, (bf16_t*)(ws + WS_MWQKV) + ((size_t)(j * 3 + which) * 4 + h) * DH * DH, scr, r % 128, lane); continue; } r -= 1536;
        transpose_item(P.m_w_out + (size_t)j * DI * DM, DI, DM, (bf16_t*)(ws + WS_MWOUT) + (size_t)j * DM * DI, scr, r, lane);
    }
    bf16_t* MWG2 = (bf16_t*)(ws + WS_MWG);
    for (int item = gw; item < 2 * 2 * 2048; item += NGW) {
        const int j = item >> 12, part = (item >> 11) & 1, kg = item & 2047, h = kg >> 9, d = kg & 511;
        float acc[16];
#pragma unroll
        for (int n = 0; n < 16; ++n) acc[n] = 0.f;
        for (int pass = 0; pass < (part == 0 ? 2 : 1); ++pass) {
            const int which = part == 0 ? pass : 2; const float scl = which == 1 ? 0.044194173824159216f : 1.f;
            const float* wrow = (which == 0 ? P.m_wq : (which == 1 ? P.m_wk : P.m_wv)) + ((size_t)(j * 4 + h) * DH + d) * DH;
            const float* wgp = P.m_w_gate + ((size_t)j * 6144 + which * 2048 + h * 512) * 16;
#pragma unroll
            for (int q = 0; q < 8; ++q) { const int e = lane + 64 * q; const float wvv = wrow[e] * scl;
                const f32x4 g0 = *(const f32x4*)(wgp + (size_t)e * 16), g1 = *(const f32x4*)(wgp + (size_t)e * 16 + 4), g2 = *(const f32x4*)(wgp + (size_t)e * 16 + 8), g3 = *(const f32x4*)(wgp + (size_t)e * 16 + 12);
#pragma unroll
                for (int i = 0; i < 4; ++i) { acc[i] += wvv * g0[i]; acc[4 + i] += wvv * g1[i]; acc[8 + i] += wvv * g2[i]; acc[12 + i] += wvv * g3[i]; } }
        }
        float mine = 0.f;
#pragma unroll
        for (int n = 0; n < 16; ++n) { const float t = wave_sum(acc[n], lane); mine = (lane == n) ? t : mine; }
        if (lane < 16) MWG2[((size_t)(j * 2 + part) * 256 + lane) * 2048 + kg] = (bf16_t)(cvt_pk_bf16(mine, 0.f) & 0xffffu);
    }
    for (size_t idx = (size_t)blockIdx.x * 512 + tid; idx < (size_t)4 * 240 * 2048; idx += (size_t)gridDim.x * 512) {
        const int m4 = (int)(idx / (240 * 2048)); const int rem = (int)(idx % (240 * 2048));
        MWG2[((size_t)m4 * 256 + 16) * 2048 + rem] = (bf16_t)0;
    }
    __syncthreads();
}
__device__ __forceinline__ void phase_modreduce(int wv) {
    const Params P = load_params();
    unsigned char* ws = opq(P.ws);
    const float* MODP = (const float*)(ws + WS_MODP); float* MOD = (float*)(ws + WS_MOD);
    for (int idx = blockIdx.x * 512 + opaque_tid(wv); idx < 4 * 17 * 3072; idx += gridDim.x * 512) {
        const int i = idx / (17 * 3072), n = idx % 3072;
        float s = P.mod_b[i * 3072 + n];
#pragma unroll
        for (int ks = 0; ks < 8; ++ks) s += MODP[(size_t)ks * 4 * 17 * 3072 + idx];
        MOD[idx] = s;
    }
}

__device__ __forceinline__ void phase_modulate(int layer, int g, int buf, bool light, int wv) {
    if (light && blockIdx.x < 160) return;
    const Params P = load_params();
    const float* xin_x = (layer == 0) ? P.x : P.out; const float* xin_c = (layer == 0) ? P.ctx : (const float*)(P.ws + WS_XC);
    const int tid = opaque_tid(wv), lane = tid & 63, gw = (light ? (int)blockIdx.x - 160 : (int)blockIdx.x) * 8 + (tid >> 6), NGW = (light ? 96 : (int)gridDim.x) * 8;
    unsigned char* ws = opq(P.ws); xin_x = opq(xin_x); xin_c = opq(xin_c);
    bf16_t* HX = (bf16_t*)(ws + (buf ? WS_HX2 : WS_HX)); const float* MOD = (const float*)(ws + WS_MOD) + (size_t)layer * 17 * 3072;
    const float* ng = opq(P.norm_g) + layer * DM;
    for (int r = gw; r < RG; r += NGW) {
        const int bl = r / TT, tt = r % TT, b = g * GB + bl;
        const float* xr; int v;
        if (tt < CTXL) { xr = xin_c + ((size_t)b * CTXL + tt) * DM; v = 16; } else { xr = xin_x + ((size_t)b * SEQ + (tt - CTXL)) * DM; v = b; }
        const float* md = MOD + (size_t)v * 3072;
        f32x4 xv[4]; float ss = 0.f;
#pragma unroll
        for (int q = 0; q < 4; ++q) { xv[q] = *(const f32x4*)(xr + 4 * lane + 256 * q); ss += (xv[q][0] * xv[q][0] + xv[q][1] * xv[q][1]) + (xv[q][2] * xv[q][2] + xv[q][3] * xv[q][3]); }
        const float rstd = rsqrtf(wave_sum(ss, lane) * (1.f / DM) + EPSV);
#pragma unroll
        for (int q = 0; q < 4; ++q) { const int c0 = 4 * lane + 256 * q;
            const f32x4 gv = *(const f32x4*)(ng + c0), sh = *(const f32x4*)(md + c0), sc = *(const f32x4*)(md + 1024 + c0);
            const f32x4 y = xv[q] * rstd * gv * (sc + 1.f) + sh;
            u32x2 o; o.x = cvt_pk_bf16(y[0], y[1]); o.y = cvt_pk_bf16(y[2], y[3]);
            *(u32x2*)(HX + (size_t)r * DM + c0) = o; }
    }
}
__device__ __forceinline__ void conv_valid(int r, bool& pv, bool& nv) {
    const int tt = r % TT;
    if (tt < CTXL) { pv = tt != 0; nv = tt != CTXL - 1; } else { pv = (tt & 63) != 0; nv = (tt & 63) != 63; }
}
__device__ __forceinline__ void phase_convmix(int j, int g, int wv) {
    const Params P = load_params();
    unsigned char* ws = opq(P.ws);
    const bf16_t* BIG = (const bf16_t*)(ws + WS_BIG); bf16_t* Y = (bf16_t*)(ws + ((g & 1) ? WS_KT : WS_VT));
    const float* cw = opq(P.conv_w) + (size_t)j * 3 * DI;
    for (int it = blockIdx.x * 512 + opaque_tid(wv); it < GB * CTXL * 256; it += gridDim.x * 512) {
        const int rc = it >> 8, r = (rc >> 8) * TT + (rc & 255), c8 = (it & 255) * 8; bool pv, nv; conv_valid(r, pv, nv);
        const bf16_t* row = BIG + (size_t)r * 8192 + c8;
        float bb[8], cc[8], uu[8], zz[8], cp[8], up[8], cn[8], un[8];
        unpack8(*(const u32x4*)(row), bb); unpack8(*(const u32x4*)(row + 2048), cc); unpack8(*(const u32x4*)(row + 4096), uu); unpack8(*(const u32x4*)(row + 6144), zz);
        const u32x4 z4 = (u32x4){0u, 0u, 0u, 0u};
        unpack8(pv ? *(const u32x4*)(row - 8192 + 2048) : z4, cp); unpack8(pv ? *(const u32x4*)(row - 8192 + 4096) : z4, up);
        unpack8(nv ? *(const u32x4*)(row + 8192 + 2048) : z4, cn); unpack8(nv ? *(const u32x4*)(row + 8192 + 4096) : z4, un);
        float w0[8], w1[8], w2[8], y[8];
        *(f32x4*)(w0) = *(const f32x4*)(cw + c8); *(f32x4*)(w0 + 4) = *(const f32x4*)(cw + c8 + 4);
        *(f32x4*)(w1) = *(const f32x4*)(cw + DI + c8); *(f32x4*)(w1 + 4) = *(const f32x4*)(cw + DI + c8 + 4);
        *(f32x4*)(w2) = *(const f32x4*)(cw + 2 * DI + c8); *(f32x4*)(w2 + 4) = *(const f32x4*)(cw + 2 * DI + c8 + 4);
#pragma unroll
        for (int e = 0; e < 8; ++e) { const float s = w0[e] * (cp[e] * up[e]) + w1[e] * (cc[e] * uu[e]) + w2[e] * (cn[e] * un[e]); y[e] = bb[e] * s * silu_f(zz[e]); }
        *(u32x4*)(Y + (size_t)r * DI + c8) = pack8(y);
    }
}
__device__ __forceinline__ void phase_uc(int j, int wv) {
    const Params P = load_params();
    unsigned char* ws = opq(P.ws);
    const bf16_t* UZO = (const bf16_t*)(ws + WS_BIG); bf16_t* UC = (bf16_t*)(ws + WS_UC);
    const float* cw = opq(P.m_conv_w) + (size_t)j * 3 * DI;
    for (int it = blockIdx.x * 512 + opaque_tid(wv); it < RG * 256; it += gridDim.x * 512) {
        const int r = it >> 8, c8 = (it & 255) * 8; bool pv, nv; conv_valid(r, pv, nv);
        const bf16_t* row = UZO + (size_t)r * 6144 + c8;
        float uu[8], up[8], un[8], y[8];
        const u32x4 z4 = (u32x4){0u, 0u, 0u, 0u};
        unpack8(*(const u32x4*)(row), uu);
        unpack8(pv ? *(const u32x4*)(row - 6144) : z4, up);
        unpack8(nv ? *(const u32x4*)(row + 6144) : z4, un);
        float w0[8], w1[8], w2[8];
        *(f32x4*)(w0) = *(const f32x4*)(cw + c8); *(f32x4*)(w0 + 4) = *(const f32x4*)(cw + c8 + 4);
        *(f32x4*)(w1) = *(const f32x4*)(cw + DI + c8); *(f32x4*)(w1 + 4) = *(const f32x4*)(cw + DI + c8 + 4);
        *(f32x4*)(w2) = *(const f32x4*)(cw + 2 * DI + c8); *(f32x4*)(w2 + 4) = *(const f32x4*)(cw + 2 * DI + c8 + 4);
#pragma unroll
        for (int e = 0; e < 8; ++e) { const float s = w0[e] * up[e] + w1[e] * uu[e] + w2[e] * un[e]; y[e] = silu_f(s); }
        *(u32x4*)(UC + (size_t)r * DI + c8) = pack8(y);
    }
}
__device__ __forceinline__ void phase_gating(int j, int wv) {
    const Params P = load_params();
    const int tid = opaque_tid(wv), lane = tid & 63, gw = blockIdx.x * 8 + (tid >> 6), NGW = gridDim.x * 8;
    unsigned char* ws = opq(P.ws); const float* mng = opq(P.m_norm_g) + (size_t)j * DI; const float* msk = opq(P.m_skip) + (size_t)j * DI;
    const bf16_t* QKV = (const bf16_t*)(ws + WS_QKV); const bf16_t* UZO = (const bf16_t*)(ws + WS_BIG); const bf16_t* UC = (const bf16_t*)(ws + WS_UC);
    bf16_t* Y = (bf16_t*)(ws + WS_KT);
    u32x4 nhf, nhb, nzz, noo, nuc;
#define GATE_LOAD(IT) { const int r_ = (IT) >> 2, c_ = ((IT) & 3) * 512 + 8 * lane; \
        nhf = *(const u32x4*)(QKV + (size_t)r_ * 6144 + 2048 + c_); nhb = *(const u32x4*)(QKV + (size_t)r_ * 6144 + 4096 + c_); \
        nzz = *(const u32x4*)(UZO + (size_t)r_ * 6144 + 2048 + c_); noo = *(const u32x4*)(UZO + (size_t)r_ * 6144 + 4096 + c_); nuc = *(const u32x4*)(UC + (size_t)r_ * DI + c_); }
    if (gw < RG * 4) GATE_LOAD(gw)
    for (int it = gw; it < RG * 4; it += NGW) {
        const int r = it >> 2, h = it & 3, c0 = h * 512 + 8 * lane;
        float hf[8], hb[8], zz[8], oo[8], uc[8], y[8];
        unpack8(nhf, hf); unpack8(nhb, hb); unpack8(nzz, zz); unpack8(noo, oo); unpack8(nuc, uc);
        { const int itn = (it + NGW < RG * 4) ? it + NGW : it; GATE_LOAD(itn) }
        float s = 0.f;
#pragma unroll
        for (int e = 0; e < 8; ++e) { hf[e] += hb[e]; s += hf[e]; }
        const float mean = wave_sum(s, lane) * (1.f / DH); float s2 = 0.f;
#pragma unroll
        for (int e = 0; e < 8; ++e) { hf[e] -= mean; s2 += hf[e] * hf[e]; }
        const float rstd = rsqrtf(wave_sum(s2, lane) * (1.f / DH) + EPSV);
        float ng[8], sk[8];
        *(f32x4*)(ng) = *(const f32x4*)(mng + c0); *(f32x4*)(ng + 4) = *(const f32x4*)(mng + c0 + 4);
        *(f32x4*)(sk) = *(const f32x4*)(msk + c0); *(f32x4*)(sk + 4) = *(const f32x4*)(msk + c0 + 4);
#pragma unroll
        for (int e = 0; e < 8; ++e) y[e] = (sigmoid_f(oo[e]) * (hf[e] * rstd * ng[e]) + sk[e] * uc[e]) * silu_f(zz[e]);
        *(u32x4*)(Y + (size_t)r * DI + c0) = pack8(y);
    }
#undef GATE_LOAD
}
__device__ __forceinline__ void phase_final(int r0, int r1, bool light, int wv) {
    if (light && blockIdx.x < 144) return;
    const Params P = load_params();
    const int tid = opaque_tid(wv), lane = tid & 63, gw = (light ? (int)blockIdx.x - 144 : (int)blockIdx.x) * 8 + (tid >> 6), NGW = (light ? 112 : (int)gridDim.x) * 8;
    float* outp = opq(P.out); const float* fg = opq(P.final_g);
    for (int r = r0 + gw; r < r1; r += NGW) {
        float* xr = outp + (size_t)r * DM;
        f32x4 xv[4]; float ss = 0.f;
#pragma unroll
        for (int q = 0; q < 4; ++q) { xv[q] = *(const f32x4*)(xr + 4 * lane + 256 * q); ss += (xv[q][0] * xv[q][0] + xv[q][1] * xv[q][1]) + (xv[q][2] * xv[q][2] + xv[q][3] * xv[q][3]); }
        const float rstd = rsqrtf(wave_sum(ss, lane) * (1.f / DM) + EPSV);
#pragma unroll
        for (int q = 0; q < 4; ++q) { const f32x4 gv = *(const f32x4*)(fg + 4 * lane + 256 * q); *(f32x4*)(xr + 4 * lane + 256 * q) = xv[q] * rstd * gv; }
    }
}

__device__ __forceinline__ void phase_gatetab(LAS unsigned char* lds, int j, int wv) {
    if (blockIdx.x < 144 || blockIdx.x >= 176) return;
    const Params P = load_params();
    const int tid = opaque_tid(wv), lane = tid & 63, w = __builtin_amdgcn_readfirstlane(tid >> 6);
    unsigned char* ws = P.ws;
    const int sidx = (int)blockIdx.x - 144, dir = sidx & 1, h = (sidx >> 1) & 3, bl = sidx >> 3;
    const float* gt = (const float*)(ws + WS_GATESP) + (size_t)(bl * TT) * 16 + h + (dir ? 8 : 0);
    LAS float* tA = (LAS float*)(lds + 102400); LAS float* tPM = tA + TT; LAS float* tBC = tA + 2 * TT;
    LAS float* cMP = (LAS float*)(lds + 102400 + 3 * TT * 4); LAS float* cM63 = cMP + 36; LAS float* cBL = cMP + 72; LAS float* cAM = cMP + 108;
        {
            const float bi_ = P.m_b_gate[j * 16 + (dir ? 8 : 0) + h], bf_ = P.m_b_gate[j * 16 + (dir ? 8 : 0) + 4 + h];
            for (int cc = w; cc < 36; cc += 8) { const int ac = dir ? (cc < 4 ? 3 - cc : 39 - cc) : cc, t = dir ? 63 - lane : lane, row = ac * 64 + t;
                const float* gp = gt + (size_t)row * 16; float si = bi_, sf = bf_;
#pragma unroll
                for (int ks_ = 0; ks_ < 8; ++ks_) { si += gp[(size_t)ks_ * RG * 16]; sf += gp[(size_t)ks_ * RG * 16 + 4]; }
                const float fp = sf; const float lf = fminf(fp, 0.f) - log1pf(__expf(-fabsf(fp)));
#define DPP_F(oldv, src, ctrl, rmask) __int_as_float(__builtin_amdgcn_update_dpp(__float_as_int(oldv), __float_as_int(src), ctrl, rmask, 0xf, false))
                float bc = lf;
                bc += DPP_F(0.f, bc, 0x111, 0xf); bc += DPP_F(0.f, bc, 0x112, 0xf); bc += DPP_F(0.f, bc, 0x114, 0xf); bc += DPP_F(0.f, bc, 0x118, 0xf);
                bc += DPP_F(0.f, bc, 0x142, 0xa); bc += DPP_F(0.f, bc, 0x143, 0xc);
                const float av = si - bc;
                const float ninf = -__builtin_inff();
                float pmx = av;
                pmx = fmaxf(pmx, DPP_F(ninf, pmx, 0x111, 0xf)); pmx = fmaxf(pmx, DPP_F(ninf, pmx, 0x112, 0xf)); pmx = fmaxf(pmx, DPP_F(ninf, pmx, 0x114, 0xf)); pmx = fmaxf(pmx, DPP_F(ninf, pmx, 0x118, 0xf));
                pmx = fmaxf(pmx, DPP_F(ninf, pmx, 0x142, 0xa)); pmx = fmaxf(pmx, DPP_F(ninf, pmx, 0x143, 0xc));
#undef DPP_F
                tA[row] = av; tPM[row] = pmx; tBC[row] = bc;
                if (lane == 63) { cBL[cc] = bc; cAM[cc] = pmx; } }
            __syncthreads();
            if (tid == 0) { float mp = 0.f; for (int cc = 0; cc < 36; ++cc) { cMP[cc] = mp; const float M63 = fmaxf(mp, cAM[cc]); cM63[cc] = M63; mp = cBL[cc] + M63; } }
            __syncthreads();
        }
    { char* gdst = (char*)(ws + WS_GTAB) + (size_t)sidx * 28224; const LAS f32x4* lsrc = (const LAS f32x4*)tA;
      for (int i = tid; i < 7056 / 4; i += 512) { unsigned off = (unsigned)i * 16u; asm volatile("" : "+v"(off)); *(f32x4*)(gdst + off) = lsrc[i]; } }
    __syncthreads();
}

constexpr int SC_R = 0, SC_V = 81920, SC_VW = 91136, SC_TAB = 100352;
__device__ __forceinline__ bf16x8 mk_frag(unsigned a, unsigned b, unsigned c, unsigned d) { u32x4 t; t.x = a; t.y = b; t.z = c; t.w = d; return __builtin_bit_cast(bf16x8, t); }
__device__ __forceinline__ void phase_scan(LAS unsigned char* lds, int j, int wv) {
    const Params P = load_params();
    const int tid = opaque_tid(wv);
    const int lane = tid & 63, w = __builtin_amdgcn_readfirstlane(tid >> 6), lr = lane & 15, lq = lane >> 4;
    const unsigned qoff = (unsigned)(lr * 6144 + 64 * w + 8 * lq) * 2u;
    const unsigned koff = (unsigned)((64 * w + lr) * TT + 8 * lq) * 2u;
    const unsigned hoff = (unsigned)((4 * lq) * 6144 + lr) * 2u;
    unsigned char* ws = opq(P.ws);
    bf16_t* QKV = (bf16_t*)(ws + WS_QKV); const bf16_t* KT = (const bf16_t*)(ws + WS_KT); const bf16_t* VT = (const bf16_t*)(ws + WS_VT);
    const float* QKR = (const float*)(ws + WS_QKR); const float* GATES = (const float*)(ws + WS_GATESP);
    LAS f32x4* R = (LAS f32x4*)(lds + SC_R);
    LAS bf16_t* sV = (LAS bf16_t*)(lds + SC_V); LAS bf16_t* sVW = (LAS bf16_t*)(lds + SC_VW);
    LAS bf16_t* sH = (LAS bf16_t*)(lds + 139264);
    LAS u32x4* sS = (LAS u32x4*)(lds + 131072);
    LAS float* tA = (LAS float*)(lds + 102400); LAS float* tPM = tA + TT; LAS float* tBC = tA + 2 * TT;
    LAS float* cMP = (LAS float*)(lds + 102400 + 3 * TT * 4); LAS float* cM63 = cMP + 36; LAS float* cBL = cMP + 72; LAS float* cAM = cMP + 108;
    LAS float* tabA = (LAS float*)(lds + SC_TAB); LAS float* tabM = tabA + 64; LAS float* tabWI = tabA + 128; LAS float* tabFL = tabA + 192; LAS float* tabWS = tabA + 256; LAS float* scal = tabA + 320;
    for (int uid = blockIdx.x; uid < GB * NH * 2 * 8; uid += gridDim.x) {
        const int xcd_ = uid & 7, yy_ = uid >> 3, pair_ = xcd_ * 2 + (yy_ >> 4);
        const int es = yy_ & 7, dir = (yy_ >> 3) & 1, h = pair_ & 3, bl = pair_ >> 2;
        const bf16_t* qb = QKV + (size_t)(bl * TT) * 6144 + h * 512;
        const bf16_t* kTb = KT + (size_t)((bl * 4 + h) * 512) * TT;
        const bf16_t* vTb = VT + (size_t)((bl * 4 + h) * 512 + es * 64) * TT;
        const float* qkr = QKR + (size_t)((bl * 4 + h) * TT) * 64;
        const float* gt = GATES + (size_t)(bl * TT) * 16 + h + (dir ? 8 : 0);
        bf16_t* hout = QKV + (size_t)(bl * TT) * 6144 + (dir ? 4096 : 2048) + h * 512 + es * 64;
        f32x4 C[4][5];
#pragma unroll
        for (int a = 0; a < 4; ++a)
#pragma unroll
            for (int b = 0; b < 5; ++b) C[a][b] = (f32x4){0.f, 0.f, 0.f, 0.f};
        { const char* gsrc = (const char*)(ws + WS_GTAB) + (size_t)((bl * 4 + h) * 2 + dir) * 28224; LAS f32x4* ldst = (LAS f32x4*)tA;
          for (int i = tid; i < 7056 / 4; i += 512) { unsigned off = (unsigned)i * 16u; asm volatile("" : "+v"(off)); ldst[i] = *(const f32x4*)(gsrc + off); }
          __syncthreads(); }
        bf16x8 qa0[4], qa1[4];
#define SCAN_LOAD_Q0(T0) { _Pragma("unroll") for (int jt = 0; jt < 4; ++jt) { const char* p_ = (const char*)qb + (size_t)((T0) + 16 * jt) * 12288 + qoff; \
            qa0[jt] = *(const bf16x8*)p_; qa1[jt] = *(const bf16x8*)(p_ + 64); } }
        SCAN_LOAD_Q0(dir ? 3 * 64 : 0)
        for (int cc = 0; cc < 36; ++cc) {
            const int ac = dir ? (cc < 4 ? 3 - cc : 39 - cc) : cc, t0 = ac * 64;
            const int ccn = cc < 35 ? cc + 1 : 35, acn = dir ? (ccn < 4 ? 3 - ccn : 39 - ccn) : ccn, t0n = acn * 64;
            if (w == 7) { const float mpc = cMP[cc], M63c = cM63[cc]; const float av_ = tA[t0 + lane], Mi_ = fmaxf(mpc, tPM[t0 + lane]);
                tabWS[lane] = __expf(av_ - M63c); tabWI[lane] = __expf(mpc - Mi_); tabFL[lane] = __expf(-(tBC[t0 + lane] + Mi_)); }
#define SCAN_PASS(E0, NE) { f32x4 Pt[4][NE]; \
                _Pragma("unroll") for (int ks = 0; ks < 2; ++ks) { \
                  _Pragma("unroll") for (int e = 0; e < NE; ++e) { const f32x4 c0 = C[2 * ks][E0 + e], c1 = C[2 * ks + 1][E0 + e]; \
                    const bf16x8 cb = mk_frag(cvt_pk_bf16(c0[0], c0[1]), cvt_pk_bf16(c0[2], c0[3]), cvt_pk_bf16(c1[0], c1[1]), cvt_pk_bf16(c1[2], c1[3])); \
                    _Pragma("unroll") for (int jt = 0; jt < 4; ++jt) Pt[jt][e] = __builtin_amdgcn_mfma_f32_16x16x32_bf16(ks == 0 ? qa0[jt] : qa1[jt], cb, ks == 0 ? (f32x4){0.f, 0.f, 0.f, 0.f} : Pt[jt][e], 0, 0, 0); } } \
                if (w >= 4) { _Pragma("unroll") for (int jt = 0; jt < 4; ++jt) _Pragma("unroll") for (int e = 0; e < NE; ++e) R[((w - 4) * 20 + jt * 5 + E0 + e) * 64 + lane] = Pt[jt][e]; } \
                __syncthreads(); \
                if (w < 4) { _Pragma("unroll") for (int jt = 0; jt < 4; ++jt) _Pragma("unroll") for (int e = 0; e < NE; ++e) { const int idx = (w * 20 + jt * 5 + E0 + e) * 64 + lane; const f32x4 sres = Pt[jt][e] + R[idx]; R[idx] = sres; } } }
            SCAN_PASS(0, 2)
            if (w >= 4) {
#pragma unroll
                for (int hlf = 0; hlf < 2; ++hlf) { const int it_ = (tid - 256) + 256 * hlf, ve = it_ >> 3, vs = (it_ & 7) * 8;
                    const u32x4 vraw = *(const u32x4*)(vTb + (size_t)ve * TT + t0 + vs);
                    float vf[8], wv[8]; unpack8(vraw, vf);
                    const f32x4 w0 = *(const LAS f32x4*)(tabWS + vs), w1 = *(const LAS f32x4*)(tabWS + vs + 4);
#pragma unroll
                    for (int e = 0; e < 4; ++e) { wv[e] = vf[e] * w0[e]; wv[4 + e] = vf[4 + e] * w1[e]; }
                    *(LAS u32x4*)(sV + ve * 72 + vs) = vraw;
                    *(LAS u32x4*)(sVW + ve * 72 + vs) = pack8(wv); }
            }
            SCAN_PASS(2, 3)
#undef SCAN_PASS
            if (w >= 4) {
                int jr = 16 * (w - 4) + lr; asm volatile("" : "+v"(jr));
                const float Mj = fmaxf(cMP[cc], tPM[t0 + jr]);
#pragma unroll
                for (int ks = 0; ks < 2; ++ks) { const int s0 = 32 * ks + 8 * lq; const float* qp = qkr + (size_t)(t0 + jr) * 64 + s0;
                    const f32x4 q0 = *(const f32x4*)qp, q1 = *(const f32x4*)(qp + 4);
                    const f32x4 a0 = *(const LAS f32x4*)(tA + t0 + s0), a1 = *(const LAS f32x4*)(tA + t0 + s0 + 4);
                    float sv[8];
#pragma unroll
                    for (int e = 0; e < 4; ++e) { const int sA = s0 + e, sB = s0 + 4 + e;
                        const bool vA = dir ? (sA >= jr) : (sA <= jr), vB = dir ? (sB >= jr) : (sB <= jr);
                        sv[e] = vA ? q0[e] * __expf(a0[e] - Mj) : 0.f; sv[4 + e] = vB ? q1[e] * __expf(a1[e] - Mj) : 0.f; }
                    sS[((w - 4) * 2 + ks) * 64 + lane] = pack8(sv); }
            }
            bf16x8 ka[4][2];
#pragma unroll
            for (int dt = 0; dt < 4; ++dt)
#pragma unroll
                for (int ks = 0; ks < 2; ++ks) ka[dt][ks] = *(const bf16x8*)((const char*)kTb + (size_t)(16 * dt * TT + t0 + 32 * ks) * 2 + koff);
            const int jt_f = w >> 1, eh = w & 1;
            __syncthreads();
            {
                const int jt = jt_f;
                bf16x8 sa[2];
#pragma unroll
                for (int ks = 0; ks < 2; ++ks) { const u32x4 pk = sS[(jt * 2 + ks) * 64 + lane]; sa[ks] = __builtin_bit_cast(bf16x8, pk); }
                const unsigned one2 = (lr == 0) ? 0x3F803F80u : 0u;
                const bf16x8 ones = mk_frag(one2, one2, one2, one2);
                const f32x4 wi = *(const LAS f32x4*)(tabWI + 16 * jt + 4 * lq), fl = *(const LAS f32x4*)(tabFL + 16 * jt + 4 * lq);
                f32x4 num[3];
#pragma unroll
                for (int x = 0; x < 3; ++x) { const int et = (x < 2) ? 2 * eh + x : 4, tile = jt * 5 + et;
                    const f32x4 inter = (R[(0 * 20 + tile) * 64 + lane] + R[(1 * 20 + tile) * 64 + lane]) + (R[(2 * 20 + tile) * 64 + lane] + R[(3 * 20 + tile) * 64 + lane]);
                    f32x4 it = (f32x4){0.f, 0.f, 0.f, 0.f};
#pragma unroll
                    for (int ks = 0; ks < 2; ++ks) { const bf16x8 vb = (x < 2) ? *(const LAS bf16x8*)(sV + (16 * et + lr) * 72 + 32 * ks + 8 * lq) : ones;
                        it = __builtin_amdgcn_mfma_f32_16x16x32_bf16(sa[ks], vb, it, 0, 0, 0); }
                    num[x] = wi * inter + it; }
                f32x4 den;
#pragma unroll
                for (int i = 0; i < 4; ++i) den[i] = fmaxf(fabsf(lane_read(num[2][i], lane & 48)), fl[i]);
#pragma unroll
                for (int x = 0; x < 2; ++x) { const int et = 2 * eh + x;
#pragma unroll
                    for (int i = 0; i < 4; ++i) { const float hv = num[x][i] * __builtin_amdgcn_rcpf(den[i]);
                        sH[(16 * jt + 4 * lq + i) * 72 + 16 * et + lr] = (bf16_t)(cvt_pk_bf16(hv, 0.f) & 0xffffu); } }
            }
            SCAN_LOAD_Q0(t0n)
            {
                const float wd = __expf(cMP[cc] - cM63[cc]);
#pragma unroll
                for (int dt = 0; dt < 4; ++dt)
#pragma unroll
                    for (int et = 0; et < 5; ++et) C[dt][et] = C[dt][et] * wd;
#pragma unroll
                for (int ks = 0; ks < 2; ++ks) {
#pragma unroll
                    for (int et = 0; et < 4; ++et) { const bf16x8 vwb = *(const LAS bf16x8*)(sVW + (16 * et + lr) * 72 + 32 * ks + 8 * lq);
#pragma unroll
                        for (int dt = 0; dt < 4; ++dt) C[dt][et] = __builtin_amdgcn_mfma_f32_16x16x32_bf16(ka[dt][ks], vwb, C[dt][et], 0, 0, 0); }
                    const f32x4 w0 = *(const LAS f32x4*)(tabWS + 32 * ks + 8 * lq), w1 = *(const LAS f32x4*)(tabWS + 32 * ks + 8 * lq + 4);
                    u32x4 wp; wp.x = cvt_pk_bf16(w0[0], w0[1]); wp.y = cvt_pk_bf16(w0[2], w0[3]); wp.z = cvt_pk_bf16(w1[0], w1[1]); wp.w = cvt_pk_bf16(w1[2], w1[3]);
                    if (lr != 0) { wp.x = 0u; wp.y = 0u; wp.z = 0u; wp.w = 0u; }
                    const bf16x8 wb = __builtin_bit_cast(bf16x8, wp);
#pragma unroll
                    for (int dt = 0; dt < 4; ++dt) C[dt][4] = __builtin_amdgcn_mfma_f32_16x16x32_bf16(ka[dt][ks], wb, C[dt][4], 0, 0, 0);
                }
            }
            __syncthreads();
            { const int hr = tid >> 3, hc = (tid & 7) * 8; const u32x4 hv4 = *(const LAS u32x4*)(sH + hr * 72 + hc);
              unsigned ho_ = (unsigned)(hr * 6144 + hc) * 2u; asm volatile("" : "+v"(ho_));
              *(u32x4*)((char*)hout + (size_t)t0 * 12288 + ho_) = hv4; }
        }
    }
}

__device__ __forceinline__ void run_in_gemm(LAS unsigned char* lds, int j, bool conv, int coff, int g, int buf, int wv) {
    const Params P = load_params(); unsigned char* ws = P.ws;
    if (conv) {
        PhConvFused ph; ph.K = DM; ph.lda = DM; ph.ldb = DM; ph.nM = MT; ph.nN = 32; ph.coff = coff; ph.A = (const bf16_t*)(ws + (buf ? WS_HX2 : WS_HX)); ph.B = (const bf16_t*)(ws + WS_CWIN) + (size_t)j * 8192 * DM;
        ph.BIG = (bf16_t*)(ws + WS_BIG); ph.Y = (bf16_t*)(ws + ((g & 1) ? WS_KT : WS_VT)); ph.cw = P.conv_w + (size_t)j * 3 * DI;
        gemm_phase(lds, ph, wv);
    } else {
        PhPlain ph; ph.K = DM; ph.lda = DM; ph.ldb = DM; ph.nM = MT; ph.coff = coff; ph.A = (const bf16_t*)(ws + (buf ? WS_HX2 : WS_HX)); ph.O = (bf16_t*)(ws + WS_BIG);
        ph.nN = 24; ph.B = (const bf16_t*)(ws + WS_MWIN) + (size_t)j * 6144 * DM; ph.ldc = 6144;
        gemm_phase(lds, ph, wv);
    }
}
__device__ __forceinline__ void run_out_gemm(LAS unsigned char* lds, int layer, int g, int wv) {
    const Params P = load_params(); unsigned char* ws = P.ws; const int j = layer >> 1;
    PhResid ph; ph.K = DI; ph.lda = DI; ph.ldb = DI; ph.nM = MT; ph.nN = 4; ph.coff = 0; ph.A = (const bf16_t*)(ws + (((layer & 1) || (g & 1)) ? WS_KT : WS_VT));
    ph.B = ((layer & 1) ? (const bf16_t*)(ws + WS_MWOUT) : (const bf16_t*)(ws + WS_CWOUT)) + (size_t)j * DM * DI;
    ph.xin_x = (layer == 0) ? P.x : P.out; ph.xin_c = (layer == 0) ? P.ctx : (const float*)(ws + WS_XC); ph.xout_x = P.out; ph.xout_c = (float*)(ws + WS_XC);
    ph.mod = (const float*)(ws + WS_MOD) + (size_t)layer * 17 * 3072; ph.g = g;
    gemm_phase(lds, ph, wv);
}
__device__ __forceinline__ void run_qkv_nat(LAS unsigned char* lds, int j, bool isv, int wv) {
    const Params P = load_params(); unsigned char* ws = P.ws;
    PhQKV ph; ph.K = DH; ph.ldb = DH; ph.nM = MT; ph.W = (const bf16_t*)(ws + WS_MWQKV) + (size_t)j * 3 * 4 * DH * DH; ph.O = (bf16_t*)(ws + WS_QKV);
    if (!isv) { ph.lda = DI; ph.nN = 16; ph.coff = 0; ph.A = (const bf16_t*)(ws + WS_UC); ph.which0 = 0; }
    else { ph.lda = 6144; ph.nN = 8; ph.coff = 256 - 64; ph.A = (const bf16_t*)(ws + WS_BIG); ph.which0 = 2; }
    gemm_phase(lds, ph, wv);
}
__device__ __forceinline__ void run_tr(LAS unsigned char* lds, int j, bool isv, int wv) {
    const Params P = load_params(); unsigned char* ws = P.ws;
    PhTr ph; ph.K = DH; ph.lda = DH; ph.nM = 8; ph.nN = MT;
    const bf16_t* WQKV = (const bf16_t*)(ws + WS_MWQKV) + (size_t)j * 3 * 4 * DH * DH;
    if (!isv) { ph.ldb = DI; ph.coff = 192; ph.W = WQKV + (size_t)1 * 4 * DH * DH; ph.Act = (const bf16_t*)(ws + WS_UC); ph.OT = (bf16_t*)(ws + WS_KT); ph.scale = 0.044194173824159216f; }
    else { ph.ldb = 6144; ph.coff = 160; ph.W = WQKV + (size_t)2 * 4 * DH * DH; ph.Act = (const bf16_t*)(ws + WS_BIG); ph.OT = (bf16_t*)(ws + WS_VT); ph.scale = 1.f; }
    gemm_phase(lds, ph, wv);
}
__device__ __forceinline__ void run_qk(LAS unsigned char* lds, int wv) {
    const Params P = load_params(); unsigned char* ws = P.ws;
    PhQK ph; ph.K = DH; ph.lda = 6144; ph.ldb = 6144; ph.nM = GB * NH * 9; ph.nN = 1; ph.coff = 0; ph.QKV = (const bf16_t*)(ws + WS_QKV); ph.QKR = (float*)(ws + WS_QKR);
    gemm_phase(lds, ph, wv);
}
__device__ __forceinline__ void run_gates(LAS unsigned char* lds, int j, int part, int wv) {
    const Params P = load_params(); unsigned char* ws = P.ws;
    PhGates ph; ph.K = 512; ph.ldb = 2048; ph.nM = MT; ph.nN = 4; ph.poff = 4 * part;
    if (part == 0) { ph.A = (const bf16_t*)(ws + WS_UC); ph.lda = DI; ph.coff = 128; } else { ph.A = (const bf16_t*)(ws + WS_BIG); ph.lda = 6144; ph.coff = 144; }
    ph.WG = (const bf16_t*)(ws + WS_MWG) + (size_t)(j * 2 + part) * 256 * 2048; ph.GATESP = (float*)(ws + WS_GATESP);
    gemm_phase(lds, ph, wv);
}

#define XB_TMO      128
#define XB_XCNT(j)  (256  + 64 * (j))
#define XB_XSUB(j)  (1280 + 64 * (j))
#define XB_XGEN(j)  (2304 + 64 * (j))
#define XB_TOP      3328
#define XB_TOPGEN   3392
#define XCD_BAR_WORDS 3456
#define XB_SPIN_CAP (1u << 22)
__device__ __forceinline__ unsigned xb_ld(unsigned* p)              { return __hip_atomic_load(p, __ATOMIC_RELAXED, __HIP_MEMORY_SCOPE_AGENT); }
__device__ __forceinline__ unsigned xb_add(unsigned* p, unsigned v) { return __hip_atomic_fetch_add(p, v, __ATOMIC_RELAXED, __HIP_MEMORY_SCOPE_AGENT); }
__device__ __forceinline__ unsigned xb_xcc_id() { return (unsigned)__builtin_amdgcn_s_getreg((3 << 11) | 20) & 0xFu; }
#define XB_SPIN(cond, bar) do { unsigned _sp = 0; while (cond) { __builtin_amdgcn_s_sleep(1); \
    if ((++_sp & 255u) == 0u) { if (xb_ld(&(bar)[XB_TMO])) break; if (_sp > XB_SPIN_CAP) { atomicAdd(&(bar)[XB_TMO], 1u); break; } } } } while (0)
struct XcdBarrier { unsigned* bar; unsigned x; volatile LAS unsigned* st; };
__device__ __forceinline__ XcdBarrier xcd_barrier_post(unsigned* bar, volatile LAS unsigned* st) {
    XcdBarrier b; b.bar = bar; b.x = xb_xcc_id(); b.st = st;
    if (threadIdx.x == 0) (void)xb_add(&bar[XB_XCNT(b.x)], 1u);
    return b;
}
__device__ __forceinline__ void xcd_barrier_complete(unsigned* bar, unsigned x, unsigned& nloc, unsigned& nx) {
    const unsigned G = gridDim.x * gridDim.y * gridDim.z;
    unsigned sum, cnt, mine, sp = 0u;
    for (;;) {
        sum = 0u; cnt = 0u; mine = 0u;
#pragma unroll
        for (unsigned j = 0; j < 16; ++j) { const unsigned c = xb_ld(&bar[XB_XCNT(j)]); sum += c; cnt += (c > 0u) ? 1u : 0u; mine = (j == x) ? c : mine; }
        if (sum == G) break;
        __builtin_amdgcn_s_sleep(1);
        if ((++sp & 255u) == 0u) { if (xb_ld(&bar[XB_TMO])) break; if (sp > XB_SPIN_CAP) { atomicAdd(&bar[XB_TMO], 1u); break; } }
    }
    nloc = mine > 0u ? mine : 1u; nx = cnt > 0u ? cnt : 1u;
}
__device__ __forceinline__ void xcd_barrier(const XcdBarrier& b, int wv) {
    asm volatile("s_waitcnt vmcnt(0)" ::: "memory");
    __syncthreads();
    if (opaque_tid(wv) == 0) {
        unsigned* bar = b.bar;
        __builtin_amdgcn_s_waitcnt(0);
        unsigned nloc = b.st[0], nx = b.st[1];
        if (nloc == 0u) { xcd_barrier_complete(bar, b.x, nloc, nx); b.st[0] = nloc; b.st[1] = nx; }
        const unsigned old = xb_add(&bar[XB_XSUB(b.x)], 1u);
        const unsigned gen = old / nloc;
        if (old + 1u == (gen + 1u) * nloc) {
            __builtin_amdgcn_fence(__ATOMIC_RELEASE, "agent");
            asm volatile("s_waitcnt vmcnt(0)" ::: "memory");
            const unsigned og = xb_add(&bar[XB_TOP], 1u);
            const unsigned tg = og / nx;
            if (og + 1u == (tg + 1u) * nx) xb_add(&bar[XB_TOPGEN], 1u);
            else XB_SPIN(xb_ld(&bar[XB_TOPGEN]) == tg, bar);
            __builtin_amdgcn_fence(__ATOMIC_ACQUIRE, "agent");
            xb_add(&bar[XB_XGEN(b.x)], 1u);
            asm volatile("s_waitcnt vmcnt(0)" ::: "memory");
        } else {
            XB_SPIN(xb_ld(&bar[XB_XGEN(b.x)]) == gen, bar);
            __builtin_amdgcn_fence(__ATOMIC_ACQUIRE, "agent");
            asm volatile("s_waitcnt vmcnt(0)" ::: "memory");
        }
    }
    __syncthreads();
}

__global__ void __launch_bounds__(512, 2) hybrid_fwd(Params Punused) {
    extern __shared__ __attribute__((aligned(16))) unsigned char lds_raw[];
    LAS unsigned char* lds = (LAS unsigned char*)lds_raw;
    cg::grid_group grid = cg::this_grid();
    const int wv = __builtin_amdgcn_readfirstlane((int)(threadIdx.x >> 6));
    volatile LAS unsigned* bst = (volatile LAS unsigned*)(lds + LDS_BST);
    if (threadIdx.x < 4) bst[threadIdx.x] = 0u;
    __syncthreads();
    { const Params P0 = load_params(); (void)xcd_barrier_post((unsigned*)(P0.ws + WS_BAR), bst); }
#define GSYNC() do { const Params Pb = load_params(); XcdBarrier xb_; xb_.bar = (unsigned*)(Pb.ws + WS_BAR); xb_.x = xb_xcc_id(); xb_.st = (volatile LAS unsigned*)(lds + LDS_BST); xcd_barrier(xb_, wv); } while (0)
    phase_prep(lds, wv);
    grid.sync();
    phase_modreduce(wv);
    GSYNC();
    phase_modulate(0, 0, 0, false, wv);
    GSYNC();
    run_in_gemm(lds, 0, true, 0, 0, 0, wv);
    phase_modulate(0, 1, 1, true, wv);
    GSYNC();
    for (int st = 0; st < 16; ++st) {
        const int layer = st >> 2, g = st & 3, j = st >> 3, nst = st + 1;
        if ((layer & 1) == 0) {
            phase_convmix(j, g, wv);
            GSYNC();
        } else {
            phase_uc(j, wv);
            GSYNC();
            run_qkv_nat(lds, j, false, wv); run_tr(lds, j, false, wv); run_tr(lds, j, true, wv); run_gates(lds, j, 0, wv); run_gates(lds, j, 1, wv);
            GSYNC();
            run_qk(lds, wv); phase_gatetab(lds, j, wv);
            GSYNC();
            phase_scan(lds, j, wv);
            GSYNC();
            phase_gating(j, wv);
            GSYNC();
        }
        run_out_gemm(lds, layer, g, wv);
        if (nst < 16) run_in_gemm(lds, nst >> 3, ((nst >> 2) & 1) == 0, 256 - 144, nst & 3, nst & 1, wv);
        if (st == 15) phase_final(0, 3 * GB * SEQ, true, wv);
        if (st + 2 < 16) phase_modulate((st + 2) >> 2, (st + 2) & 3, st & 1, true, wv);
        GSYNC();
    }
    phase_final(3 * GB * SEQ, NB * SEQ, false, wv);
}

extern "C" void kernel_launch(void* const* d_in, const int* in_sizes, int n_in, void* d_out, int out_size, void* d_ws, size_t ws_size, hipStream_t stream) {
    static int grid_blocks = 0;
    if (grid_blocks == 0) {
        if (n_in != 21 || out_size != NB * SEQ * DM || ws_size < WS_END) { fprintf(stderr, "kernel_launch: unexpected shapes (n_in %d out %d ws %zu)\n", n_in, out_size, ws_size); grid_blocks = -1; return; }
        int dev = 0, cus = 0, per_cu = 0;
        if (hipGetDevice(&dev) != hipSuccess || hipDeviceGetAttribute(&cus, hipDeviceAttributeMultiprocessorCount, dev) != hipSuccess) { grid_blocks = -1; return; }
        if (hipFuncSetAttribute((const void*)hybrid_fwd, hipFuncAttributeMaxDynamicSharedMemorySize, LDS_BYTES) != hipSuccess) { fprintf(stderr, "kernel_launch: hipFuncSetAttribute failed\n"); grid_blocks = -1; return; }
        if (hipOccupancyMaxActiveBlocksPerMultiprocessor(&per_cu, (const void*)hybrid_fwd, 512, LDS_BYTES) != hipSuccess || per_cu < 1) { fprintf(stderr, "kernel_launch: occupancy query says %d\n", per_cu); per_cu = 1; }
        (void)hipGetLastError();
        grid_blocks = cus;
    }
    if (grid_blocks < 0) return;
    if (hipMemsetAsync((char*)d_ws + WS_BAR, 0, XCD_BAR_WORDS * sizeof(unsigned), stream) != hipSuccess) { fprintf(stderr, "kernel_launch: memset of the barrier words failed\n"); return; }
    Params p{};
    const float** pp = (const float**)&p;
    for (int i = 0; i < 21; ++i) pp[i] = (const float*)d_in[i];
    p.out = (float*)d_out; p.ws = (unsigned char*)d_ws;
    void* args[] = {&p};
    hipError_t e = hipLaunchCooperativeKernel((const void*)hybrid_fwd, dim3(grid_blocks), dim3(512), args, LDS_BYTES, stream);
    if (e != hipSuccess) fprintf(stderr, "cooperative launch failed: %s (grid %d)\n", hipGetErrorString(e), grid_blocks);
}
```

```cpp
#include <hip/hip_runtime.h>
#include <hip/hip_cooperative_groups.h>
#include <cstdio>
namespace cg = cooperative_groups;

#define LAS __attribute__((address_space(3)))
typedef unsigned short bf16_t;
typedef short bf16x8 __attribute__((ext_vector_type(8)));
typedef float f32x4 __attribute__((ext_vector_type(4)));
typedef unsigned u32x4 __attribute__((ext_vector_type(4)));
typedef unsigned u32x2 __attribute__((ext_vector_type(2)));

constexpr int DM = 1024, DI = 2048, NB = 16, SEQ = 2048, CTXL = 256, TT = 2304  , NH = 4, DH = 512;
constexpr int GB = 4  , RG = GB * TT  , MT = RG / 256  ;
constexpr float EPSV = 1e-6f;
constexpr size_t MIB = 1ull << 20;
constexpr size_t WS_CWIN = 0, WS_CWOUT = 32 * MIB, WS_MWIN = 40 * MIB, WS_MWQKV = 64 * MIB, WS_MWOUT = 76 * MIB, WS_MWG = 84 * MIB,
                 WS_MODP = 90 * MIB, WS_MOD = 97 * MIB, WS_XC = 98 * MIB, WS_HX = 114 * MIB, WS_BIG = 132 * MIB, WS_UC = WS_BIG + 108 * MIB,
                 WS_QKV = 276 * MIB, WS_KT = 384 * MIB, WS_VT = 420 * MIB, WS_QKR = 456 * MIB, WS_GATES = 465 * MIB, WS_BAR = 466 * MIB, WS_GATESP = 468 * MIB  , WS_HX2 = 474 * MIB  , WS_GTAB = 492 * MIB  , WS_END = 493 * MIB;
constexpr int LDS_BST = 148480;
constexpr int LDS_BYTES = LDS_BST + 16;

struct Params {
    const float *x, *c, *ctx, *c_ctx, *norm_g, *mod_w, *mod_b, *conv_w_in, *conv_w, *conv_w_out, *m_w_in, *m_conv_w, *m_wq, *m_wk, *m_wv,
        *m_w_gate, *m_b_gate, *m_norm_g, *m_skip, *m_w_out, *final_g;
    float* out; unsigned char* ws;
};

__device__ __forceinline__ unsigned cvt_pk_bf16(float lo, float hi) { unsigned r; asm volatile("v_cvt_pk_bf16_f32 %0, %1, %2" : "=v"(r) : "v"(lo), "v"(hi)); return r; }
__device__ __forceinline__ float bf_lo(unsigned w) { return __uint_as_float(w << 16); }
__device__ __forceinline__ float bf_hi(unsigned w) { return __uint_as_float(w & 0xffff0000u); }
__device__ __forceinline__ void unpack8(u32x4 v, float* f) { f[0] = bf_lo(v.x); f[1] = bf_hi(v.x); f[2] = bf_lo(v.y); f[3] = bf_hi(v.y); f[4] = bf_lo(v.z); f[5] = bf_hi(v.z); f[6] = bf_lo(v.w); f[7] = bf_hi(v.w); }
__device__ __forceinline__ u32x4 pack8(const float* f) { u32x4 o; o.x = cvt_pk_bf16(f[0], f[1]); o.y = cvt_pk_bf16(f[2], f[3]); o.z = cvt_pk_bf16(f[4], f[5]); o.w = cvt_pk_bf16(f[6], f[7]); return o; }
__device__ __forceinline__ float silu_f(float v) { return v * __builtin_amdgcn_rcpf(1.f + __expf(-v)); }
__device__ __forceinline__ float sigmoid_f(float v) { return __builtin_amdgcn_rcpf(1.f + __expf(-v)); }
__device__ __forceinline__ float lane_read(float v, int srclane) { return __int_as_float(__builtin_amdgcn_ds_bpermute(srclane << 2, __float_as_int(v))); }
__device__ __forceinline__ float wave_sum(float v, int lane) {
    (void)lane;
#define DPPS(x, ctrl, rmask) __int_as_float(__builtin_amdgcn_update_dpp(0, __float_as_int(x), ctrl, rmask, 0xf, false))
    v += DPPS(v, 0x111, 0xf); v += DPPS(v, 0x112, 0xf); v += DPPS(v, 0x114, 0xf); v += DPPS(v, 0x118, 0xf);
    v += DPPS(v, 0x142, 0xa); v += DPPS(v, 0x143, 0xc);
#undef DPPS
    return __int_as_float(__builtin_amdgcn_readlane(__float_as_int(v), 63));
}
#define LDS_WAIT() asm volatile("s_waitcnt lgkmcnt(0)" ::: "memory")
template <class T> __device__ __forceinline__ T* opq(T* p) { return p; }
#define CAS __attribute__((address_space(4)))
#define GAS __attribute__((address_space(1)))
__device__ __forceinline__ Params load_params() {
    int z = 0; asm volatile("" : "+s"(z));
    const CAS unsigned long long* kp = (const CAS unsigned long long*)((const CAS char*)__builtin_amdgcn_kernarg_segment_ptr() + z);
    Params r;
#define LP_F(i, name) r.name = (const float*)(const GAS float*)kp[i];
    LP_F(0, x) LP_F(1, c) LP_F(2, ctx) LP_F(3, c_ctx) LP_F(4, norm_g) LP_F(5, mod_w) LP_F(6, mod_b) LP_F(7, conv_w_in) LP_F(8, conv_w) LP_F(9, conv_w_out) LP_F(10, m_w_in)
    LP_F(11, m_conv_w) LP_F(12, m_wq) LP_F(13, m_wk) LP_F(14, m_wv) LP_F(15, m_w_gate) LP_F(16, m_b_gate) LP_F(17, m_norm_g) LP_F(18, m_skip) LP_F(19, m_w_out) LP_F(20, final_g)
#undef LP_F
    r.out = (float*)(GAS float*)kp[21]; r.ws = (unsigned char*)(GAS unsigned char*)kp[22];
    return r;
}
__device__ __forceinline__ int opaque_tid(int wv) {
    int ln; asm volatile("v_mbcnt_lo_u32_b32 %0, -1, 0\n\tv_mbcnt_hi_u32_b32 %0, -1, %0" : "=&v"(ln)); return wv * 64 + ln; }

constexpr int BM = 256, BK = 64, HALF = 128, HTB = HALF * BK * 2, NXCD = 8, WGM = 8;
__device__ __forceinline__ int lds_byte(int r, int c) { const int st = (r >> 4) * 2 + (c >> 5), rr = r & 15, cc = c & 31, ob = rr * 64 + cc * 2; return st * 1024 + (ob ^ (((ob >> 9) & 1) << 5)); }
__device__ __forceinline__ void stage_rc(int b, int& R, int& C) { const int st = b / 1024, sb = b % 1024, swz = sb ^ (((sb >> 9) & 1) << 5); R = (st >> 1) * 16 + swz / 64; C = (st & 1) * 32 + (swz % 64) / 2; }
__device__ __forceinline__ int perm32(int rho) { const int n = rho >> 4, i = rho & 15; return 8 * (i >> 2) + 4 * n + (i & 3); }
__device__ __forceinline__ int qperm32(int p) { const int q = p >> 3, jj = p & 7; return jj < 4 ? 4 * q + jj : 16 + 4 * q + (jj - 4); }
struct Unit { int pm, pn; };
__device__ __forceinline__ bool tile_next(int i, int G, int c, int nM, int nN, Unit& u, int tailc = 0) {
    const int nwg = nM * nN; long L = (long)i * G + c;
    if (tailc > 0) { const int fr_ = nwg / G, full = fr_ * G, rem = nwg - full;
        if (i >= fr_) { const int k = i - fr_; if (k == 0) { if (c >= tailc) return false; L = full + c; } else if (k == 1) { if (c >= rem - tailc) return false; L = full + tailc + c; } else return false; } }
    if (L >= nwg) return false;
    int wgid = (int)L; { const int q = nwg / NXCD, r = nwg % NXCD, xcd = wgid % NXCD, off = wgid / NXCD; wgid = (xcd < r ? xcd * (q + 1) : r * (q + 1) + (xcd - r) * q) + off; }
    const int nig = WGM * nN, gid = wgid / nig, fm = gid * WGM, gsz = (nM - fm) < WGM ? (nM - fm) : WGM;
    u.pm = fm + ((wgid % nig) % gsz); u.pn = (wgid % nig) / gsz; return true;
}

__device__ __forceinline__ void store_bf16_tile(const f32x4 (&acc)[2][2][4][2], bf16_t* base, size_t ldc, float scale, int wr, int wc, int fr, int fq) {
    bf16_t* p0 = base + (size_t)(wr * 64 + fr) * ldc + wc * 32 + 8 * fq;
#pragma unroll
    for (int ai = 0; ai < 2; ++ai)
#pragma unroll
        for (int m = 0; m < 4; ++m) { bf16_t* rowp = p0 + (size_t)(ai * HALF + m * 16) * ldc;
#pragma unroll
            for (int bj = 0; bj < 2; ++bj) { const f32x4 v0 = acc[ai][bj][m][0] * scale, v1 = acc[ai][bj][m][1] * scale;
                u32x4 w; w.x = cvt_pk_bf16(v0[0], v0[1]); w.y = cvt_pk_bf16(v0[2], v0[3]); w.z = cvt_pk_bf16(v1[0], v1[1]); w.w = cvt_pk_bf16(v1[2], v1[3]);
                *(u32x4*)(rowp + bj * HALF) = w; } }
}

template <class PH>
__device__ __forceinline__ void gemm_phase(LAS unsigned char* lds, const PH& S, int wv) {
    const int tid = opaque_tid(wv);
    const int wid = __builtin_amdgcn_readfirstlane(tid >> 6), lane = tid & 63, wr = wid >> 2, wc = wid & 3, fr = lane & 15, fq = lane >> 4;
    const int K = S.K, nt = K / BK;
    const int G = gridDim.x, cblk = (int)((blockIdx.x + (unsigned)S.coff) % gridDim.x);
    unsigned voffA[2], voffB[2];
#pragma unroll
    for (int i = 0; i < 2; ++i) { int R, C; stage_rc(tid * 16 + i * 8192, R, C); const int Rb = PH::PERM ? ((R & ~31) + perm32(R & 31)) : R;
        const int Rs = PH::QPERM ? ((Rb & ~31) + qperm32(Rb & 31)) : Rb;
        voffA[i] = (unsigned)(R * S.lda + C) * 2u; voffB[i] = (unsigned)(Rs * S.ldb + C) * 2u; }
    const size_t kstep = (size_t)(BK * 2);
    const size_t hstepA = (size_t)HALF * S.lda * 2, hstepB = (size_t)HALF * S.ldb * 2;
    const unsigned ldsw = (unsigned)wid * 1024u;
    const int aoff = lds_byte(wr * 64 + fr, fq * 8), boff = lds_byte(wc * 32 + fr, fq * 8);
#define PG8_SA(b, h) (((b) * 2 + (h)) * HTB)
#define PG8_SB(b, h) ((4 + (b) * 2 + (h)) * HTB)
#define PG8_STAGE(bufoff, gbase, voff) do { _Pragma("unroll") for (int _i = 0; _i < 2; ++_i) \
        __builtin_amdgcn_global_load_lds((const unsigned*)((const char*)(gbase) + (voff)[_i]), (LAS unsigned*)(lds + (bufoff) + ldsw + _i * 8192), 16, 0, 0); } while (0)
#define PG8_LDA(dst, b, h) do { _Pragma("unroll") for (int m = 0; m < 4; ++m) _Pragma("unroll") for (int k = 0; k < 2; ++k) dst[m][k] = *(const LAS bf16x8*)(lds + PG8_SA(b, h) + aoff + m * 2048 + k * 1024); } while (0)
#define PG8_LDB(dst, b, h) do { _Pragma("unroll") for (int n = 0; n < 2; ++n) _Pragma("unroll") for (int k = 0; k < 2; ++k) dst[n][k] = *(const LAS bf16x8*)(lds + PG8_SB(b, h) + boff + n * 2048 + k * 1024); } while (0)
#define PG8_MMA(ai, bj, At, Bt) do { __builtin_amdgcn_s_setprio(1); _Pragma("unroll") for (int m = 0; m < 4; ++m) _Pragma("unroll") for (int n = 0; n < 2; ++n) _Pragma("unroll") for (int k = 0; k < 2; ++k) \
        acc[ai][bj][m][n] = __builtin_amdgcn_mfma_f32_16x16x32_bf16(Bt[n][k], At[m][k], acc[ai][bj][m][n], 0, 0, 0); __builtin_amdgcn_s_setprio(0); } while (0)
#define PG8_WAIT_V(n) asm volatile("s_waitcnt vmcnt(" #n ")" ::: "memory")
#define PG8_WAIT_L(n) asm volatile("s_waitcnt lgkmcnt(" #n ")" ::: "memory")
#define PG8_BAR __builtin_amdgcn_s_barrier()
#define PG8_SCHED __builtin_amdgcn_sched_barrier(0)
    Unit cur, nxt; int ui = 0;
    if (!tile_next(0, G, cblk, S.nM, S.nN, cur, S.coff != 0 ? PH::TAILC : 0)) return;
    f32x4 acc[2][2][4][2];
#pragma unroll
    for (int a = 0; a < 2; ++a)
#pragma unroll
        for (int b = 0; b < 2; ++b)
#pragma unroll
            for (int m = 0; m < 4; ++m)
#pragma unroll
                for (int n = 0; n < 2; ++n) acc[a][b][m][n] = (f32x4){0.f, 0.f, 0.f, 0.f};
    bf16x8 At[4][2], B0[2][2], B1[2][2];
    const char* cA = S.aptr(cur); const char* cB = S.bptr(cur);
    PG8_STAGE(PG8_SB(0, 0), cB, voffB); PG8_STAGE(PG8_SA(0, 0), cA, voffA); PG8_STAGE(PG8_SB(0, 1), cB + hstepB, voffB); PG8_STAGE(PG8_SA(0, 1), cA + hstepA, voffA);
    if (wr == 1) PG8_BAR;
    PG8_WAIT_V(4); PG8_BAR;
    PG8_STAGE(PG8_SB(1, 0), cB + kstep, voffB); PG8_STAGE(PG8_SA(1, 0), cA + kstep, voffA); PG8_STAGE(PG8_SB(1, 1), cB + hstepB + kstep, voffB);
    PG8_WAIT_V(6); PG8_BAR;
    for (;;) {
        const bool has_next = tile_next(ui + 1, G, cblk, S.nM, S.nN, nxt, S.coff != 0 ? PH::TAILC : 0);
        const char* nA = has_next ? S.aptr(nxt) : cA; const char* nB = has_next ? S.bptr(nxt) : cB;
        for (int t = 0; t < nt; t += 2) {
            const bool last = (t == nt - 2);
            const char* a1 = cA + (size_t)(t + 1) * kstep;
            const char* a2 = last ? nA : cA + (size_t)(t + 2) * kstep; const char* b2 = last ? nB : cB + (size_t)(t + 2) * kstep;
            const char* a3 = a2 + kstep; const char* b3 = b2 + kstep;
            PG8_LDB(B0, 0, 0); PG8_SCHED; PG8_LDA(At, 0, 0); PG8_STAGE(PG8_SA(1, 1), a1 + hstepA, voffA);
            PG8_WAIT_L(8); PG8_BAR; PG8_WAIT_L(0); PG8_MMA(0, 0, At, B0); PG8_BAR; PG8_SCHED;
            PG8_LDB(B1, 0, 1); PG8_STAGE(PG8_SB(0, 0), b2, voffB);
            PG8_BAR; PG8_WAIT_L(0); PG8_MMA(0, 1, At, B1); PG8_BAR;
            PG8_LDA(At, 0, 1); PG8_STAGE(PG8_SA(0, 0), a2, voffA);
            PG8_BAR; PG8_WAIT_L(0); PG8_MMA(1, 0, At, B0); PG8_BAR; PG8_SCHED;
            PG8_STAGE(PG8_SB(0, 1), b2 + hstepB, voffB);
            PG8_WAIT_V(6); PG8_BAR; PG8_MMA(1, 1, At, B1); PG8_BAR;
            PG8_LDB(B0, 1, 0); PG8_SCHED; PG8_LDA(At, 1, 0); PG8_STAGE(PG8_SA(0, 1), a2 + hstepA, voffA);
            PG8_WAIT_L(8); PG8_BAR; PG8_WAIT_L(0); PG8_MMA(0, 0, At, B0); PG8_BAR; PG8_SCHED;
            PG8_LDB(B1, 1, 1); PG8_STAGE(PG8_SB(1, 0), b3, voffB);
            PG8_BAR; PG8_WAIT_L(0); PG8_MMA(0, 1, At, B1); PG8_BAR;
            PG8_LDA(At, 1, 1); PG8_STAGE(PG8_SA(1, 0), a3, voffA);
            PG8_BAR; PG8_WAIT_L(0); PG8_MMA(1, 0, At, B0); PG8_BAR; PG8_SCHED;
            PG8_STAGE(PG8_SB(1, 1), b3 + hstepB, voffB);
            PG8_WAIT_V(6); PG8_BAR; PG8_MMA(1, 1, At, B1); PG8_BAR;
        }
        S.epi(acc, cur, wr, wc, fr, fq);
        if (!has_next) break;
#pragma unroll
        for (int a = 0; a < 2; ++a)
#pragma unroll
            for (int b = 0; b < 2; ++b)
#pragma unroll
                for (int m = 0; m < 4; ++m)
#pragma unroll
                    for (int n = 0; n < 2; ++n) acc[a][b][m][n] = (f32x4){0.f, 0.f, 0.f, 0.f};
        cur = nxt; cA = nA; cB = nB; ++ui;
    }
    PG8_WAIT_V(0);
    if (wr == 0) PG8_BAR;
    PG8_BAR;
#undef PG8_SA
#undef PG8_SB
#undef PG8_STAGE
#undef PG8_LDA
#undef PG8_LDB
#undef PG8_MMA
#undef PG8_WAIT_V
#undef PG8_WAIT_L
#undef PG8_BAR
#undef PG8_SCHED
}

struct PhPlain {
    static constexpr bool PERM = true; static constexpr int TAILC = 0; static constexpr bool QPERM = false;
    int K, lda, ldb, nM, nN, coff; const bf16_t *A, *B; bf16_t* O; int ldc;
    __device__ __forceinline__ const char* aptr(const Unit& u) const { return (const char*)(A + (size_t)u.pm * 256 * lda); }
    __device__ __forceinline__ const char* bptr(const Unit& u) const { return (const char*)(B + (size_t)u.pn * 256 * ldb); }
    __device__ __forceinline__ void epi(const f32x4 (&acc)[2][2][4][2], const Unit& u, int wr, int wc, int fr, int fq) const {
        store_bf16_tile(acc, O + (size_t)u.pm * 256 * ldc + (size_t)u.pn * 256, (size_t)ldc, 1.f, wr, wc, fr, fq);
    }
};
#define DPP4(dst, src, ctrl) { _Pragma("unroll") for (int i_ = 0; i_ < 4; ++i_) dst[i_] = __int_as_float(__builtin_amdgcn_update_dpp(0, __float_as_int(src[i_]), ctrl, 0xf, 0xf, false)); }
struct PhConvFused {
    static constexpr bool PERM = true; static constexpr int TAILC = 112; static constexpr bool QPERM = false;
    int K, lda, ldb, nM, nN, coff; const bf16_t *A, *B; bf16_t* BIG; bf16_t* Y; const float* cw;
    __device__ __forceinline__ const char* aptr(const Unit& u) const { return (const char*)(A + (size_t)u.pm * 256 * lda); }
    __device__ __forceinline__ const char* bptr(const Unit& u) const { return (const char*)(B + (size_t)u.pn * 256 * ldb); }
    __device__ __forceinline__ void epi(const f32x4 (&acc)[2][2][4][2], const Unit& u, int wr, int wc, int fr, int fq) const {
        const int jc = u.pn * 64 + 16 * wc + 4 * fq;
        if (u.pm % 9 == 0) {
#pragma unroll
            for (int ai = 0; ai < 2; ++ai)
#pragma unroll
                for (int m = 0; m < 4; ++m) { bf16_t* rowp = BIG + (size_t)(u.pm * 256 + ai * HALF + wr * 64 + m * 16 + fr) * 8192 + jc;
#pragma unroll
                    for (int bj = 0; bj < 2; ++bj)
#pragma unroll
                        for (int n = 0; n < 2; ++n) { const f32x4 v = acc[ai][bj][m][n]; u32x2 o; o.x = cvt_pk_bf16(v[0], v[1]); o.y = cvt_pk_bf16(v[2], v[3]);
                            *(u32x2*)(rowp + (2 * bj + n) * 2048) = o; } }
            return;
        }
        const f32x4 w0 = *(const f32x4*)(cw + jc), w1 = *(const f32x4*)(cw + DI + jc), w2 = *(const f32x4*)(cw + 2 * DI + jc);
#pragma unroll
        for (int ai = 0; ai < 2; ++ai) {
            f32x4 cu[4];
#pragma unroll
            for (int m = 0; m < 4; ++m) cu[m] = acc[ai][0][m][1] * acc[ai][1][m][0];
#pragma unroll
            for (int m = 0; m < 4; ++m) {
                f32x4 pv, nx, t;
                DPP4(pv, cu[m], 0x111)
                if (m > 0) { DPP4(t, cu[m - 1], 0x121) if (fr == 0) pv = t; }
                DPP4(nx, cu[m], 0x101)
                if (m < 3) { DPP4(t, cu[m + 1], 0x12F) if (fr == 15) nx = t; }
                const f32x4 bb = acc[ai][0][m][0], zz = acc[ai][1][m][1];
                f32x4 y;
#pragma unroll
                for (int i = 0; i < 4; ++i) y[i] = bb[i] * (w0[i] * pv[i] + w1[i] * cu[m][i] + w2[i] * nx[i]) * silu_f(zz[i]);
                u32x2 o; o.x = cvt_pk_bf16(y[0], y[1]); o.y = cvt_pk_bf16(y[2], y[3]);
                *(u32x2*)(Y + (size_t)(u.pm * 256 + ai * HALF + wr * 64 + m * 16 + fr) * DI + jc) = o;
            }
        }
    }
};
struct PhQKV {
    static constexpr bool PERM = true; static constexpr int TAILC = 0; static constexpr bool QPERM = true;
    int K, lda, ldb, nM, nN, coff; const bf16_t* A; const bf16_t* W  ; bf16_t* O; int which0;
    __device__ __forceinline__ const char* aptr(const Unit& u) const { const int h = (u.pn >> 1) & 3; return (const char*)(A + (size_t)u.pm * 256 * lda + h * 512); }
    __device__ __forceinline__ const char* bptr(const Unit& u) const { const int which = which0 + (u.pn >> 3), h = (u.pn >> 1) & 3, half = u.pn & 1;
        return (const char*)(W + ((size_t)(which * 4 + h) * 512 + half * 256) * 512); }
    __device__ __forceinline__ void epi(const f32x4 (&acc)[2][2][4][2], const Unit& u, int wr, int wc, int fr, int fq) const {
        const int which = which0 + (u.pn >> 3), h = (u.pn >> 1) & 3, half = u.pn & 1;
        store_bf16_tile(acc, O + (size_t)u.pm * 256 * 6144 + which * 2048 + h * 512 + half * 256, 6144, which == 1 ? 0.044194173824159216f : 1.f, wr, wc, fr, fq);
    }
};
struct PhTr {
    static constexpr bool PERM = true; static constexpr int TAILC = 0; static constexpr bool QPERM = false;
    int K, lda, ldb, nM, nN, coff; const bf16_t* W  ; const bf16_t* Act; bf16_t* OT; float scale; int frag;
    __device__ __forceinline__ const char* aptr(const Unit& u) const { const int h = u.pm >> 1, mh = u.pm & 1; return (const char*)(W + ((size_t)h * 512 + mh * 256) * 512); }
    __device__ __forceinline__ const char* bptr(const Unit& u) const { const int h = u.pm >> 1; return (const char*)(Act + (size_t)u.pn * 256 * ldb + h * 512); }
    __device__ __forceinline__ void epi(const f32x4 (&acc)[2][2][4][2], const Unit& u, int wr, int wc, int fr, int fq) const {
        const int h = u.pm >> 1, mh = u.pm & 1, bl = u.pn / 9, w = u.pn % 9;
        if (!frag) { store_bf16_tile(acc, OT + ((size_t)(bl * 4 + h) * 512 + mh * 256) * TT + w * 256, (size_t)TT, scale, wr, wc, fr, fq); return; }
        bf16_t* base = OT + (size_t)(bl * 4 + h) * 512 * TT;
#pragma unroll
        for (int ai = 0; ai < 2; ++ai)
#pragma unroll
            for (int m = 0; m < 4; ++m) { const int dt = mh * 16 + wr * 4 + ai * 8 + m;
#pragma unroll
                for (int bj = 0; bj < 2; ++bj) { const int c = w * 4 + 2 * bj + (wc >> 1), ks = wc & 1;
                    const f32x4 v0 = acc[ai][bj][m][0] * scale, v1 = acc[ai][bj][m][1] * scale;
                    u32x4 o; o.x = cvt_pk_bf16(v0[0], v0[1]); o.y = cvt_pk_bf16(v0[2], v0[3]); o.z = cvt_pk_bf16(v1[0], v1[1]); o.w = cvt_pk_bf16(v1[2], v1[3]);
                    *(u32x4*)(base + ((size_t)((c * 32 + dt) * 2 + ks) * 64 + fq * 16 + fr) * 8) = o; } }
    }
};
struct PhQK {
    static constexpr bool PERM = false; static constexpr int TAILC = 0; static constexpr bool QPERM = false;
    int K, lda, ldb, nM, nN, coff; const bf16_t* QKV; float* QKR;
    __device__ __forceinline__ const char* aptr(const Unit& u) const { const int bl = u.pm / 36, h = (u.pm / 9) & 3, w = u.pm % 9; return (const char*)(QKV + (size_t)(bl * TT + w * 256) * 6144 + h * 512); }
    __device__ __forceinline__ const char* bptr(const Unit& u) const { const int bl = u.pm / 36, h = (u.pm / 9) & 3, w = u.pm % 9; return (const char*)(QKV + (size_t)(bl * TT + w * 256) * 6144 + 2048 + h * 512); }
    __device__ __forceinline__ void epi(const f32x4 (&acc)[2][2][4][2], const Unit& u, int wr, int wc, int fr, int fq) const {
        if (wr != (wc >> 1)) return;
        const int bl = u.pm / 36, h = (u.pm / 9) & 3, w = u.pm % 9;
        float* base = QKR + ((size_t)(bl * 4 + h) * TT + w * 256 + wr * 64 + fr) * 64 + 32 * (wc & 1) + 4 * fq;
#pragma unroll
        for (int ai = 0; ai < 2; ++ai)
#pragma unroll
            for (int m = 0; m < 4; ++m)
#pragma unroll
                for (int n = 0; n < 2; ++n) *(f32x4*)(base + (size_t)(ai * 128 + m * 16) * 64 + n * 16) = acc[ai][ai][m][n];
    }
};
struct PhGates {
    static constexpr bool PERM = false; static constexpr int TAILC = 0; static constexpr bool QPERM = false;
    int K, lda, ldb, nM, nN, coff; const bf16_t* A; const bf16_t* WG; float* GATESP; int poff;
    __device__ __forceinline__ const char* aptr(const Unit& u) const { return (const char*)(A + (size_t)u.pm * 256 * lda + u.pn * 512); }
    __device__ __forceinline__ const char* bptr(const Unit& u) const { return (const char*)(WG + u.pn * 512); }
    __device__ __forceinline__ void epi(const f32x4 (&acc)[2][2][4][2], const Unit& u, int wr, int wc, int fr, int fq) const {
        if (wc != 0) return;
        float* base = GATESP + (size_t)(poff + u.pn) * RG * 16 + (size_t)(u.pm * 256 + wr * 64 + fr) * 16 + 4 * fq;
#pragma unroll
        for (int ai = 0; ai < 2; ++ai)
#pragma unroll
            for (int m = 0; m < 4; ++m) *(f32x4*)(base + (size_t)(ai * 128 + m * 16) * 16) = acc[ai][0][m][0];
    }
};
struct PhResid {
    static constexpr bool PERM = false; static constexpr int TAILC = 0; static constexpr bool QPERM = false;
    int K, lda, ldb, nM, nN, coff; const bf16_t *A, *B; const float *xin_x, *xin_c; float *xout_x, *xout_c; const float* mod  ; int g;
    __device__ __forceinline__ const char* aptr(const Unit& u) const { return (const char*)(A + (size_t)u.pm * 256 * lda); }
    __device__ __forceinline__ const char* bptr(const Unit& u) const { return (const char*)(B + (size_t)u.pn * 256 * ldb); }
    __device__ __forceinline__ void epi(const f32x4 (&acc)[2][2][4][2], const Unit& u, int wr, int wc, int fr, int fq) const {
        const int bl = u.pm / 9, w = u.pm % 9, b = g * GB + bl;
        const float* xin; float* xout; size_t rbase; int v;
        if (w == 0) { rbase = (size_t)b * CTXL; xin = xin_c; xout = xout_c; v = 16; } else { rbase = (size_t)b * SEQ + (w - 1) * 256; xin = xin_x; xout = xout_x; v = b; }
        const int col0 = u.pn * 256 + wc * 32 + 4 * fq;
        const float* gate = mod + (size_t)v * 3072 + 2048 + col0;
        f32x4 gv[2][2];
#pragma unroll
        for (int bj = 0; bj < 2; ++bj)
#pragma unroll
            for (int n = 0; n < 2; ++n) gv[bj][n] = *(const f32x4*)(gate + bj * HALF + n * 16);
#pragma unroll
        for (int ai = 0; ai < 2; ++ai)
#pragma unroll
            for (int m = 0; m < 4; ++m) { const size_t off = (rbase + wr * 64 + fr + ai * HALF + m * 16) * DM + col0;
#pragma unroll
                for (int bj = 0; bj < 2; ++bj)
#pragma unroll
                    for (int n = 0; n < 2; ++n) { const f32x4 xv = *(const f32x4*)(xin + off + bj * HALF + n * 16);
                        *(f32x4*)(xout + off + bj * HALF + n * 16) = xv + gv[bj][n] * acc[ai][bj][m][n]; } }
    }
};

__device__ __forceinline__ int convin_dst_row(int ns) { const int g = ns >> 11, rem = ns & 2047, pn = rem >> 6, jc = rem & 63;
    return 256 * pn + 128 * (g >> 1) + 32 * (jc >> 4) + 8 * ((jc >> 2) & 3) + 4 * (g & 1) + (jc & 3); }
__device__ __forceinline__ void transpose_item(const float* W, int K, int N, bf16_t* WT, LAS float* scr, int item, int lane, bool perm = false) {
    const int nblk = N / 32, kb = item / nblk, nb = item % nblk, k0 = 64 * kb, n0 = 32 * nb;
    float tv[32];
#pragma unroll
    for (int i = 0; i < 32; ++i) { const int kk = 2 * i + (lane >> 5); tv[i] = W[(size_t)(k0 + kk) * N + n0 + (lane & 31)]; }
#pragma unroll
    for (int i = 0; i < 32; ++i) { const int kk = 2 * i + (lane >> 5); scr[kk * 33 + (lane & 31)] = tv[i]; }
    LDS_WAIT();
    const int c = lane & 7;
#pragma unroll
    for (int j = 0; j < 4; ++j) { const int n = (lane >> 3) + 8 * j; const LAS float* s = scr + (8 * c) * 33 + n;
        u32x4 o; o.x = cvt_pk_bf16(s[0 * 33], s[1 * 33]); o.y = cvt_pk_bf16(s[2 * 33], s[3 * 33]); o.z = cvt_pk_bf16(s[4 * 33], s[5 * 33]); o.w = cvt_pk_bf16(s[6 * 33], s[7 * 33]);
        *(u32x4*)(WT + (size_t)(perm ? convin_dst_row(n0 + n) : (n0 + n)) * K + k0 + 8 * c) = o; }
    LDS_WAIT();
}
__device__ __forceinline__ void phase_prep(LAS unsigned char* lds, int wv) {
    const Params P = load_params();
    const int tid = opaque_tid(wv), lane = tid & 63, wave = tid >> 6;
    unsigned char* ws = opq(P.ws);
    float* MODP = (float*)(ws + WS_MODP);
    for (int item = blockIdx.x; item < 192; item += gridDim.x) {
        const int i = item / 48, rem = item % 48, ks = rem / 6, nb = rem % 6;
        LAS float* sc = (LAS float*)lds;
        for (int idx = tid; idx < 17 * 128; idx += 512) { const int v = idx >> 7, k = idx & 127; const float cv = (v < 16) ? P.c[v * DM + ks * 128 + k] : P.c_ctx[ks * 128 + k]; sc[idx] = silu_f(cv); }
        __syncthreads();
        const int n = nb * 512 + tid;
        float a[17];
#pragma unroll
        for (int v = 0; v < 17; ++v) a[v] = 0.f;
        const float* wp = P.mod_w + ((size_t)i * DM + ks * 128) * 3072 + n;
        for (int k0 = 0; k0 < 128; k0 += 16) {
            float wv[16];
#pragma unroll
            for (int u = 0; u < 16; ++u) wv[u] = wp[(size_t)(k0 + u) * 3072];
#pragma unroll
            for (int u = 0; u < 16; ++u)
#pragma unroll
                for (int v = 0; v < 17; ++v) a[v] += sc[v * 128 + k0 + u] * wv[u]; }
#pragma unroll
        for (int v = 0; v < 17; ++v) MODP[((size_t)(ks * 4 + i) * 17 + v) * 3072 + n] = a[v];
        __syncthreads();
    }
    LAS float* scr = (LAS float*)(lds + 16384 + wave * 8448);
    const int gw = blockIdx.x * 8 + wave, NGW = gridDim.x * 8;
    constexpr int PERJ = 4096 + 1024 + 3072 + 12 * 128 + 1024;
    for (int it = gw; it < 2 * PERJ; it += NGW) {
        const int j = it / PERJ; int r = it % PERJ;
        if (r < 4096) { transpose_item(P.conv_w_in + (size_t)j * DM * 8192, DM, 8192, (bf16_t*)(ws + WS_CWIN) + (size_t)j * 8192 * DM, scr, r, lane, true); continue; } r -= 4096;
        if (r < 1024) { transpose_item(P.conv_w_out + (size_t)j * DI * DM, DI, DM, (bf16_t*)(ws + WS_CWOUT) + (size_t)j * DM * DI, scr, r, lane); continue; } r -= 1024;
        if (r < 3072) { transpose_item(P.m_w_in + (size_t)j * DM * 6144, DM, 6144, (bf16_t*)(ws + WS_MWIN) + (size_t)j * 6144 * DM, scr, r, lane); continue; } r -= 3072;
        if (r < 1536) { const int wh = r / 128, which = wh >> 2, h = wh & 3; const float* src = (which == 0 ? P.m_wq : (which == 1 ? P.m_wk : P.m_wv)) + (size_t)(j * 4 + h) * DH * DH;
            transpose_item(src, DH, DH, (bf16_t*)(ws + WS_MWQKV) + ((size_t)(j * 3 + which) * 4 + h) * DH * DH, scr, r % 128, lane); continue; } r -= 1536;
        transpose_item(P.m_w_out + (size_t)j * DI * DM, DI, DM, (bf16_t*)(ws + WS_MWOUT) + (size_t)j * DM * DI, scr, r, lane);
    }
    bf16_t* MWG2 = (bf16_t*)(ws + WS_MWG);
    for (int item = gw; item < 2 * 2 * 2048; item += NGW) {
        const int j = item >> 12, part = (item >> 11) & 1, kg = item & 2047, h = kg >> 9, d = kg & 511;
        float acc[16];
#pragma unroll
        for (int n = 0; n < 16; ++n) acc[n] = 0.f;
        for (int pass = 0; pass < (part == 0 ? 2 : 1); ++pass) {
            const int which = part == 0 ? pass : 2; const float scl = which == 1 ? 0.044194173824159216f : 1.f;
            const float* wrow = (which == 0 ? P.m_wq : (which == 1 ? P.m_wk : P.m_wv)) + ((size_t)(j * 4 + h) * DH + d) * DH;
            const float* wgp = P.m_w_gate + ((size_t)j * 6144 + which * 2048 + h * 512) * 16;
#pragma unroll
            for (int q = 0; q < 8; ++q) { const int e = lane + 64 * q; const float wvv = wrow[e] * scl;
                const f32x4 g0 = *(const f32x4*)(wgp + (size_t)e * 16), g1 = *(const f32x4*)(wgp + (size_t)e * 16 + 4), g2 = *(const f32x4*)(wgp + (size_t)e * 16 + 8), g3 = *(const f32x4*)(wgp + (size_t)e * 16 + 12);
#pragma unroll
                for (int i = 0; i < 4; ++i) { acc[i] += wvv * g0[i]; acc[4 + i] += wvv * g1[i]; acc[8 + i] += wvv * g2[i]; acc[12 + i] += wvv * g3[i]; } }
        }
        float mine = 0.f;
#pragma unroll
        for (int n = 0; n < 16; ++n) { const float t = wave_sum(acc[n], lane); mine = (lane == n) ? t : mine; }
        if (lane < 16) MWG2[((size_t)(j * 2 + part) * 256 + lane) * 2048 + kg] = (bf16_t)(cvt_pk_bf16(mine, 0.f) & 0xffffu);
    }
    for (size_t idx = (size_t)blockIdx.x * 512 + tid; idx < (size_t)4 * 240 * 2048; idx += (size_t)gridDim.x * 512) {
        const int m4 = (int)(idx / (240 * 2048)); const int rem = (int)(idx % (240 * 2048));
        MWG2[((size_t)m4 * 256 + 16) * 2048 + rem] = (bf16_t)0;
    }
    __syncthreads();
}
__device__ __forceinline__ void phase_modreduce(int wv) {
    const Params P = load_params();
    unsigned char* ws = opq(P.ws);
    const float* MODP = (const float*)(ws + WS_MODP); float* MOD = (float*)(ws + WS_MOD);
    for (int idx = blockIdx.x * 512 + opaque_tid(wv); idx < 4 * 17 * 3072; idx += gridDim.x * 512) {
        const int i = idx / (17 * 3072), n = idx % 3072;
        float s = P.mod_b[i * 3072 + n];
#pragma unroll
        for (int ks = 0; ks < 8; ++ks) s += MODP[(size_t)ks * 4 * 17 * 3072 + idx];
        MOD[idx] = s;
    }
}

__device__ __forceinline__ void phase_modulate(int layer, int g, int buf, bool light, int wv) {
    if (light && blockIdx.x < 160) return;
    const Params P = load_params();
    const float* xin_x = (layer == 0) ? P.x : P.out; const float* xin_c = (layer == 0) ? P.ctx : (const float*)(P.ws + WS_XC);
    const int tid = opaque_tid(wv), lane = tid & 63, gw = (light ? (int)blockIdx.x - 160 : (int)blockIdx.x) * 8 + (tid >> 6), NGW = (light ? 96 : (int)gridDim.x) * 8;
    unsigned char* ws = opq(P.ws); xin_x = opq(xin_x); xin_c = opq(xin_c);
    bf16_t* HX = (bf16_t*)(ws + (buf ? WS_HX2 : WS_HX)); const float* MOD = (const float*)(ws + WS_MOD) + (size_t)layer * 17 * 3072;
    const float* ng = opq(P.norm_g) + layer * DM;
    for (int r = gw; r < RG; r += NGW) {
        const int bl = r / TT, tt = r % TT, b = g * GB + bl;
        const float* xr; int v;
        if (tt < CTXL) { xr = xin_c + ((size_t)b * CTXL + tt) * DM; v = 16; } else { xr = xin_x + ((size_t)b * SEQ + (tt - CTXL)) * DM; v = b; }
        const float* md = MOD + (size_t)v * 3072;
        f32x4 xv[4]; float ss = 0.f;
#pragma unroll
        for (int q = 0; q < 4; ++q) { xv[q] = *(const f32x4*)(xr + 4 * lane + 256 * q); ss += (xv[q][0] * xv[q][0] + xv[q][1] * xv[q][1]) + (xv[q][2] * xv[q][2] + xv[q][3] * xv[q][3]); }
        const float rstd = rsqrtf(wave_sum(ss, lane) * (1.f / DM) + EPSV);
#pragma unroll
        for (int q = 0; q < 4; ++q) { const int c0 = 4 * lane + 256 * q;
            const f32x4 gv = *(const f32x4*)(ng + c0), sh = *(const f32x4*)(md + c0), sc = *(const f32x4*)(md + 1024 + c0);
            const f32x4 y = xv[q] * rstd * gv * (sc + 1.f) + sh;
            u32x2 o; o.x = cvt_pk_bf16(y[0], y[1]); o.y = cvt_pk_bf16(y[2], y[3]);
            *(u32x2*)(HX + (size_t)r * DM + c0) = o; }
    }
}
__device__ __forceinline__ void conv_valid(int r, bool& pv, bool& nv) {
    const int tt = r % TT;
    if (tt < CTXL) { pv = tt != 0; nv = tt != CTXL - 1; } else { pv = (tt & 63) != 0; nv = (tt & 63) != 63; }
}
__device__ __forceinline__ void phase_convmix(int j, int g, int wv) {
    const Params P = load_params();
    unsigned char* ws = opq(P.ws);
    const bf16_t* BIG = (const bf16_t*)(ws + WS_BIG); bf16_t* Y = (bf16_t*)(ws + ((g & 1) ? WS_KT : WS_VT));
    const float* cw = opq(P.conv_w) + (size_t)j * 3 * DI;
    for (int it = blockIdx.x * 512 + opaque_tid(wv); it < GB * CTXL * 256; it += gridDim.x * 512) {
        const int rc = it >> 8, r = (rc >> 8) * TT + (rc & 255), c8 = (it & 255) * 8; bool pv, nv; conv_valid(r, pv, nv);
        const bf16_t* row = BIG + (size_t)r * 8192 + c8;
        float bb[8], cc[8], uu[8], zz[8], cp[8], up[8], cn[8], un[8];
        unpack8(*(const u32x4*)(row), bb); unpack8(*(const u32x4*)(row + 2048), cc); unpack8(*(const u32x4*)(row + 4096), uu); unpack8(*(const u32x4*)(row + 6144), zz);
        const u32x4 z4 = (u32x4){0u, 0u, 0u, 0u};
        unpack8(pv ? *(const u32x4*)(row - 8192 + 2048) : z4, cp); unpack8(pv ? *(const u32x4*)(row - 8192 + 4096) : z4, up);
        unpack8(nv ? *(const u32x4*)(row + 8192 + 2048) : z4, cn); unpack8(nv ? *(const u32x4*)(row + 8192 + 4096) : z4, un);
        float w0[8], w1[8], w2[8], y[8];
        *(f32x4*)(w0) = *(const f32x4*)(cw + c8); *(f32x4*)(w0 + 4) = *(const f32x4*)(cw + c8 + 4);
        *(f32x4*)(w1) = *(const f32x4*)(cw + DI + c8); *(f32x4*)(w1 + 4) = *(const f32x4*)(cw + DI + c8 + 4);
        *(f32x4*)(w2) = *(const f32x4*)(cw + 2 * DI + c8); *(f32x4*)(w2 + 4) = *(const f32x4*)(cw + 2 * DI + c8 + 4);
#pragma unroll
        for (int e = 0; e < 8; ++e) { const float s = w0[e] * (cp[e] * up[e]) + w1[e] * (cc[e] * uu[e]) + w2[e] * (cn[e] * un[e]); y[e] = bb[e] * s * silu_f(zz[e]); }
        *(u32x4*)(Y + (size_t)r * DI + c8) = pack8(y);
    }
}
__device__ __forceinline__ void phase_uc(int j, int wv) {
    const Params P = load_params();
    unsigned char* ws = opq(P.ws);
    const bf16_t* UZO = (const bf16_t*)(ws + WS_BIG); bf16_t* UC = (bf16_t*)(ws + WS_UC);
    const float* cw = opq(P.m_conv_w) + (size_t)j * 3 * DI;
    for (int it = blockIdx.x * 512 + opaque_tid(wv); it < RG * 256; it += gridDim.x * 512) {
        const int r = it >> 8, c8 = (it & 255) * 8; bool pv, nv; conv_valid(r, pv, nv);
        const bf16_t* row = UZO + (size_t)r * 6144 + c8;
        float uu[8], up[8], un[8], y[8];
        const u32x4 z4 = (u32x4){0u, 0u, 0u, 0u};
        unpack8(*(const u32x4*)(row), uu);
        unpack8(pv ? *(const u32x4*)(row - 6144) : z4, up);
        unpack8(nv ? *(const u32x4*)(row + 6144) : z4, un);
        float w0[8], w1[8], w2[8];
        *(f32x4*)(w0) = *(const f32x4*)(cw + c8); *(f32x4*)(w0 + 4) = *(const f32x4*)(cw + c8 + 4);
        *(f32x4*)(w1) = *(const f32x4*)(cw + DI + c8); *(f32x4*)(w1 + 4) = *(const f32x4*)(cw + DI + c8 + 4);
        *(f32x4*)(w2) = *(const f32x4*)(cw + 2 * DI + c8); *(f32x4*)(w2 + 4) = *(const f32x4*)(cw + 2 * DI + c8 + 4);
#pragma unroll
        for (int e = 0; e < 8; ++e) { const float s = w0[e] * up[e] + w1[e] * uu[e] + w2[e] * un[e]; y[e] = silu_f(s); }
        *(u32x4*)(UC + (size_t)r * DI + c8) = pack8(y);
    }
}
__device__ __forceinline__ void phase_gating(int j, int wv) {
    const Params P = load_params();
    const int tid = opaque_tid(wv), lane = tid & 63, gw = blockIdx.x * 8 + (tid >> 6), NGW = gridDim.x * 8;
    unsigned char* ws = opq(P.ws); const float* mng = opq(P.m_norm_g) + (size_t)j * DI; const float* msk = opq(P.m_skip) + (size_t)j * DI;
    const bf16_t* QKV = (const bf16_t*)(ws + WS_QKV); const bf16_t* UZO = (const bf16_t*)(ws + WS_BIG); const bf16_t* UC = (const bf16_t*)(ws + WS_UC);
    bf16_t* Y = (bf16_t*)(ws + WS_KT);
    u32x4 nhf, nhb, nzz, noo, nuc;
#define GATE_LOAD(IT) { const int r_ = (IT) >> 2, c_ = ((IT) & 3) * 512 + 8 * lane; \
        nhf = *(const u32x4*)(QKV + (size_t)r_ * 6144 + 2048 + c_); nhb = *(const u32x4*)(QKV + (size_t)r_ * 6144 + 4096 + c_); \
        nzz = *(const u32x4*)(UZO + (size_t)r_ * 6144 + 2048 + c_); noo = *(const u32x4*)(UZO + (size_t)r_ * 6144 + 4096 + c_); nuc = *(const u32x4*)(UC + (size_t)r_ * DI + c_); }
    if (gw < RG * 4) GATE_LOAD(gw)
    for (int it = gw; it < RG * 4; it += NGW) {
        const int r = it >> 2, h = it & 3, c0 = h * 512 + 8 * lane;
        float hf[8], hb[8], zz[8], oo[8], uc[8], y[8];
        unpack8(nhf, hf); unpack8(nhb, hb); unpack8(nzz, zz); unpack8(noo, oo); unpack8(nuc, uc);
        { const int itn = (it + NGW < RG * 4) ? it + NGW : it; GATE_LOAD(itn) }
        float s = 0.f;
#pragma unroll
        for (int e = 0; e < 8; ++e) { hf[e] += hb[e]; s += hf[e]; }
        const float mean = wave_sum(s, lane) * (1.f / DH); float s2 = 0.f;
#pragma unroll
        for (int e = 0; e < 8; ++e) { hf[e] -= mean; s2 += hf[e] * hf[e]; }
        const float rstd = rsqrtf(wave_sum(s2, lane) * (1.f / DH) + EPSV);
        float ng[8], sk[8];
        *(f32x4*)(ng) = *(const f32x4*)(mng + c0); *(f32x4*)(ng + 4) = *(const f32x4*)(mng + c0 + 4);
        *(f32x4*)(sk) = *(const f32x4*)(msk + c0); *(f32x4*)(sk + 4) = *(const f32x4*)(msk + c0 + 4);
#pragma unroll
        for (int e = 0; e < 8; ++e) y[e] = (sigmoid_f(oo[e]) * (hf[e] * rstd * ng[e]) + sk[e] * uc[e]) * silu_f(zz[e]);
        *(u32x4*)(Y + (size_t)r * DI + c0) = pack8(y);
    }
#undef GATE_LOAD
}
__device__ __forceinline__ void phase_final(int r0, int r1, bool light, int wv) {
    if (light && blockIdx.x < 144) return;
    const Params P = load_params();
    const int tid = opaque_tid(wv), lane = tid & 63, gw = (light ? (int)blockIdx.x - 144 : (int)blockIdx.x) * 8 + (tid >> 6), NGW = (light ? 112 : (int)gridDim.x) * 8;
    float* outp = opq(P.out); const float* fg = opq(P.final_g);
    for (int r = r0 + gw; r < r1; r += NGW) {
        float* xr = outp + (size_t)r * DM;
        f32x4 xv[4]; float ss = 0.f;
#pragma unroll
        for (int q = 0; q < 4; ++q) { xv[q] = *(const f32x4*)(xr + 4 * lane + 256 * q); ss += (xv[q][0] * xv[q][0] + xv[q][1] * xv[q][1]) + (xv[q][2] * xv[q][2] + xv[q][3] * xv[q][3]); }
        const float rstd = rsqrtf(wave_sum(ss, lane) * (1.f / DM) + EPSV);
#pragma unroll
        for (int q = 0; q < 4; ++q) { const f32x4 gv = *(const f32x4*)(fg + 4 * lane + 256 * q); *(f32x4*)(xr + 4 * lane + 256 * q) = xv[q] * rstd * gv; }
    }
}

__device__ __forceinline__ void phase_gatetab(LAS unsigned char* lds, int j, int wv) {
    if (blockIdx.x < 144 || blockIdx.x >= 176) return;
    const Params P = load_params();
    const int tid = opaque_tid(wv), lane = tid & 63, w = __builtin_amdgcn_readfirstlane(tid >> 6);
    unsigned char* ws = P.ws;
    const int sidx = (int)blockIdx.x - 144, dir = sidx & 1, h = (sidx >> 1) & 3, bl = sidx >> 3;
    const float* gt = (const float*)(ws + WS_GATESP) + (size_t)(bl * TT) * 16 + h + (dir ? 8 : 0);
    LAS float* tA = (LAS float*)(lds + 102400); LAS float* tPM = tA + TT; LAS float* tBC = tA + 2 * TT;
    LAS float* cMP = (LAS float*)(lds + 102400 + 3 * TT * 4); LAS float* cM63 = cMP + 36; LAS float* cBL = cMP + 72; LAS float* cAM = cMP + 108;
        {
            const float bi_ = P.m_b_gate[j * 16 + (dir ? 8 : 0) + h], bf_ = P.m_b_gate[j * 16 + (dir ? 8 : 0) + 4 + h];
            for (int cc = w; cc < 36; cc += 8) { const int ac = dir ? (cc < 4 ? 3 - cc : 39 - cc) : cc, t = dir ? 63 - lane : lane, row = ac * 64 + t;
                const float* gp = gt + (size_t)row * 16; float si = bi_, sf = bf_;
#pragma unroll
                for (int ks_ = 0; ks_ < 8; ++ks_) { si += gp[(size_t)ks_ * RG * 16]; sf += gp[(size_t)ks_ * RG * 16 + 4]; }
                const float fp = sf; const float lf = fminf(fp, 0.f) - log1pf(__expf(-fabsf(fp)));
#define DPP_F(oldv, src, ctrl, rmask) __int_as_float(__builtin_amdgcn_update_dpp(__float_as_int(oldv), __float_as_int(src), ctrl, rmask, 0xf, false))
                float bc = lf;
                bc += DPP_F(0.f, bc, 0x111, 0xf); bc += DPP_F(0.f, bc, 0x112, 0xf); bc += DPP_F(0.f, bc, 0x114, 0xf); bc += DPP_F(0.f, bc, 0x118, 0xf);
                bc += DPP_F(0.f, bc, 0x142, 0xa); bc += DPP_F(0.f, bc, 0x143, 0xc);
                const float av = si - bc;
                const float ninf = -__builtin_inff();
                float pmx = av;
                pmx = fmaxf(pmx, DPP_F(ninf, pmx, 0x111, 0xf)); pmx = fmaxf(pmx, DPP_F(ninf, pmx, 0x112, 0xf)); pmx = fmaxf(pmx, DPP_F(ninf, pmx, 0x114, 0xf)); pmx = fmaxf(pmx, DPP_F(ninf, pmx, 0x118, 0xf));
                pmx = fmaxf(pmx, DPP_F(ninf, pmx, 0x142, 0xa)); pmx = fmaxf(pmx, DPP_F(ninf, pmx, 0x143, 0xc));
#undef DPP_F
                tA[row] = av; tPM[row] = pmx; tBC[row] = bc;
                if (lane == 63) { cBL[cc] = bc; cAM[cc] = pmx; } }
            __syncthreads();
            if (tid == 0) { float mp = 0.f; for (int cc = 0; cc < 36; ++cc) { cMP[cc] = mp; const float M63 = fmaxf(mp, cAM[cc]); cM63[cc] = M63; mp = cBL[cc] + M63; } }
            __syncthreads();
        }
    { char* gdst = (char*)(ws + WS_GTAB) + (size_t)sidx * 28224; const LAS f32x4* lsrc = (const LAS f32x4*)tA;
      for (int i = tid; i < 7056 / 4; i += 512) { unsigned off = (unsigned)i * 16u; asm volatile("" : "+v"(off)); *(f32x4*)(gdst + off) = lsrc[i]; } }
    __syncthreads();
}

constexpr int SC_R = 0, SC_V = 81920, SC_VW = 91136, SC_TAB = 100352;
__device__ __forceinline__ bf16x8 mk_frag(unsigned a, unsigned b, unsigned c, unsigned d) { u32x4 t; t.x = a; t.y = b; t.z = c; t.w = d; return __builtin_bit_cast(bf16x8, t); }
__device__ __forceinline__ void phase_scan(LAS unsigned char* lds, int j, int wv) {
    const Params P = load_params();
    const int tid = opaque_tid(wv);
    const int lane = tid & 63, w = __builtin_amdgcn_readfirstlane(tid >> 6), lr = lane & 15, lq = lane >> 4;
    const unsigned qoff = (unsigned)(lr * 6144 + 64 * w + 8 * lq) * 2u;
    const unsigned koff = (unsigned)lane * 16u;
    const unsigned hoff = (unsigned)((4 * lq) * 6144 + lr) * 2u;
    unsigned char* ws = opq(P.ws);
    bf16_t* QKV = (bf16_t*)(ws + WS_QKV); const bf16_t* KT = (const bf16_t*)(ws + WS_KT); const bf16_t* VT = (const bf16_t*)(ws + WS_VT);
    const float* QKR = (const float*)(ws + WS_QKR); const float* GATES = (const float*)(ws + WS_GATESP);
    LAS f32x4* R = (LAS f32x4*)(lds + SC_R);
    LAS bf16_t* sV = (LAS bf16_t*)(lds + SC_V); LAS bf16_t* sVW = (LAS bf16_t*)(lds + SC_VW);
    LAS bf16_t* sH = (LAS bf16_t*)(lds + 139264);
    LAS u32x4* sS = (LAS u32x4*)(lds + 131072);
    LAS float* tA = (LAS float*)(lds + 102400); LAS float* tPM = tA + TT; LAS float* tBC = tA + 2 * TT;
    LAS float* cMP = (LAS float*)(lds + 102400 + 3 * TT * 4); LAS float* cM63 = cMP + 36; LAS float* cBL = cMP + 72; LAS float* cAM = cMP + 108;
    LAS float* tabA = (LAS float*)(lds + SC_TAB); LAS float* tabM = tabA + 64; LAS float* tabWI = tabA + 128; LAS float* tabFL = tabA + 192; LAS float* tabWS = tabA + 256; LAS float* scal = tabA + 320;
    for (int uid = blockIdx.x; uid < GB * NH * 2 * 8; uid += gridDim.x) {
        const int xcd_ = uid & 7, yy_ = uid >> 3, pair_ = xcd_ * 2 + (yy_ >> 4);
        const int es = yy_ & 7, dir = (yy_ >> 3) & 1, h = pair_ & 3, bl = pair_ >> 2;
        const bf16_t* qb = QKV + (size_t)(bl * TT) * 6144 + h * 512;
        const bf16_t* kTb = KT + (size_t)((bl * 4 + h) * 512) * TT;
        const bf16_t* vTb = VT + (size_t)((bl * 4 + h) * 512 + es * 64) * TT;
        const float* qkr = QKR + (size_t)((bl * 4 + h) * TT) * 64;
        const float* gt = GATES + (size_t)(bl * TT) * 16 + h + (dir ? 8 : 0);
        bf16_t* hout = QKV + (size_t)(bl * TT) * 6144 + (dir ? 4096 : 2048) + h * 512 + es * 64;
        f32x4 C[4][5];
#pragma unroll
        for (int a = 0; a < 4; ++a)
#pragma unroll
            for (int b = 0; b < 5; ++b) C[a][b] = (f32x4){0.f, 0.f, 0.f, 0.f};
        { const char* gsrc = (const char*)(ws + WS_GTAB) + (size_t)((bl * 4 + h) * 2 + dir) * 28224; LAS f32x4* ldst = (LAS f32x4*)tA;
          for (int i = tid; i < 7056 / 4; i += 512) { unsigned off = (unsigned)i * 16u; asm volatile("" : "+v"(off)); ldst[i] = *(const f32x4*)(gsrc + off); }
          __syncthreads(); }
        bf16x8 qa0[4], qa1[4];
#define SCAN_LOAD_Q0(T0) { _Pragma("unroll") for (int jt = 0; jt < 4; ++jt) { const char* p_ = (const char*)qb + (size_t)((T0) + 16 * jt) * 12288 + qoff; \
            qa0[jt] = *(const bf16x8*)p_; qa1[jt] = *(const bf16x8*)(p_ + 64); } }
        SCAN_LOAD_Q0(dir ? 3 * 64 : 0)
        for (int cc = 0; cc < 36; ++cc) {
            const int ac = dir ? (cc < 4 ? 3 - cc : 39 - cc) : cc, t0 = ac * 64;
            const int ccn = cc < 35 ? cc + 1 : 35, acn = dir ? (ccn < 4 ? 3 - ccn : 39 - ccn) : ccn, t0n = acn * 64;
            if (w == 7) { const float mpc = cMP[cc], M63c = cM63[cc]; const float av_ = tA[t0 + lane], Mi_ = fmaxf(mpc, tPM[t0 + lane]);
                tabWS[lane] = __expf(av_ - M63c); tabWI[lane] = __expf(mpc - Mi_); tabFL[lane] = __expf(-(tBC[t0 + lane] + Mi_)); }
#define SCAN_PASS(E0, NE) { f32x4 Pt[4][NE]; \
                _Pragma("unroll") for (int ks = 0; ks < 2; ++ks) { \
                  _Pragma("unroll") for (int e = 0; e < NE; ++e) { const f32x4 c0 = C[2 * ks][E0 + e], c1 = C[2 * ks + 1][E0 + e]; \
                    const bf16x8 cb = mk_frag(cvt_pk_bf16(c0[0], c0[1]), cvt_pk_bf16(c0[2], c0[3]), cvt_pk_bf16(c1[0], c1[1]), cvt_pk_bf16(c1[2], c1[3])); \
                    _Pragma("unroll") for (int jt = 0; jt < 4; ++jt) Pt[jt][e] = __builtin_amdgcn_mfma_f32_16x16x32_bf16(ks == 0 ? qa0[jt] : qa1[jt], cb, ks == 0 ? (f32x4){0.f, 0.f, 0.f, 0.f} : Pt[jt][e], 0, 0, 0); } } \
                if (w >= 4) { _Pragma("unroll") for (int jt = 0; jt < 4; ++jt) _Pragma("unroll") for (int e = 0; e < NE; ++e) R[((w - 4) * 20 + jt * 5 + E0 + e) * 64 + lane] = Pt[jt][e]; } \
                __syncthreads(); \
                if (w < 4) { _Pragma("unroll") for (int jt = 0; jt < 4; ++jt) _Pragma("unroll") for (int e = 0; e < NE; ++e) { const int idx = (w * 20 + jt * 5 + E0 + e) * 64 + lane; const f32x4 sres = Pt[jt][e] + R[idx]; R[idx] = sres; } } }
            SCAN_PASS(0, 2)
            if (w >= 4) {
#pragma unroll
                for (int hlf = 0; hlf < 2; ++hlf) { const int it_ = (tid - 256) + 256 * hlf, ve = it_ >> 3, vs = (it_ & 7) * 8;
                    const u32x4 vraw = *(const u32x4*)(vTb + (size_t)ve * TT + t0 + vs);
                    float vf[8], wv[8]; unpack8(vraw, vf);
                    const f32x4 w0 = *(const LAS f32x4*)(tabWS + vs), w1 = *(const LAS f32x4*)(tabWS + vs + 4);
#pragma unroll
                    for (int e = 0; e < 4; ++e) { wv[e] = vf[e] * w0[e]; wv[4 + e] = vf[4 + e] * w1[e]; }
                    *(LAS u32x4*)(sV + ve * 72 + vs) = vraw;
                    *(LAS u32x4*)(sVW + ve * 72 + vs) = pack8(wv); }
            }
            SCAN_PASS(2, 3)
#undef SCAN_PASS
            if (w >= 4) {
                int jr = 16 * (w - 4) + lr; asm volatile("" : "+v"(jr));
                const float Mj = fmaxf(cMP[cc], tPM[t0 + jr]);
#pragma unroll
                for (int ks = 0; ks < 2; ++ks) { const int s0 = 32 * ks + 8 * lq; const float* qp = qkr + (size_t)(t0 + jr) * 64 + s0;
                    const f32x4 q0 = *(const f32x4*)qp, q1 = *(const f32x4*)(qp + 4);
                    const f32x4 a0 = *(const LAS f32x4*)(tA + t0 + s0), a1 = *(const LAS f32x4*)(tA + t0 + s0 + 4);
                    float sv[8];
#pragma unroll
                    for (int e = 0; e < 4; ++e) { const int sA = s0 + e, sB = s0 + 4 + e;
                        const bool vA = dir ? (sA >= jr) : (sA <= jr), vB = dir ? (sB >= jr) : (sB <= jr);
                        sv[e] = vA ? q0[e] * __expf(a0[e] - Mj) : 0.f; sv[4 + e] = vB ? q1[e] * __expf(a1[e] - Mj) : 0.f; }
                    sS[((w - 4) * 2 + ks) * 64 + lane] = pack8(sv); }
            }
            bf16x8 ka[4][2];
#pragma unroll
            for (int dt = 0; dt < 4; ++dt)
#pragma unroll
                for (int ks = 0; ks < 2; ++ks) ka[dt][ks] = *(const bf16x8*)((const char*)kTb + (size_t)((((t0 >> 6) * 32 + 4 * w + dt) * 2 + ks) * 64) * 16 + koff);
            const int jt_f = w >> 1, eh = w & 1;
            __syncthreads();
            {
                const int jt = jt_f;
                bf16x8 sa[2];
#pragma unroll
                for (int ks = 0; ks < 2; ++ks) { const u32x4 pk = sS[(jt * 2 + ks) * 64 + lane]; sa[ks] = __builtin_bit_cast(bf16x8, pk); }
                const unsigned one2 = (lr == 0) ? 0x3F803F80u : 0u;
                const bf16x8 ones = mk_frag(one2, one2, one2, one2);
                const f32x4 wi = *(const LAS f32x4*)(tabWI + 16 * jt + 4 * lq), fl = *(const LAS f32x4*)(tabFL + 16 * jt + 4 * lq);
                f32x4 num[3];
#pragma unroll
                for (int x = 0; x < 3; ++x) { const int et = (x < 2) ? 2 * eh + x : 4, tile = jt * 5 + et;
                    const f32x4 inter = (R[(0 * 20 + tile) * 64 + lane] + R[(1 * 20 + tile) * 64 + lane]) + (R[(2 * 20 + tile) * 64 + lane] + R[(3 * 20 + tile) * 64 + lane]);
                    f32x4 it = (f32x4){0.f, 0.f, 0.f, 0.f};
#pragma unroll
                    for (int ks = 0; ks < 2; ++ks) { const bf16x8 vb = (x < 2) ? *(const LAS bf16x8*)(sV + (16 * et + lr) * 72 + 32 * ks + 8 * lq) : ones;
                        it = __builtin_amdgcn_mfma_f32_16x16x32_bf16(sa[ks], vb, it, 0, 0, 0); }
                    num[x] = wi * inter + it; }
                f32x4 den;
#pragma unroll
                for (int i = 0; i < 4; ++i) den[i] = fmaxf(fabsf(lane_read(num[2][i], lane & 48)), fl[i]);
#pragma unroll
                for (int x = 0; x < 2; ++x) { const int et = 2 * eh + x;
#pragma unroll
                    for (int i = 0; i < 4; ++i) { const float hv = num[x][i] * __builtin_amdgcn_rcpf(den[i]);
                        sH[(16 * jt + 4 * lq + i) * 72 + 16 * et + lr] = (bf16_t)(cvt_pk_bf16(hv, 0.f) & 0xffffu); } }
            }
            SCAN_LOAD_Q0(t0n)
            {
                const float wd = __expf(cMP[cc] - cM63[cc]);
#pragma unroll
                for (int dt = 0; dt < 4; ++dt)
#pragma unroll
                    for (int et = 0; et < 5; ++et) C[dt][et] = C[dt][et] * wd;
#pragma unroll
                for (int ks = 0; ks < 2; ++ks) {
#pragma unroll
                    for (int et = 0; et < 4; ++et) { const bf16x8 vwb = *(const LAS bf16x8*)(sVW + (16 * et + lr) * 72 + 32 * ks + 8 * lq);
#pragma unroll
                        for (int dt = 0; dt < 4; ++dt) C[dt][et] = __builtin_amdgcn_mfma_f32_16x16x32_bf16(ka[dt][ks], vwb, C[dt][et], 0, 0, 0); }
                    const f32x4 w0 = *(const LAS f32x4*)(tabWS + 32 * ks + 8 * lq), w1 = *(const LAS f32x4*)(tabWS + 32 * ks + 8 * lq + 4);
                    u32x4 wp; wp.x = cvt_pk_bf16(w0[0], w0[1]); wp.y = cvt_pk_bf16(w0[2], w0[3]); wp.z = cvt_pk_bf16(w1[0], w1[1]); wp.w = cvt_pk_bf16(w1[2], w1[3]);
                    if (lr != 0) { wp.x = 0u; wp.y = 0u; wp.z = 0u; wp.w = 0u; }
                    const bf16x8 wb = __builtin_bit_cast(bf16x8, wp);
#pragma unroll
                    for (int dt = 0; dt < 4; ++dt) C[dt][4] = __builtin_amdgcn_mfma_f32_16x16x32_bf16(ka[dt][ks], wb, C[dt][4], 0, 0, 0);
                }
            }
            __syncthreads();
            { const int hr = tid >> 3, hc = (tid & 7) * 8; const u32x4 hv4 = *(const LAS u32x4*)(sH + hr * 72 + hc);
              unsigned ho_ = (unsigned)(hr * 6144 + hc) * 2u; asm volatile("" : "+v"(ho_));
              *(u32x4*)((char*)hout + (size_t)t0 * 12288 + ho_) = hv4; }
        }
    }
}

__device__ __forceinline__ void run_in_gemm(LAS unsigned char* lds, int j, bool conv, int coff, int g, int buf, int wv) {
    const Params P = load_params(); unsigned char* ws = P.ws;
    if (conv) {
        PhConvFused ph; ph.K = DM; ph.lda = DM; ph.ldb = DM; ph.nM = MT; ph.nN = 32; ph.coff = coff; ph.A = (const bf16_t*)(ws + (buf ? WS_HX2 : WS_HX)); ph.B = (const bf16_t*)(ws + WS_CWIN) + (size_t)j * 8192 * DM;
        ph.BIG = (bf16_t*)(ws + WS_BIG); ph.Y = (bf16_t*)(ws + ((g & 1) ? WS_KT : WS_VT)); ph.cw = P.conv_w + (size_t)j * 3 * DI;
        gemm_phase(lds, ph, wv);
    } else {
        PhPlain ph; ph.K = DM; ph.lda = DM; ph.ldb = DM; ph.nM = MT; ph.coff = coff; ph.A = (const bf16_t*)(ws + (buf ? WS_HX2 : WS_HX)); ph.O = (bf16_t*)(ws + WS_BIG);
        ph.nN = 24; ph.B = (const bf16_t*)(ws + WS_MWIN) + (size_t)j * 6144 * DM; ph.ldc = 6144;
        gemm_phase(lds, ph, wv);
    }
}
__device__ __forceinline__ void run_out_gemm(LAS unsigned char* lds, int layer, int g, int wv) {
    const Params P = load_params(); unsigned char* ws = P.ws; const int j = layer >> 1;
    PhResid ph; ph.K = DI; ph.lda = DI; ph.ldb = DI; ph.nM = MT; ph.nN = 4; ph.coff = 0; ph.A = (const bf16_t*)(ws + (((layer & 1) || (g & 1)) ? WS_KT : WS_VT));
    ph.B = ((layer & 1) ? (const bf16_t*)(ws + WS_MWOUT) : (const bf16_t*)(ws + WS_CWOUT)) + (size_t)j * DM * DI;
    ph.xin_x = (layer == 0) ? P.x : P.out; ph.xin_c = (layer == 0) ? P.ctx : (const float*)(ws + WS_XC); ph.xout_x = P.out; ph.xout_c = (float*)(ws + WS_XC);
    ph.mod = (const float*)(ws + WS_MOD) + (size_t)layer * 17 * 3072; ph.g = g;
    gemm_phase(lds, ph, wv);
}
__device__ __forceinline__ void run_qkv_nat(LAS unsigned char* lds, int j, bool isv, int wv) {
    const Params P = load_params(); unsigned char* ws = P.ws;
    PhQKV ph; ph.K = DH; ph.ldb = DH; ph.nM = MT; ph.W = (const bf16_t*)(ws + WS_MWQKV) + (size_t)j * 3 * 4 * DH * DH; ph.O = (bf16_t*)(ws + WS_QKV);
    if (!isv) { ph.lda = DI; ph.nN = 16; ph.coff = 0; ph.A = (const bf16_t*)(ws + WS_UC); ph.which0 = 0; }
    else { ph.lda = 6144; ph.nN = 8; ph.coff = 256 - 64; ph.A = (const bf16_t*)(ws + WS_BIG); ph.which0 = 2; }
    gemm_phase(lds, ph, wv);
}
__device__ __forceinline__ void run_tr(LAS unsigned char* lds, int j, bool isv, int wv) {
    const Params P = load_params(); unsigned char* ws = P.ws;
    PhTr ph; ph.K = DH; ph.lda = DH; ph.nM = 8; ph.nN = MT;
    const bf16_t* WQKV = (const bf16_t*)(ws + WS_MWQKV) + (size_t)j * 3 * 4 * DH * DH;
    if (!isv) { ph.ldb = DI; ph.coff = 192; ph.W = WQKV + (size_t)1 * 4 * DH * DH; ph.Act = (const bf16_t*)(ws + WS_UC); ph.OT = (bf16_t*)(ws + WS_KT); ph.scale = 0.044194173824159216f; ph.frag = 1; }
    else { ph.ldb = 6144; ph.coff = 160; ph.W = WQKV + (size_t)2 * 4 * DH * DH; ph.Act = (const bf16_t*)(ws + WS_BIG); ph.OT = (bf16_t*)(ws + WS_VT); ph.scale = 1.f; ph.frag = 0; }
    gemm_phase(lds, ph, wv);
}
__device__ __forceinline__ void run_qk(LAS unsigned char* lds, int wv) {
    const Params P = load_params(); unsigned char* ws = P.ws;
    PhQK ph; ph.K = DH; ph.lda = 6144; ph.ldb = 6144; ph.nM = GB * NH * 9; ph.nN = 1; ph.coff = 0; ph.QKV = (const bf16_t*)(ws + WS_QKV); ph.QKR = (float*)(ws + WS_QKR);
    gemm_phase(lds, ph, wv);
}
__device__ __forceinline__ void run_gates(LAS unsigned char* lds, int j, int part, int wv) {
    const Params P = load_params(); unsigned char* ws = P.ws;
    PhGates ph; ph.K = 512; ph.ldb = 2048; ph.nM = MT; ph.nN = 4; ph.poff = 4 * part;
    if (part == 0) { ph.A = (const bf16_t*)(ws + WS_UC); ph.lda = DI; ph.coff = 128; } else { ph.A = (const bf16_t*)(ws + WS_BIG); ph.lda = 6144; ph.coff = 144; }
    ph.WG = (const bf16_t*)(ws + WS_MWG) + (size_t)(j * 2 + part) * 256 * 2048; ph.GATESP = (float*)(ws + WS_GATESP);
    gemm_phase(lds, ph, wv);
}

#define XB_TMO      128
#define XB_XCNT(j)  (256  + 64 * (j))
#define XB_XSUB(j)  (1280 + 64 * (j))
#define XB_XGEN(j)  (2304 + 64 * (j))
#define XB_TOP      3328
#define XB_TOPGEN   3392
#define XCD_BAR_WORDS 3456
#define XB_SPIN_CAP (1u << 22)
__device__ __forceinline__ unsigned xb_ld(unsigned* p)              { return __hip_atomic_load(p, __ATOMIC_RELAXED, __HIP_MEMORY_SCOPE_AGENT); }
__device__ __forceinline__ unsigned xb_add(unsigned* p, unsigned v) { return __hip_atomic_fetch_add(p, v, __ATOMIC_RELAXED, __HIP_MEMORY_SCOPE_AGENT); }
__device__ __forceinline__ unsigned xb_xcc_id() { return (unsigned)__builtin_amdgcn_s_getreg((3 << 11) | 20) & 0xFu; }
#define XB_SPIN(cond, bar) do { unsigned _sp = 0; while (cond) { __builtin_amdgcn_s_sleep(1); \
    if ((++_sp & 255u) == 0u) { if (xb_ld(&(bar)[XB_TMO])) break; if (_sp > XB_SPIN_CAP) { atomicAdd(&(bar)[XB_TMO], 1u); break; } } } } while (0)
struct XcdBarrier { unsigned* bar; unsigned x; volatile LAS unsigned* st; };
__device__ __forceinline__ XcdBarrier xcd_barrier_post(unsigned* bar, volatile LAS unsigned* st) {
    XcdBarrier b; b.bar = bar; b.x = xb_xcc_id(); b.st = st;
    if (threadIdx.x == 0) (void)xb_add(&bar[XB_XCNT(b.x)], 1u);
    return b;
}
__device__ __forceinline__ void xcd_barrier_complete(unsigned* bar, unsigned x, unsigned& nloc, unsigned& nx) {
    const unsigned G = gridDim.x * gridDim.y * gridDim.z;
    unsigned sum, cnt, mine, sp = 0u;
    for (;;) {
        sum = 0u; cnt = 0u; mine = 0u;
#pragma unroll
        for (unsigned j = 0; j < 16; ++j) { const unsigned c = xb_ld(&bar[XB_XCNT(j)]); sum += c; cnt += (c > 0u) ? 1u : 0u; mine = (j == x) ? c : mine; }
        if (sum == G) break;
        __builtin_amdgcn_s_sleep(1);
        if ((++sp & 255u) == 0u) { if (xb_ld(&bar[XB_TMO])) break; if (sp > XB_SPIN_CAP) { atomicAdd(&bar[XB_TMO], 1u); break; } }
    }
    nloc = mine > 0u ? mine : 1u; nx = cnt > 0u ? cnt : 1u;
}
__device__ __forceinline__ void xcd_barrier(const XcdBarrier& b, int wv) {
    asm volatile("s_waitcnt vmcnt(0)" ::: "memory");
    __syncthreads();
    if (opaque_tid(wv) == 0) {
        unsigned* bar = b.bar;
        __builtin_amdgcn_s_waitcnt(0);
        unsigned nloc = b.st[0], nx = b.st[1];
        if (nloc == 0u) { xcd_barrier_complete(bar, b.x, nloc, nx); b.st[0] = nloc; b.st[1] = nx; }
        const unsigned old = xb_add(&bar[XB_XSUB(b.x)], 1u);
        const unsigned gen = old / nloc;
        if (old + 1u == (gen + 1u) * nloc) {
            __builtin_amdgcn_fence(__ATOMIC_RELEASE, "agent");
            asm volatile("s_waitcnt vmcnt(0)" ::: "memory");
            const unsigned og = xb_add(&bar[XB_TOP], 1u);
            const unsigned tg = og / nx;
            if (og + 1u == (tg + 1u) * nx) xb_add(&bar[XB_TOPGEN], 1u);
            else XB_SPIN(xb_ld(&bar[XB_TOPGEN]) == tg, bar);
            __builtin_amdgcn_fence(__ATOMIC_ACQUIRE, "agent");
            xb_add(&bar[XB_XGEN(b.x)], 1u);
            asm volatile("s_waitcnt vmcnt(0)" ::: "memory");
        } else {
            XB_SPIN(xb_ld(&bar[XB_XGEN(b.x)]) == gen, bar);
            __builtin_amdgcn_fence(__ATOMIC_ACQUIRE, "agent");
            asm volatile("s_waitcnt vmcnt(0)" ::: "memory");
        }
    }
    __syncthreads();
}

__global__ void __launch_bounds__(512, 2) hybrid_fwd(Params Punused) {
    extern __shared__ __attribute__((aligned(16))) unsigned char lds_raw[];
    LAS unsigned char* lds = (LAS unsigned char*)lds_raw;
    cg::grid_group grid = cg::this_grid();
    const int wv = __builtin_amdgcn_readfirstlane((int)(threadIdx.x >> 6));
    volatile LAS unsigned* bst = (volatile LAS unsigned*)(lds + LDS_BST);
    if (threadIdx.x < 4) bst[threadIdx.x] = 0u;
    __syncthreads();
    { const Params P0 = load_params(); (void)xcd_barrier_post((unsigned*)(P0.ws + WS_BAR), bst); }
#define GSYNC() do { const Params Pb = load_params(); XcdBarrier xb_; xb_.bar = (unsigned*)(Pb.ws + WS_BAR); xb_.x = xb_xcc_id(); xb_.st = (volatile LAS unsigned*)(lds + LDS_BST); xcd_barrier(xb_, wv); } while (0)
    phase_prep(lds, wv);
    grid.sync();
    phase_modreduce(wv);
    GSYNC();
    phase_modulate(0, 0, 0, false, wv);
    GSYNC();
    run_in_gemm(lds, 0, true, 0, 0, 0, wv);
    phase_modulate(0, 1, 1, true, wv);
    GSYNC();
    for (int st = 0; st < 16; ++st) {
        const int layer = st >> 2, g = st & 3, j = st >> 3, nst = st + 1;
        if ((layer & 1) == 0) {
            phase_convmix(j, g, wv);
            GSYNC();
        } else {
            phase_uc(j, wv);
            GSYNC();
            run_qkv_nat(lds, j, false, wv); run_tr(lds, j, false, wv); run_tr(lds, j, true, wv); run_gates(lds, j, 0, wv); run_gates(lds, j, 1, wv);
            GSYNC();
            run_qk(lds, wv); phase_gatetab(lds, j, wv);
            GSYNC();
            phase_scan(lds, j, wv);
            GSYNC();
            phase_gating(j, wv);
            GSYNC();
        }
        run_out_gemm(lds, layer, g, wv);
        if (nst < 16) run_in_gemm(lds, nst >> 3, ((nst >> 2) & 1) == 0, 256 - 144, nst & 3, nst & 1, wv);
        if (st == 15) phase_final(0, 3 * GB * SEQ, true, wv);
        if (st + 2 < 16) phase_modulate((st + 2) >> 2, (st + 2) & 3, st & 1, true, wv);
        GSYNC();
    }
    phase_final(3 * GB * SEQ, NB * SEQ, false, wv);
}

extern "C" void kernel_launch(void* const* d_in, const int* in_sizes, int n_in, void* d_out, int out_size, void* d_ws, size_t ws_size, hipStream_t stream) {
    static int grid_blocks = 0;
    if (grid_blocks == 0) {
        if (n_in != 21 || out_size != NB * SEQ * DM || ws_size < WS_END) { fprintf(stderr, "kernel_launch: unexpected shapes (n_in %d out %d ws %zu)\n", n_in, out_size, ws_size); grid_blocks = -1; return; }
        int dev = 0, cus = 0, per_cu = 0;
        if (hipGetDevice(&dev) != hipSuccess || hipDeviceGetAttribute(&cus, hipDeviceAttributeMultiprocessorCount, dev) != hipSuccess) { grid_blocks = -1; return; }
        if (hipFuncSetAttribute((const void*)hybrid_fwd, hipFuncAttributeMaxDynamicSharedMemorySize, LDS_BYTES) != hipSuccess) { fprintf(stderr, "kernel_launch: hipFuncSetAttribute failed\n"); grid_blocks = -1; return; }
        if (hipOccupancyMaxActiveBlocksPerMultiprocessor(&per_cu, (const void*)hybrid_fwd, 512, LDS_BYTES) != hipSuccess || per_cu < 1) { fprintf(stderr, "kernel_launch: occupancy query says %d\n", per_cu); per_cu = 1; }
        (void)hipGetLastError();
        grid_blocks = cus;
    }
    if (grid_blocks < 0) return;
    if (hipMemsetAsync((char*)d_ws + WS_BAR, 0, XCD_BAR_WORDS * sizeof(unsigned), stream) != hipSuccess) { fprintf(stderr, "kernel_launch: memset of the barrier words failed\n"); return; }
    Params p{};
    const float** pp = (const float**)&p;
    for (int i = 0; i < 21; ++i) pp[i] = (const float*)d_in[i];
    p.out = (float*)d_out; p.ws = (unsigned char*)d_ws;
    void* args[] = {&p};
    hipError_t e = hipLaunchCooperativeKernel((const void*)hybrid_fwd, dim3(grid_blocks), dim3(512), args, LDS_BYTES, stream);
    if (e != hipSuccess) fprintf(stderr, "cooperative launch failed: %s (grid %d)\n", hipGetErrorString(e), grid_blocks);
}
```
